# Optimizing an MI355X kernel written in HIP

```python
import jax, jax.numpy as jnp
from jax import lax
import numpy as np

D_MODEL = 1024
BATCH = 8
SEQ = 2048
DEPTH = 1

CHUNK = 64
N_META = 16
ROPE_THETA = 10000.0
RMS_EPS = 1e-6
D_MIX = D_MODEL
HEAD_DIM = 64
D_ATTN = D_MIX // 2
ATTN_HEADS = D_ATTN // HEAD_DIM
IDX_HEADS = 8
IDX_DIM = 64
TOPK_MAX = 256
Q_BLOCK = 128
POOL_WINDOWS = (2, 4, 8, 16)
POOL_GROUPS = 4
D_POOL = D_MIX - D_ATTN
POOL_CH = D_POOL // POOL_GROUPS
OFF_Q = 0
OFF_K = OFF_Q + D_ATTN
OFF_V = OFF_K + D_ATTN
OFF_POOL = OFF_V + D_ATTN
OFF_IQ = OFF_POOL + D_POOL
OFF_IK = OFF_IQ + IDX_HEADS * IDX_DIM
OFF_IW = OFF_IK + IDX_DIM
D_IN_PROJ = OFF_IW + IDX_HEADS
PEER_HEADS = 8
N_KEYS = 128
N_EXPERTS = N_KEYS * N_KEYS
PEER_QDIM = 256
PEER_HALF = PEER_QDIM // 2
PEER_TOPK = 16
TOK_BLOCK = 256

kernel_name = 'hymba_dsa_pool_peer_layer'


def rms_norm(x, g):
    xf = x.astype(jnp.float32)
    y = xf * lax.rsqrt(jnp.mean(xf * xf, axis=-1, keepdims=True) + RMS_EPS)
    return (y * g.astype(jnp.float32)).astype(x.dtype)


def rope_tables(T, dim):
    inv = ROPE_THETA ** (-jnp.arange(0, dim, 2, dtype=jnp.float32) / dim)
    ang = jnp.arange(T, dtype=jnp.float32)[:, None] * inv[None, :]
    return jnp.cos(ang), jnp.sin(ang)


def apply_rope(x, cos, sin):
    xf = x.astype(jnp.float32)
    x1, x2 = jnp.split(xf, 2, axis=-1)
    c = cos[None, :, None, :]
    s = sin[None, :, None, :]
    return jnp.concatenate([x1 * c - x2 * s, x2 * c + x1 * s], axis=-1).astype(x.dtype)


def chunk_ids(T):
    pos = jnp.arange(T, dtype=jnp.int32)
    return jnp.where(pos < N_META, 0, 1 + (pos - N_META) // CHUNK)


def dsa_attention(q, k, v, qi, ki, wi, k_sel):
    B, T = q.shape[0], q.shape[1]
    nb = -(-T // Q_BLOCK)
    Tp = nb * Q_BLOCK
    pad = Tp - T
    cid = chunk_ids(T)
    cq_all = chunk_ids(Tp).reshape(nb, Q_BLOCK)

    def blocks(a):
        a = jnp.pad(a, [(0, 0), (0, pad)] + [(0, 0)] * (a.ndim - 2))
        return a.reshape((B, nb, Q_BLOCK) + a.shape[2:]).swapaxes(0, 1)

    gather = jax.vmap(lambda a, i: a[i])

    def one_block(args):
        qb, qib, wb, cqb = args
        rel = jax.nn.relu(jnp.einsum('bqhd,bsd->bqhs', qib, ki, preferred_element_type=jnp.float32))
        score = jnp.einsum('bqhs,bqh->bqs', rel, wb.astype(jnp.float32))
        vis = cid[None, :] <= cqb[:, None]
        score = jnp.where(vis[None], score, -jnp.inf)
        _, idx = lax.top_k(score, k_sel)
        ks = gather(k, idx)
        vs = gather(v, idx)
        ok = cid[idx] <= cqb[None, :, None]
        logits = jnp.einsum('bqhd,bqkhd->bhqk', qb, ks,
                            preferred_element_type=jnp.float32) * (HEAD_DIM ** -0.5)
        logits = jnp.where(ok[:, None], logits, -jnp.inf)
        p = jax.nn.softmax(logits, axis=-1).astype(vs.dtype)
        return jnp.einsum('bhqk,bqkhd->bqhd', p, vs)

    out = lax.map(one_block, (blocks(q), blocks(qi), blocks(wi), cq_all))
    out = out.swapaxes(0, 1).reshape(B, Tp, q.shape[2], q.shape[3])[:, :T]
    return out


def pool_mixer(u, pool_w, pool_scale):
    B, T, _ = u.shape
    uf = u.astype(jnp.float32).reshape(B, T, POOL_GROUPS, POOL_CH)
    c = jnp.cumsum(jnp.pad(uf, ((0, 0), (1, 0), (0, 0), (0, 0))), axis=1)
    t = jnp.arange(T, dtype=jnp.int32)
    means = []
    for g, w in enumerate(POOL_WINDOWS):
        lo = jnp.maximum(t + 1 - w, 0)
        cnt = jnp.minimum(t + 1, w).astype(jnp.float32)
        means.append((c[:, 1:, g] - c[:, lo, g]) / cnt[None, :, None])
    y = (jnp.stack(means, axis=2) - uf).astype(u.dtype)
    y = jnp.einsum('btgc,gcd->btgd', y, pool_w).reshape(B, T, D_POOL)
    return y * pool_scale


def peer_ffn(h, peer_wq, sub_keys1, sub_keys2, peer_u, peer_v):
    B, T, D = h.shape
    q = (h @ peer_wq).reshape(B, T, PEER_HEADS, PEER_QDIM)
    q1, q2 = q[..., :PEER_HALF], q[..., PEER_HALF:]
    s1 = jnp.einsum('bthd,nd->bthn', q1, sub_keys1, preferred_element_type=jnp.float32)
    s2 = jnp.einsum('bthd,nd->bthn', q2, sub_keys2, preferred_element_type=jnp.float32)
    v1, i1 = lax.top_k(s1, PEER_TOPK)
    v2, i2 = lax.top_k(s2, PEER_TOPK)
    n_cand = PEER_TOPK * PEER_TOPK
    cand_s = (v1[..., :, None] + v2[..., None, :]).reshape(B, T, PEER_HEADS, n_cand)
    cand_i = (i1[..., :, None] * N_KEYS + i2[..., None, :]).reshape(B, T, PEER_HEADS, n_cand)
    top_s, pos = lax.top_k(cand_s, PEER_TOPK)
    eid = jnp.take_along_axis(cand_i, pos, axis=-1)
    gate = jax.nn.softmax(top_s, axis=-1)
    n = B * T
    npad = -(-n // TOK_BLOCK) * TOK_BLOCK
    kk = PEER_HEADS * PEER_TOPK
    hf = jnp.pad(h.reshape(n, D), ((0, npad - n), (0, 0))).reshape(-1, TOK_BLOCK, D)
    ef = jnp.pad(eid.reshape(n, kk), ((0, npad - n), (0, 0))).reshape(-1, TOK_BLOCK, kk)
    gf = jnp.pad(gate.reshape(n, kk), ((0, npad - n), (0, 0))).reshape(-1, TOK_BLOCK, kk)

    def one_block(args):
        hb, eb, gb = args
        a = jnp.einsum('td,tkd->tk', hb, peer_u[eb], preferred_element_type=jnp.float32)
        a = jax.nn.gelu(a, approximate=False)
        return jnp.einsum('tk,tkd->td', (gb * a).astype(hb.dtype), peer_v[eb])

    out = lax.map(one_block, (hf, ef, gf))
    return out.reshape(npad, D)[:n].reshape(B, T, D)


def setup_inputs(seed: int = 0) -> dict:
    key = jax.random.key(seed)
    ks = jax.random.split(key, 16)
    nrm = jax.random.normal
    f32 = jnp.float32
    return {
        'x': nrm(ks[0], (BATCH, SEQ, D_MODEL), f32),
        'meta_tokens': nrm(ks[1], (N_META, D_MODEL), f32),
        'norm1_g': 1.0 + 0.02 * nrm(ks[2], (DEPTH, D_MODEL), f32),
        'w_in': nrm(ks[3], (DEPTH, D_MODEL, D_IN_PROJ), f32) * D_MODEL ** -0.5,
        'q_norm_g': 1.0 + 0.02 * nrm(ks[4], (DEPTH, HEAD_DIM), f32),
        'k_norm_g': 1.0 + 0.02 * nrm(ks[5], (DEPTH, HEAD_DIM), f32),
        'pool_w': nrm(ks[6], (DEPTH, POOL_GROUPS, POOL_CH, POOL_CH), f32) * POOL_CH ** -0.5,
        'pool_scale': 1.0 + 0.1 * nrm(ks[7], (DEPTH, D_POOL), f32),
        'w_out': nrm(ks[8], (DEPTH, D_MIX, D_MODEL), f32) * D_MIX ** -0.5,
        'norm2_g': 1.0 + 0.02 * nrm(ks[9], (DEPTH, D_MODEL), f32),
        'peer_wq': nrm(ks[10], (DEPTH, D_MODEL, PEER_HEADS * PEER_QDIM), f32) * D_MODEL ** -0.5,
        'sub_keys1': nrm(ks[11], (DEPTH, N_KEYS, PEER_HALF), f32) * PEER_HALF ** -0.5,
        'sub_keys2': nrm(ks[12], (DEPTH, N_KEYS, PEER_HALF), f32) * PEER_HALF ** -0.5,
        'peer_u': nrm(ks[13], (DEPTH, N_EXPERTS, D_MODEL), f32) * D_MODEL ** -0.5,
        'peer_v': nrm(ks[14], (DEPTH, N_EXPERTS, D_MODEL), f32) * PEER_HEADS ** -0.5,
    }


def reference(x, meta_tokens, norm1_g, w_in, q_norm_g, k_norm_g, pool_w, pool_scale,
              w_out, norm2_g, peer_wq, sub_keys1, sub_keys2, peer_u, peer_v):
    B, S, D = x.shape
    k_sel = min(TOPK_MAX, S // 4)
    T = S + N_META
    h = jnp.concatenate([jnp.broadcast_to(meta_tokens.astype(x.dtype)[None], (B, N_META, D)), x], axis=1)
    cos, sin = rope_tables(T, HEAD_DIM)
    for l in range(DEPTH):
        z = rms_norm(h, norm1_g[l]) @ w_in[l]
        q = z[..., OFF_Q:OFF_K].reshape(B, T, ATTN_HEADS, HEAD_DIM)
        k = z[..., OFF_K:OFF_V].reshape(B, T, ATTN_HEADS, HEAD_DIM)
        v = z[..., OFF_V:OFF_POOL].reshape(B, T, ATTN_HEADS, HEAD_DIM)
        q = apply_rope(rms_norm(q, q_norm_g[l]), cos, sin)
        k = apply_rope(rms_norm(k, k_norm_g[l]), cos, sin)
        qi = apply_rope(z[..., OFF_IQ:OFF_IK].reshape(B, T, IDX_HEADS, IDX_DIM), cos, sin)
        ki = apply_rope(z[..., OFF_IK:OFF_IW][:, :, None, :], cos, sin)[:, :, 0, :]
        wi = z[..., OFF_IW:D_IN_PROJ] * (IDX_HEADS ** -0.5 * IDX_DIM ** -0.5)
        a = dsa_attention(q, k, v, qi, ki, wi, k_sel).reshape(B, T, D_ATTN)
        p = pool_mixer(z[..., OFF_POOL:OFF_IQ], pool_w[l], pool_scale[l])
        h = h + jnp.concatenate([a, p], axis=-1) @ w_out[l]
        h = h + peer_ffn(rms_norm(h, norm2_g[l]), peer_wq[l], sub_keys1[l], sub_keys2[l],
                         peer_u[l], peer_v[l])
    return h[:, N_META:]
```

```cpp
#include <hip/hip_runtime.h>
#include <cstdio>
#include <cstdint>
namespace pg8 {
#define PG8_LAS __attribute__((address_space(3)))
typedef unsigned short bf16_t;
typedef short bf16x8 __attribute__((ext_vector_type(8)));
typedef float f32x4 __attribute__((ext_vector_type(4)));
typedef unsigned u32x4 __attribute__((ext_vector_type(4)));
constexpr int BM = 256, BK = 64, HALF = 128, HTB = HALF * BK * 2  , STAGE_BYTES = 8 * HTB, NXCD = 8, WGM = 8;

__host__ __device__ __forceinline__ int lds_byte(int r, int c) { const int st = (r >> 4) * 2 + (c >> 5), rr = r & 15, cc = c & 31, ob = rr * 64 + cc * 2; return st * 1024 + (ob ^ (((ob >> 9) & 1) << 5)); }
__host__ __device__ __forceinline__ void stage_rc(int b, int& R, int& C) { const int st = b / 1024, sb = b % 1024, swz = sb ^ (((sb >> 9) & 1) << 5); R = (st >> 1) * 16 + swz / 64; C = (st & 1) * 32 + (swz % 64) / 2; }
__host__ __device__ __forceinline__ int perm32(int rho) { const int n = rho >> 4, i = rho & 15; return 8 * (i >> 2) + 4 * n + (i & 3); }

struct Unit { int pm, pn; };
struct Gemm { const bf16_t* A; const bf16_t* Bt; int M, N, K; };
struct StaticOrder {
    int nM, nN, nwg, G, c;
    __host__ __device__ void init(int M, int N, int G_, int c_) { nM = M / BM; nN = N / BM; nwg = nM * nN; G = G_; c = c_; }
    __host__ __device__ bool next(int i, Unit& u) const {
        const long L = (long)i * G + c; if (L >= nwg) return false;
        int wgid = (int)L; { const int q = nwg / NXCD, r = nwg % NXCD, xcd = wgid % NXCD, off = wgid / NXCD; wgid = (xcd < r ? xcd * (q + 1) : r * (q + 1) + (xcd - r) * q) + off; }
        const int nig = WGM * nN, gid = wgid / nig, fm = gid * WGM, gsz = (nM - fm) < WGM ? (nM - fm) : WGM;
        u.pm = fm + ((wgid % nig) % gsz); u.pn = (wgid % nig) / gsz; return true;
    }
    __device__ __forceinline__ void a_ready(const Unit&) const {}
    __device__ __forceinline__ void done(const Unit&) const {}
};
__device__ __forceinline__ unsigned cvt_pk_bf16(float lo, float hi) { unsigned r; asm volatile("v_cvt_pk_bf16_f32 %0, %1, %2" : "=v"(r) : "v"(lo), "v"(hi)); return r; }
template <class Epi, class Sched>
__device__ __forceinline__ void gemm_phase(PG8_LAS unsigned char* lds, const Gemm g, const Sched& S, const Epi& E) {
    int tid_ = threadIdx.x; asm volatile("" : "+v"(tid_));
    const int tid = tid_, wid = __builtin_amdgcn_readfirstlane(tid >> 6), lane = tid & 63, wr = wid >> 2, wc = wid & 3, fr = lane & 15, fq = lane >> 4;
    const int K = g.K, nt = K / BK;
    unsigned voffA[2], voffB[2];
#pragma unroll
    for (int i = 0; i < 2; ++i) { int R, C; stage_rc(tid * 16 + i * 8192, R, C); const int Rb = Epi::PERM ? ((R & ~31) + perm32(R & 31)) : R;
        voffA[i] = (unsigned)(R * K + C) * 2u; voffB[i] = (unsigned)(Rb * K + C) * 2u; }
    const size_t kstep = (size_t)(BK * 2);
    const size_t hstep = (size_t)HALF * K * 2;
    const size_t tstep = 2 * hstep;
    const unsigned ldsw = (unsigned)wid * 1024u;
    const int aoff = lds_byte(wr * 64 + fr, fq * 8), boff = lds_byte(wc * 32 + fr, fq * 8);
#define PG8_SA(b, h) (((b) * 2 + (h)) * HTB)
#define PG8_SB(b, h) ((4 + (b) * 2 + (h)) * HTB)
#define PG8_STAGE(bufoff, gbase, voff) do { _Pragma("unroll") for (int _i = 0; _i < 2; ++_i) \
        __builtin_amdgcn_global_load_lds((const unsigned*)((const char*)(gbase) + (voff)[_i]), (PG8_LAS unsigned*)(lds + (bufoff) + ldsw + _i * 8192), 16, 0, 0); } while (0)
#define PG8_LDA(dst, b, h) do { _Pragma("unroll") for (int m = 0; m < 4; ++m) _Pragma("unroll") for (int k = 0; k < 2; ++k) dst[m][k] = *(const PG8_LAS bf16x8*)(lds + PG8_SA(b, h) + aoff + m * 2048 + k * 1024); } while (0)
#define PG8_LDB(dst, b, h) do { _Pragma("unroll") for (int n = 0; n < 2; ++n) _Pragma("unroll") for (int k = 0; k < 2; ++k) dst[n][k] = *(const PG8_LAS bf16x8*)(lds + PG8_SB(b, h) + boff + n * 2048 + k * 1024); } while (0)
#define PG8_MMA(ai, bj, At, Bt) do { __builtin_amdgcn_s_setprio(1); _Pragma("unroll") for (int m = 0; m < 4; ++m) _Pragma("unroll") for (int n = 0; n < 2; ++n) _Pragma("unroll") for (int k = 0; k < 2; ++k) \
        acc[ai][bj][m][n] = __builtin_amdgcn_mfma_f32_16x16x32_bf16(Bt[n][k], At[m][k], acc[ai][bj][m][n], 0, 0, 0); __builtin_amdgcn_s_setprio(0); } while (0)
#define PG8_WAIT_V(n) asm volatile("s_waitcnt vmcnt(" #n ")" ::: "memory")
#define PG8_WAIT_L(n) asm volatile("s_waitcnt lgkmcnt(" #n ")" ::: "memory")
#define PG8_BAR __builtin_amdgcn_s_barrier()
#define PG8_SCHED __builtin_amdgcn_sched_barrier(0)
    Unit cur, nxt; int ui = 0;
    if (!S.next(0, cur)) return;
    f32x4 acc[2][2][4][2];
#pragma unroll
    for (int a = 0; a < 2; ++a)
#pragma unroll
        for (int b = 0; b < 2; ++b)
#pragma unroll
            for (int m = 0; m < 4; ++m)
#pragma unroll
                for (int n = 0; n < 2; ++n) acc[a][b][m][n] = (f32x4){0.f, 0.f, 0.f, 0.f};
    bf16x8 At[4][2], B0[2][2], B1[2][2];
    const char* cA = (const char*)g.A + (size_t)cur.pm * tstep; const char* cB = (const char*)g.Bt + (size_t)cur.pn * tstep;
    S.a_ready(cur);
    PG8_STAGE(PG8_SB(0, 0), cB, voffB); PG8_STAGE(PG8_SA(0, 0), cA, voffA); PG8_STAGE(PG8_SB(0, 1), cB + hstep, voffB); PG8_STAGE(PG8_SA(0, 1), cA + hstep, voffA);
    if (wr == 1) PG8_BAR;
    PG8_WAIT_V(4); PG8_BAR;
    PG8_STAGE(PG8_SB(1, 0), cB + kstep, voffB); PG8_STAGE(PG8_SA(1, 0), cA + kstep, voffA); PG8_STAGE(PG8_SB(1, 1), cB + hstep + kstep, voffB);
    PG8_WAIT_V(6); PG8_BAR;
    for (;;) {
        const bool has_next = S.next(ui + 1, nxt);
        const char* nA = has_next ? (const char*)g.A + (size_t)nxt.pm * tstep : cA; const char* nB = has_next ? (const char*)g.Bt + (size_t)nxt.pn * tstep : cB;
        for (int t = 0; t < nt; t += 2) {
            const bool last = (t == nt - 2);
            const char* a1 = cA + (size_t)(t + 1) * kstep;
            const char* a2 = last ? nA : cA + (size_t)(t + 2) * kstep; const char* b2 = last ? nB : cB + (size_t)(t + 2) * kstep;
            const char* a3 = a2 + kstep; const char* b3 = b2 + kstep;
            if (last && has_next) S.a_ready(nxt);
            PG8_LDB(B0, 0, 0); PG8_SCHED; PG8_LDA(At, 0, 0); PG8_STAGE(PG8_SA(1, 1), a1 + hstep, voffA);
            PG8_WAIT_L(8); PG8_BAR; PG8_WAIT_L(0); PG8_MMA(0, 0, At, B0); PG8_BAR; PG8_SCHED;
            PG8_LDB(B1, 0, 1); PG8_STAGE(PG8_SB(0, 0), b2, voffB);
            PG8_BAR; PG8_WAIT_L(0); PG8_MMA(0, 1, At, B1); PG8_BAR;
            PG8_LDA(At, 0, 1); PG8_STAGE(PG8_SA(0, 0), a2, voffA);
            PG8_BAR; PG8_WAIT_L(0); PG8_MMA(1, 0, At, B0); PG8_BAR; PG8_SCHED;
            PG8_STAGE(PG8_SB(0, 1), b2 + hstep, voffB);
            PG8_WAIT_V(6); PG8_BAR; PG8_MMA(1, 1, At, B1); PG8_BAR;
            PG8_LDB(B0, 1, 0); PG8_SCHED; PG8_LDA(At, 1, 0); PG8_STAGE(PG8_SA(0, 1), a2 + hstep, voffA);
            PG8_WAIT_L(8); PG8_BAR; PG8_WAIT_L(0); PG8_MMA(0, 0, At, B0); PG8_BAR; PG8_SCHED;
            PG8_LDB(B1, 1, 1); PG8_STAGE(PG8_SB(1, 0), b3, voffB);
            PG8_BAR; PG8_WAIT_L(0); PG8_MMA(0, 1, At, B1); PG8_BAR;
            PG8_LDA(At, 1, 1); PG8_STAGE(PG8_SA(1, 0), a3, voffA);
            PG8_BAR; PG8_WAIT_L(0); PG8_MMA(1, 0, At, B0); PG8_BAR; PG8_SCHED;
            PG8_STAGE(PG8_SB(1, 1), b3 + hstep, voffB);
            PG8_WAIT_V(6); PG8_BAR; PG8_MMA(1, 1, At, B1); PG8_BAR;
        }
        if constexpr (!Epi::AFTER_DRAIN) { E(acc, cur, wr, wc, fr, fq); S.done(cur); }
        if (!has_next) break;
#pragma unroll
        for (int a = 0; a < 2; ++a)
#pragma unroll
            for (int b = 0; b < 2; ++b)
#pragma unroll
                for (int m = 0; m < 4; ++m)
#pragma unroll
                    for (int n = 0; n < 2; ++n) acc[a][b][m][n] = (f32x4){0.f, 0.f, 0.f, 0.f};
        cur = nxt; cA = nA; cB = nB; ++ui;
    }
    PG8_WAIT_V(0);
    if (wr == 0) PG8_BAR;
    PG8_BAR;
    if constexpr (Epi::AFTER_DRAIN) { E.fused(acc, cur, wr, wc, fr, fq, lds, wid, lane); S.done(cur); }
#undef PG8_SA
#undef PG8_SB
#undef PG8_STAGE
#undef PG8_LDA
#undef PG8_LDB
#undef PG8_MMA
#undef PG8_WAIT_V
#undef PG8_WAIT_L
#undef PG8_BAR
#undef PG8_SCHED
}
}
#define XB_TMO      128
#define XB_XCNT(j)  (256  + 64 * (j))
#define XB_XSUB(j)  (1280 + 64 * (j))
#define XB_XGEN(j)  (2304 + 64 * (j))
#define XB_TOP      3328
#define XB_TOPGEN   3392
#define XCD_BAR_WORDS 3456
#define XB_SPIN_CAP (1u << 18)

__device__ __forceinline__ unsigned xb_ld(unsigned* p)              { return __hip_atomic_load(p, __ATOMIC_RELAXED, __HIP_MEMORY_SCOPE_AGENT); }
__device__ __forceinline__ unsigned xb_add(unsigned* p, unsigned v) { return __hip_atomic_fetch_add(p, v, __ATOMIC_RELAXED, __HIP_MEMORY_SCOPE_AGENT); }
__device__ __forceinline__ unsigned xb_xcc_id() { return (unsigned)__builtin_amdgcn_s_getreg((3 << 11) | 20) & 0xFu; }
#define XB_SPIN(cond, bar) do { unsigned _sp = 0; while (cond) { __builtin_amdgcn_s_sleep(1); \
    if ((++_sp & 255u) == 0u) { if (xb_ld(&(bar)[XB_TMO])) break; if (_sp > XB_SPIN_CAP) { atomicAdd(&(bar)[XB_TMO], 1u); break; } } } } while (0)

struct XcdBarrier {
    unsigned* bar; unsigned x;
    volatile __attribute__((address_space(3))) unsigned* st;
};

__device__ __forceinline__ XcdBarrier xcd_barrier_post(unsigned* bar, volatile __attribute__((address_space(3))) unsigned* st) {
    XcdBarrier b; b.bar = bar; b.x = xb_xcc_id(); b.st = st;
    if (threadIdx.x == 0) (void)xb_add(&bar[XB_XCNT(b.x)], 1u);
    return b;
}
__device__ __forceinline__ void xcd_barrier_complete(unsigned* bar, unsigned x, unsigned& nloc, unsigned& nx) {
    const unsigned G = gridDim.x * gridDim.y * gridDim.z;
    unsigned sum, cnt, mine, sp = 0u;
    for (;;) {
        sum = 0u; cnt = 0u; mine = 0u;
#pragma unroll
        for (unsigned j = 0; j < 16; ++j) { const unsigned c = xb_ld(&bar[XB_XCNT(j)]); sum += c; cnt += (c > 0u) ? 1u : 0u; mine = (j == x) ? c : mine; }
        if (sum == G) break;
        __builtin_amdgcn_s_sleep(1);
        if ((++sp & 255u) == 0u) { if (xb_ld(&bar[XB_TMO])) break; if (sp > XB_SPIN_CAP) { atomicAdd(&bar[XB_TMO], 1u); break; } }
    }
    nloc = mine > 0u ? mine : 1u; nx = cnt > 0u ? cnt : 1u;
}

__device__ __forceinline__ void xcd_barrier(const XcdBarrier& b) {
    asm volatile("s_waitcnt vmcnt(0)" ::: "memory");
    __syncthreads();
    if (threadIdx.x == 0) {
        unsigned* bar = b.bar;
        __builtin_amdgcn_s_waitcnt(0);
        unsigned nloc = b.st[0], nx = b.st[1];
        if (nloc == 0u) { xcd_barrier_complete(bar, b.x, nloc, nx); b.st[0] = nloc; b.st[1] = nx; }
        const unsigned old = xb_add(&bar[XB_XSUB(b.x)], 1u);
        const unsigned gen = old / nloc;
        if (old + 1u == (gen + 1u) * nloc) {
            __builtin_amdgcn_fence(__ATOMIC_RELEASE, "agent");
            asm volatile("s_waitcnt vmcnt(0)" ::: "memory");
            const unsigned og = xb_add(&bar[XB_TOP], 1u);
            const unsigned tg = og / nx;
            if (og + 1u == (tg + 1u) * nx) xb_add(&bar[XB_TOPGEN], 1u);
            else XB_SPIN(xb_ld(&bar[XB_TOPGEN]) == tg, bar);
            __builtin_amdgcn_fence(__ATOMIC_ACQUIRE, "agent");
            xb_add(&bar[XB_XGEN(b.x)], 1u);
            asm volatile("s_waitcnt vmcnt(0)" ::: "memory");
        } else {
            XB_SPIN(xb_ld(&bar[XB_XGEN(b.x)]) == gen, bar);
            __builtin_amdgcn_fence(__ATOMIC_ACQUIRE, "agent");
            asm volatile("s_waitcnt vmcnt(0)" ::: "memory");
        }
    }
    __syncthreads();
}

namespace mk {
using pg8::bf16_t; using pg8::bf16x8; using pg8::f32x4; using pg8::u32x4; using pg8::cvt_pk_bf16;
typedef float f32x16 __attribute__((ext_vector_type(16)));
typedef unsigned u32x2 __attribute__((ext_vector_type(2)));
typedef short s16x4 __attribute__((ext_vector_type(4)));
#define LAS __attribute__((address_space(3)))
#define MFMA32(a, b, c) __builtin_amdgcn_mfma_f32_32x32x16_bf16((a), (b), (c), 0, 0, 0)

constexpr int DM = 1024, NB = 8, SEQ = 2048, TT = 2064, NMETA = 16;
constexpr int MREAL = NB * SEQ, MROWS = MREAL + NMETA, MPAD = 16640;
constexpr int NZ = 2632, NZP = 2816;
constexpr int OFF_Q = 0, OFF_K = 512, OFF_V = 1024, OFF_POOL = 1536, OFF_IQ = 2048, OFF_IK = 2560, OFF_IW = 2624;
constexpr int NEXP = 16384;
constexpr float RMS_EPS = 1e-6f, LOG2E = 1.4426950408889634f;
constexpr int NTHR = 512, LDS_BYTES = 163840;
constexpr int MASKW = 66;
constexpr int SCW = 2112;

constexpr size_t WS_CTL = 0;
constexpr size_t WS_SUMSQ = 65536;
constexpr size_t WS_WIN = WS_SUMSQ + 65536;
constexpr size_t WS_WOUT = WS_WIN + (size_t)NZP * 1024 * 2;
constexpr size_t WS_WQ = WS_WOUT + (size_t)1024 * 1024 * 2;
constexpr size_t WS_SK = WS_WQ + (size_t)2048 * 1024 * 2;
constexpr size_t WS_KI = WS_SK + 65536;
constexpr size_t WS_WI = WS_KI + (size_t)NB * TT * 64 * 2;
constexpr size_t WS_MASK = WS_WI + (size_t)MREAL * 8 * 4;
constexpr size_t WS_XN = WS_MASK + (size_t)MREAL * MASKW * 4;
constexpr size_t WS_MIX = WS_XN + (size_t)MPAD * 1024 * 2;
constexpr size_t WS_Q = WS_MIX + (size_t)MREAL * 1024 * 2;
constexpr size_t WS_K = WS_Q + (size_t)MREAL * 512 * 2;
constexpr size_t WS_VV = WS_K + (size_t)NB * TT * 512 * 2;
constexpr size_t WS_QI = WS_VV + (size_t)NB * TT * 512 * 2;
constexpr size_t WS_UP = WS_QI + (size_t)MREAL * 512 * 2;
constexpr size_t WS_U8 = WS_UP + (size_t)MROWS * 512 * 2;
constexpr size_t WS_SCL = WS_U8 + (size_t)NEXP * 1024;
constexpr size_t WS_C = WS_SCL + 131072;
constexpr size_t WS_V8 = WS_C + (size_t)MREAL * 128 * 4;
constexpr size_t WS_H1B = WS_V8 + (size_t)NEXP * 1024;
constexpr size_t WS_EID = WS_H1B + (size_t)MREAL * 1024 * 2;
constexpr size_t WS_TW = WS_EID + (size_t)MREAL * 128 * 8;
constexpr size_t WS_END = WS_TW + (size_t)1024 * 512 * 2;
constexpr size_t WS_QP = WS_Q;
static_assert(WS_END <= 268435456ull, "workspace");
static_assert((WS_MASK % 16) == 0 && (WS_XN % 256) == 0 && (WS_UP % 256) == 0 && (WS_K % 256) == 0 && (WS_U8 % 256) == 0, "align");
static_assert(WS_QP + (size_t)MREAL * 2048 * 2 <= WS_UP, "QP fits over Q..QI");
static_assert(WS_MIX == WS_XN + (size_t)MPAD * 1024 * 2 && WS_XN + (size_t)8 * MREAL * 128 * 4 <= WS_Q, "PART (f32 [8][16384][128]) fits over XN | MIX (dead after the input / output projections)");

struct Args { const float* in[15]; float* out; unsigned char* ws; int ph_lo, ph_hi; };

struct Frame {
    const float *x, *meta, *g1, *w_in, *gq, *gk, *pool_w, *pool_scale, *w_out, *g2, *wq, *sk1, *sk2, *pu, *pv;
    float* out; unsigned char* ws; LAS unsigned char* lds;
    int tid, lane, wave, G, bid;
#define WSPTR(name, type, off) __device__ __forceinline__ type* name() const { return (type*)(ws + (off)); }
    WSPTR(SUMSQ, float, WS_SUMSQ) WSPTR(WIN, bf16_t, WS_WIN) WSPTR(WOUT, bf16_t, WS_WOUT) WSPTR(WQ, bf16_t, WS_WQ) WSPTR(SK, bf16_t, WS_SK)
    WSPTR(KI, bf16_t, WS_KI) WSPTR(WI, float, WS_WI) WSPTR(MASK, unsigned, WS_MASK) WSPTR(XN, bf16_t, WS_XN) WSPTR(H1B, bf16_t, WS_H1B) WSPTR(MIX, bf16_t, WS_MIX)
    WSPTR(Q, bf16_t, WS_Q) WSPTR(K, bf16_t, WS_K) WSPTR(VV, bf16_t, WS_VV) WSPTR(QI, bf16_t, WS_QI) WSPTR(UP, bf16_t, WS_UP) WSPTR(QP, bf16_t, WS_QP)
    WSPTR(U8, unsigned char, WS_U8) WSPTR(V8, unsigned char, WS_V8) WSPTR(SU, float, WS_SCL) WSPTR(SV, float, WS_SCL + NEXP * 4)
    WSPTR(TW, bf16_t, WS_TW) WSPTR(PART, float, WS_XN) WSPTR(EID, int, WS_EID) WSPTR(GATE, float, WS_EID + (size_t)MREAL * 128 * 4) WSPTR(CB, float, WS_C)
#undef WSPTR
};


__device__ __forceinline__ int fresh(int v) { asm volatile("" : "+v"(v)); return v; }
__device__ __forceinline__ bf16_t f2bf(float f) { return (bf16_t)(cvt_pk_bf16(f, 0.f) & 0xffffu); }
__device__ __forceinline__ float bf2f(bf16_t b) { return __uint_as_float(((unsigned)b) << 16); }
__device__ __forceinline__ float bflo(unsigned w) { return __uint_as_float(w << 16); }
__device__ __forceinline__ float bfhi(unsigned w) { return __uint_as_float(w & 0xffff0000u); }
__device__ __forceinline__ float wave_sum(float v) {
#pragma unroll
    for (int o = 32; o > 0; o >>= 1) v += __shfl_xor(v, o);
    return v; }
__device__ __forceinline__ float half_sum32(float v) {
#pragma unroll
    for (int o = 16; o > 0; o >>= 1) v += __shfl_xor(v, o);
    return v; }

__host__ __device__ __forceinline__ int win_src_col(int np) {
    const int pn = np >> 8, cl = np & 255, bj = cl >> 7, wc = (cl >> 5) & 3, w = cl & 31;
    if (pn < 2) return OFF_Q + (4 * pn + wc) * 64 + 32 * bj + w;
    if (pn < 4) return OFF_K + (4 * (pn - 2) + wc) * 64 + 32 * bj + w;
    if (pn < 8) return np;
    if (pn < 10) return OFF_IQ + (4 * (pn - 8) + wc) * 64 + 32 * bj + w;
    if (wc == 0) return OFF_IK + 32 * bj + w;
    if (wc == 1 && bj == 0 && w < 8) return OFF_IW + w;
    return -1;
}
template <bool WINPERM>
__device__ __forceinline__ void transpose_tile(const Frame& F, LAS float* tile, const float* W, int ldw, int N, bf16_t* Wt, int ldt, const float* kscale, int k0, int n0) {
    const int lane = F.lane, kk = lane >> 4, n4 = (lane & 15) * 4;
    int src = n0 + n4; bool ok = src < N;
    if (WINPERM) { src = win_src_col(n0 + n4); ok = src >= 0; }
    f32x4 v[16];
#pragma unroll
    for (int p = 0; p < 16; ++p) { v[p] = (f32x4){0.f, 0.f, 0.f, 0.f}; if (ok) v[p] = *(const f32x4*)(W + (size_t)(k0 + 4 * p + kk) * ldw + src); }
#pragma unroll
    for (int p = 0; p < 16; ++p) { const float s = kscale ? kscale[k0 + 4 * p + kk] : 1.f;
#pragma unroll
        for (int i = 0; i < 4; ++i) tile[(4 * p + kk) * 65 + n4 + i] = v[p][i] * s; }
#pragma unroll
    for (int k8 = 0; k8 < 8; ++k8) { float x[8];
#pragma unroll
        for (int i = 0; i < 8; ++i) x[i] = tile[(8 * k8 + i) * 65 + lane];
        u32x4 w; w.x = cvt_pk_bf16(x[0], x[1]); w.y = cvt_pk_bf16(x[2], x[3]); w.z = cvt_pk_bf16(x[4], x[5]); w.w = cvt_pk_bf16(x[6], x[7]);
        *(u32x4*)(Wt + (size_t)(n0 + lane) * ldt + k0 + 8 * k8) = w; }
}

__device__ __forceinline__ void p0_prologue(const Frame& F) {
    const int gtid = F.bid * NTHR + F.tid, gsz = F.G * NTHR, lane = F.lane;
    const int gw = F.bid * 8 + F.wave, nw = F.G * 8;
    for (int u = gw; u < MPAD / 4; u += nw) {
        f32x4 v[4][4]; float ss[4];
#pragma unroll
        for (int r = 0; r < 4; ++r) { const int row = 4 * u + r;
            const float* src = row < MREAL ? F.x + (size_t)row * 1024 : F.meta + (size_t)(row < MROWS ? row - MREAL : 0) * 1024;
#pragma unroll
            for (int i = 0; i < 4; ++i) v[r][i] = *(const f32x4*)(src + 256 * i + 4 * lane); }
        f32x4 g[4];
#pragma unroll
        for (int i = 0; i < 4; ++i) g[i] = *(const f32x4*)(F.g1 + 256 * i + 4 * lane);
#pragma unroll
        for (int r = 0; r < 4; ++r) { float s = 0.f;
#pragma unroll
            for (int i = 0; i < 4; ++i) s += v[r][i][0] * v[r][i][0] + v[r][i][1] * v[r][i][1] + v[r][i][2] * v[r][i][2] + v[r][i][3] * v[r][i][3];
            ss[r] = s; }
#pragma unroll
        for (int o = 32; o > 0; o >>= 1) {
#pragma unroll
            for (int r = 0; r < 4; ++r) ss[r] += __shfl_xor(ss[r], o); }
#pragma unroll
        for (int r = 0; r < 4; ++r) { const int row = 4 * u + r; const float rs = row < MROWS ? rsqrtf(ss[r] * (1.f / 1024.f) + RMS_EPS) : 0.f;
            bf16_t* dst = F.XN() + (size_t)row * 1024;
#pragma unroll
            for (int i = 0; i < 4; ++i) { u32x2 w; w.x = cvt_pk_bf16(v[r][i][0] * rs * g[i][0], v[r][i][1] * rs * g[i][1]); w.y = cvt_pk_bf16(v[r][i][2] * rs * g[i][2], v[r][i][3] * rs * g[i][3]);
                *(u32x2*)(dst + 256 * i + 4 * lane) = w; } }
    }
    { LAS float* tile = (LAS float*)F.lds + F.wave * (64 * 65);
      for (int t = gw; t < 704 + 256 + 512; t += nw) {
          if (t < 704) transpose_tile<true>(F, tile, F.w_in, NZ, NZ, F.WIN(), 1024, nullptr, (t & 15) * 64, (t >> 4) * 64);
          else if (t < 960) { const int q = t - 704, kt = q & 15;
              if (kt < 8) transpose_tile<false>(F, tile, F.w_out, 1024, 1024, F.WOUT(), 1024, nullptr, kt * 64, (q >> 4) * 64);
              else transpose_tile<false>(F, tile, F.w_out + (size_t)512 * 1024, 1024, 1024, F.TW(), 512, nullptr, (kt - 8) * 64, (q >> 4) * 64); }
          else { const int q = t - 960; transpose_tile<false>(F, tile, F.wq, 2048, 2048, F.WQ(), 1024, F.g2, (q & 15) * 64, (q >> 4) * 64); } } }
    for (int idx = gtid; idx < 2 * 128 * 128; idx += gsz) F.SK()[idx] = f2bf(idx < 16384 ? F.sk1[idx] : F.sk2[idx - 16384]);
    for (int idx = gtid; idx < MREAL; idx += gsz) F.SUMSQ()[idx] = 0.f;
}

struct EpiIn {
    static constexpr bool PERM = true, AFTER_DRAIN = false;
    bf16_t *Q, *K, *VV, *QI, *KI, *UP; float* WI; const float *gq, *gk;
    __device__ __forceinline__ static u32x4 pk8(const f32x4 a, const f32x4 b) { u32x4 w; w.x = cvt_pk_bf16(a[0], a[1]); w.y = cvt_pk_bf16(a[2], a[3]); w.z = cvt_pk_bf16(b[0], b[1]); w.w = cvt_pk_bf16(b[2], b[3]); return w; }
    __device__ __forceinline__ void operator()(const f32x4 (&acc)[2][2][4][2], const pg8::Unit& u, int wr, int wc, int fr, int fq) const {
        const int pn = u.pn;
        const int kind = pn < 2 ? 0 : pn < 4 ? 1 : pn < 6 ? 2 : pn < 8 ? 3 : pn < 10 ? 4 : 5;
        const bool headk = (kind <= 1) || kind == 4 || (kind == 5 && wc == 0);
        const float* gp = (kind == 1 ? gk : gq) + 8 * fq;
        const int head = 4 * (pn & 1) + wc;
        float frq[2][4];
#pragma unroll
        for (int n = 0; n < 2; ++n)
#pragma unroll
            for (int i = 0; i < 4; ++i) frq[n][i] = __builtin_amdgcn_exp2f(-(float)(8 * fq + 4 * n + i) * 0.41524101186092029f) * 0.15915494309189535f;
#pragma unroll
        for (int ai = 0; ai < 2; ++ai)
#pragma unroll
            for (int m = 0; m < 4; ++m) {
                int row_ = u.pm * 256 + ai * 128 + wr * 64 + m * 16 + fr; asm volatile("" : "+v"(row_));
                const int row = row_;
                const bool real = row < MREAL, valid = row < MROWS;
                const int b = real ? row >> 11 : 0, pos = real ? (row & 2047) + NMETA : (valid ? row - MREAL : 0);
                f32x4 v[2][2];
#pragma unroll
                for (int bj = 0; bj < 2; ++bj)
#pragma unroll
                    for (int n = 0; n < 2; ++n) v[bj][n] = acc[ai][bj][m][n];
                if (kind <= 1) {
                    float ss = 0.f;
#pragma unroll
                    for (int bj = 0; bj < 2; ++bj)
#pragma unroll
                        for (int n = 0; n < 2; ++n) ss += v[bj][n][0] * v[bj][n][0] + v[bj][n][1] * v[bj][n][1] + v[bj][n][2] * v[bj][n][2] + v[bj][n][3] * v[bj][n][3];
                    ss += __shfl_xor(ss, 16); ss += __shfl_xor(ss, 32);
                    const float rs = rsqrtf(ss * (1.f / 64.f) + RMS_EPS);
#pragma unroll
                    for (int bj = 0; bj < 2; ++bj)
#pragma unroll
                        for (int n = 0; n < 2; ++n) v[bj][n] = v[bj][n] * (kind == 0 ? rs * (0.125f * LOG2E) : rs) * *(const f32x4*)(gp + 32 * bj + 4 * n);
                }
                if (headk) {
                    const float fpos = (float)pos;
#pragma unroll
                    for (int n = 0; n < 2; ++n) { f32x4 cs, sn;
#pragma unroll
                        for (int i = 0; i < 4; ++i) { const float rev = __builtin_amdgcn_fractf(fpos * frq[n][i]); cs[i] = __builtin_amdgcn_cosf(rev); sn[i] = __builtin_amdgcn_sinf(rev); }
                        const f32x4 x1 = v[0][n], x2 = v[1][n];
                        v[0][n] = x1 * cs - x2 * sn; v[1][n] = x2 * cs + x1 * sn; }
                }
                if (kind == 0 || kind == 4) { if (real) { bf16_t* d = (kind ? QI : Q) + (size_t)row * 512 + head * 64 + 8 * fq;
#pragma unroll
                        for (int bj = 0; bj < 2; ++bj) *(u32x4*)(d + 32 * bj) = pk8(v[bj][0], v[bj][1]); } }
                else if (kind == 1 || kind == 2) { if (valid) { const int col = (kind == 1 ? head * 64 : (pn - 4) * 256 + 32 * wc) + 8 * fq; const int cstep = kind == 1 ? 32 : 128; bf16_t* base = kind == 1 ? K : VV;
                        const int nrep = real ? 1 : NB;
                        for (int rb = 0; rb < nrep; ++rb) { bf16_t* d = base + (size_t)((real ? b : rb) * TT + pos) * 512 + col;
#pragma unroll
                            for (int bj = 0; bj < 2; ++bj) *(u32x4*)(d + cstep * bj) = pk8(v[bj][0], v[bj][1]); } } }
                else if (kind == 3) { if (valid) { bf16_t* d = UP + (size_t)row * 512 + (pn - 6) * 256 + 32 * wc + 8 * fq;
#pragma unroll
                        for (int bj = 0; bj < 2; ++bj) *(u32x4*)(d + 128 * bj) = pk8(v[bj][0], v[bj][1]); } }
                else {
                    if (wc == 0) { if (valid) { const int nrep = real ? 1 : NB;
                            for (int rb = 0; rb < nrep; ++rb) { bf16_t* d = KI + (size_t)((real ? b : rb) * TT + pos) * 64 + 8 * fq;
#pragma unroll
                                for (int bj = 0; bj < 2; ++bj) *(u32x4*)(d + 32 * bj) = pk8(v[bj][0], v[bj][1]); } } }
                    else if (wc == 1 && fq == 0 && real) { *(f32x4*)(WI + (size_t)row * 8) = v[0][0] * 0.044194173824159216f; *(f32x4*)(WI + (size_t)row * 8 + 4) = v[0][1] * 0.044194173824159216f; }
                }
                asm volatile("" ::: "memory");
            }
    }
};
struct EpiOut {
    static constexpr bool PERM = false, AFTER_DRAIN = false;
    const float* X; float* out; bf16_t* H1B; float* sumsq;
    __device__ __forceinline__ void operator()(const f32x4 (&acc)[2][2][4][2], const pg8::Unit& u, int wr, int wc, int fr, int fq) const {
        const int row0 = u.pm * 256 + wr * 64 + fr, col0 = u.pn * 256 + wc * 32 + 4 * fq;
#pragma unroll
        for (int ai = 0; ai < 2; ++ai)
#pragma unroll
            for (int m = 0; m < 4; ++m) { const int row = row0 + ai * 128 + m * 16; const size_t off = (size_t)row * 1024 + col0; float ss = 0.f;
#pragma unroll
                for (int bj = 0; bj < 2; ++bj)
#pragma unroll
                    for (int n = 0; n < 2; ++n) { const f32x4 xv = *(const f32x4*)(X + off + bj * 128 + n * 16); const f32x4 h = xv + acc[ai][bj][m][n];
                        u32x2 w; w.x = cvt_pk_bf16(h[0], h[1]); w.y = cvt_pk_bf16(h[2], h[3]); *(u32x2*)(H1B + off + bj * 128 + n * 16) = w;
                        ss += h[0] * h[0] + h[1] * h[1] + h[2] * h[2] + h[3] * h[3]; }
                ss += __shfl_xor(ss, 16); ss += __shfl_xor(ss, 32);
                if (fq == 0) atomicAdd(sumsq + row, ss); }
    }
};
struct EpiQP {
    static constexpr bool PERM = true, AFTER_DRAIN = false;
    bf16_t* O; const float* sumsq;
    __device__ __forceinline__ void operator()(const f32x4 (&acc)[2][2][4][2], const pg8::Unit& u, int wr, int wc, int fr, int fq) const {
        const int row0 = u.pm * 256 + wr * 64 + fr, col0 = u.pn * 256 + wc * 32 + 8 * fq;
#pragma unroll
        for (int ai = 0; ai < 2; ++ai)
#pragma unroll
            for (int m = 0; m < 4; ++m) { const int row = row0 + ai * 128 + m * 16; bf16_t* rowp = O + (size_t)row * 2048 + col0;
                const float rs = rsqrtf(sumsq[row] * (1.f / 1024.f) + RMS_EPS);
#pragma unroll
                for (int bj = 0; bj < 2; ++bj) { const f32x4 v0 = acc[ai][bj][m][0] * rs, v1 = acc[ai][bj][m][1] * rs;
                    u32x4 w; w.x = cvt_pk_bf16(v0[0], v0[1]); w.y = cvt_pk_bf16(v0[2], v0[3]); w.z = cvt_pk_bf16(v1[0], v1[1]); w.w = cvt_pk_bf16(v1[2], v1[3]);
                    *(u32x4*)(rowp + bj * 128) = w; } }
    }
};

__device__ __forceinline__ int zrow_of(int b, int pos) { return pos < NMETA ? MREAL + pos : b * SEQ + pos - NMETA; }

__device__ __forceinline__ bf16_t f2bf_c(float f) { unsigned u = __float_as_uint(f); u += 0x7FFFu + ((u >> 16) & 1u); return (bf16_t)(u >> 16); }
__device__ __forceinline__ void p2_weff(const Frame& F) {
    const int lane = fresh((int)threadIdx.x) & 63, hk = lane >> 5, l31 = lane & 31;
    for (int t = F.bid * 8 + F.wave; t < 512; t += F.G * 8) {
        const int n0 = (t & 31) * 32, gc0 = (t >> 5) * 32, g = gc0 >> 7;
        f32x16 acc = {};
        const bf16_t* ap = F.TW() + (size_t)(n0 + l31) * 512 + g * 128 + 8 * hk;
        const float* bp = F.pool_w + (size_t)(gc0 + l31) * 128 + 8 * hk; const float* sp = F.pool_scale + g * 128 + 8 * hk;
#pragma unroll
        for (int ks = 0; ks < 8; ++ks) {
            const bf16x8 a = *(const bf16x8*)(ap + 16 * ks);
            const f32x4 w0 = *(const f32x4*)(bp + 16 * ks) * *(const f32x4*)(sp + 16 * ks), w1 = *(const f32x4*)(bp + 16 * ks + 4) * *(const f32x4*)(sp + 16 * ks + 4);
            u32x4 bw; bw.x = cvt_pk_bf16(w0[0], w0[1]); bw.y = cvt_pk_bf16(w0[2], w0[3]); bw.z = cvt_pk_bf16(w1[0], w1[1]); bw.w = cvt_pk_bf16(w1[2], w1[3]);
            acc = MFMA32(a, __builtin_bit_cast(bf16x8, bw), acc); }
#pragma unroll
        for (int r = 0; r < 16; ++r) F.WOUT()[(size_t)(n0 + (r & 3) + 8 * (r >> 2) + 4 * hk) * 1024 + 512 + gc0 + l31] = f2bf_c(acc[r]);
    }
}
__device__ __forceinline__ void p2_pool(const Frame& F) {
    const int lane = fresh((int)threadIdx.x) & 63, g = lane >> 4, w = 2 << g;
    const float iw = 1.f / (float)w;
    for (int row0 = (F.bid * 8 + F.wave) * 2; row0 < MREAL; row0 += F.G * 8 * 2) {
        u32x4 x[2][16];
#pragma unroll
        for (int r = 0; r < 2; ++r) { const int row = row0 + r, b = row >> 11, pos = (row & 2047) + NMETA;
#pragma unroll
            for (int ii = 0; ii < 16; ++ii) { x[r][ii] = (u32x4){0u, 0u, 0u, 0u};
                if (ii < w) x[r][ii] = *(const u32x4*)(F.UP() + (size_t)zrow_of(b, pos - ii) * 512 + 8 * lane); } }
#pragma unroll
        for (int r = 0; r < 2; ++r) { float sum[8];
#pragma unroll
            for (int i = 0; i < 8; ++i) sum[i] = 0.f;
#pragma unroll
            for (int ii = 0; ii < 16; ++ii) { const u32x4 v = x[r][ii];
                sum[0] += bflo(v.x); sum[1] += bfhi(v.x); sum[2] += bflo(v.y); sum[3] += bfhi(v.y); sum[4] += bflo(v.z); sum[5] += bfhi(v.z); sum[6] += bflo(v.w); sum[7] += bfhi(v.w); }
            const u32x4 v0 = x[r][0];
            u32x4 o; o.x = cvt_pk_bf16(sum[0] * iw - bflo(v0.x), sum[1] * iw - bfhi(v0.x)); o.y = cvt_pk_bf16(sum[2] * iw - bflo(v0.y), sum[3] * iw - bfhi(v0.y));
            o.z = cvt_pk_bf16(sum[4] * iw - bflo(v0.z), sum[5] * iw - bfhi(v0.z)); o.w = cvt_pk_bf16(sum[6] * iw - bflo(v0.w), sum[7] * iw - bfhi(v0.w));
            *(u32x4*)(F.MIX() + (size_t)(row0 + r) * 1024 + 512 + 8 * lane) = o; }
    }
}

__device__ __forceinline__ void indexer_item(const Frame& F, const int b, const int qt32) {
    constexpr int NTB = 65;
    const int lane = fresh((int)threadIdx.x) & 63, tid = (int)threadIdx.x, wv = F.wave, hk = lane >> 5, l31 = lane & 31;
    const int c = qt32 >> 1, nvis = 80 + 64 * c, ntile = 3 + 2 * c, nsteps = (ntile + 3) >> 2;
    const int qrow0 = b * SEQ + qt32 * 32 + 4 * wv;
    constexpr int NST = (NTB + 3) / 4;
    const int blk = l31 >> 3, hf = (l31 >> 2) & 1, e = l31 & 3;
    const int ql = 2 * hf + (blk >> 1), head = 4 * (blk & 1) + e;
    bf16x8 af[4];
    { const bf16_t* qip = F.QI() + (size_t)(qrow0 + ql) * 512 + head * 64 + 8 * hk;
#pragma unroll
      for (int ks = 0; ks < 4; ++ks) af[ks] = *(const bf16x8*)(qip + 16 * ks); }
    float wreg[16];
#pragma unroll
    for (int r = 0; r < 16; ++r) wreg[r] = F.WI()[(size_t)(qrow0 + 2 * hk + (r >> 3)) * 8 + (r & 7)];
    const int st_key = tid >> 3, st_c8 = tid & 7;
    const unsigned st_off = st_key * 128 + ((st_c8 ^ (st_key & 7)) * 16);
    const bf16_t* kisrc = F.KI() + (size_t)(b * TT) * 64 + st_c8 * 8;
    u32x4 sa, sb;
    { int k0 = st_key, k1 = 64 + st_key; sa = *(const u32x4*)(kisrc + (size_t)k0 * 64); sb = *(const u32x4*)(kisrc + (size_t)k1 * 64); }
    *(LAS u32x4*)(F.lds + st_off) = sa; *(LAS u32x4*)(F.lds + 8192 + st_off) = sb;
    if (nsteps > 1) { int k0 = 128 + st_key, k1 = 192 + st_key; k0 = k0 < TT ? k0 : TT - 1; k1 = k1 < TT ? k1 : TT - 1; sa = *(const u32x4*)(kisrc + (size_t)k0 * 64); sb = *(const u32x4*)(kisrc + (size_t)k1 * 64); }
    __syncthreads();
    unsigned comp[2][NTB];
#pragma unroll
    for (int st = 0; st < NST; ++st) {
        if (st < nsteps) {
            const int buf = st & 1;
            u32x4 na = sa, nb = sb;
            if (st + 2 < nsteps) { int k0 = 128 * (st + 2) + st_key, k1 = k0 + 64; k0 = k0 < TT ? k0 : TT - 1; k1 = k1 < TT ? k1 : TT - 1; na = *(const u32x4*)(kisrc + (size_t)k0 * 64); nb = *(const u32x4*)(kisrc + (size_t)k1 * 64); }
#pragma unroll
            for (int tl = 0; tl < 4; ++tl) { constexpr int dummy = 0; (void)dummy; const int j = 4 * st + tl;
                if (j < NTB) {
                    unsigned c0 = 0u, c1 = 0u;
                    if (j < ntile) {
                        LAS const unsigned char* kb = F.lds + buf * 16384 + (32 * tl + l31) * 128;
                        f32x16 acc = {};
#pragma unroll
                        for (int ks = 0; ks < 4; ++ks) { const bf16x8 bfr = *(LAS const bf16x8*)(kb + (((2 * ks + hk) ^ (l31 & 7)) * 16)); acc = MFMA32(af[ks], bfr, acc); }
                        float s0 = 0.f, s1 = 0.f;
#pragma unroll
                        for (int r = 0; r < 8; ++r) { s0 += wreg[r] * fmaxf(acc[r], 0.f); s1 += wreg[r + 8] * fmaxf(acc[r + 8], 0.f); }
                        const int key = 32 * j + l31;
                        if (key < nvis) { unsigned u0 = __float_as_uint(s0), u1 = __float_as_uint(s1); if (u0 == 0x80000000u) u0 = 0u; if (u1 == 0x80000000u) u1 = 0u;
                            c0 = ((u0 ^ ((u0 >> 31) ? 0xFFFFFFFFu : 0x80000000u)) & ~0xFFFu) | (unsigned)(4095 - key);
                            c1 = ((u1 ^ ((u1 >> 31) ? 0xFFFFFFFFu : 0x80000000u)) & ~0xFFFu) | (unsigned)(4095 - key); }
                    }
                    comp[0][j] = c0; comp[1][j] = c1;
                    __builtin_amdgcn_sched_barrier(0);
                } }
            if (st + 1 < nsteps) { *(LAS u32x4*)(F.lds + (buf ^ 1) * 16384 + st_off) = sa; *(LAS u32x4*)(F.lds + (buf ^ 1) * 16384 + 8192 + st_off) = sb; }
            sa = na; sb = nb;
            __syncthreads();
        } else {
#pragma unroll
            for (int tl = 0; tl < 4; ++tl) { const int j = 4 * st + tl; if (j < NTB) { comp[0][j] = 0u; comp[1][j] = 0u; } }
        }
    }
    unsigned tA0 = 1u, tA1 = 1u, tB0 = 1u, tB1 = 1u;
    if (nvis > 256) { tA0 = tA1 = tB0 = tB1 = 0u; bool dA0 = false, dA1 = false, dB0 = false, dB1 = false;
#pragma unroll 1
        for (int bit = 31; bit >= 0; --bit) {
            const unsigned m = 1u << bit;
            const unsigned cand0 = (hk ? tB0 : tA0) | m, cand1 = (hk ? tB1 : tA1) | m;
            int p0 = 0, p1 = 0;
#define IDX_CNT(LO, HI) _Pragma("unroll") for (int j = (LO); j < (HI); ++j) { p0 += (comp[0][j] >= cand0) ? 1 : 0; p1 += (comp[1][j] >= cand1) ? 1 : 0; }
            IDX_CNT(0, 17)
            if (ntile > 17) { IDX_CNT(17, 33) if (ntile > 33) { IDX_CNT(33, 49) if (ntile > 49) { IDX_CNT(49, 65) } } }
#undef IDX_CNT
            p0 += __builtin_amdgcn_update_dpp(0, p0, 0xB1, 0xF, 0xF, false); p1 += __builtin_amdgcn_update_dpp(0, p1, 0xB1, 0xF, 0xF, false);
            p0 += __builtin_amdgcn_update_dpp(0, p0, 0x4E, 0xF, 0xF, false); p1 += __builtin_amdgcn_update_dpp(0, p1, 0x4E, 0xF, 0xF, false);
            p0 += __builtin_amdgcn_update_dpp(0, p0, 0x141, 0xF, 0xF, false); p1 += __builtin_amdgcn_update_dpp(0, p1, 0x141, 0xF, 0xF, false);
            p0 += __builtin_amdgcn_update_dpp(0, p0, 0x140, 0xF, 0xF, false); p1 += __builtin_amdgcn_update_dpp(0, p1, 0x140, 0xF, 0xF, false);
            const int cA0 = __builtin_amdgcn_readlane(p0, 0) + __builtin_amdgcn_readlane(p0, 16), cB0 = __builtin_amdgcn_readlane(p0, 32) + __builtin_amdgcn_readlane(p0, 48);
            const int cA1 = __builtin_amdgcn_readlane(p1, 0) + __builtin_amdgcn_readlane(p1, 16), cB1 = __builtin_amdgcn_readlane(p1, 32) + __builtin_amdgcn_readlane(p1, 48);
            if (!dA0 && cA0 >= 256) { tA0 |= m; dA0 = (cA0 == 256); }
            if (!dA1 && cA1 >= 256) { tA1 |= m; dA1 = (cA1 == 256); }
            if (!dB0 && cB0 >= 256) { tB0 |= m; dB0 = (cB0 == 256); }
            if (!dB1 && cB1 >= 256) { tB1 |= m; dB1 = (cB1 == 256); }
            if (dA0 && dA1 && dB0 && dB1) break; } }
    const unsigned t0 = hk ? tB0 : tA0, t1 = hk ? tB1 : tA1;
    int mq[4] = {0, 0, 0, 0};
    unsigned w64[4] = {0u, 0u, 0u, 0u};
#pragma unroll
    for (int j = 0; j < NTB; ++j) { const unsigned long long m0 = __ballot(comp[0][j] >= t0), m1 = __ballot(comp[1][j] >= t1);
        if (j < 64) {
            asm volatile("v_writelane_b32 %0, %2, %4\n\tv_writelane_b32 %1, %3, %4" : "+v"(mq[0]), "+v"(mq[2]) : "s"((int)(unsigned)m0), "s"((int)(unsigned)(m0 >> 32)), "i"(j < 64 ? j : 0));
            asm volatile("v_writelane_b32 %0, %2, %4\n\tv_writelane_b32 %1, %3, %4" : "+v"(mq[1]), "+v"(mq[3]) : "s"((int)(unsigned)m1), "s"((int)(unsigned)(m1 >> 32)), "i"(j < 64 ? j : 0));
        } else { w64[0] = (unsigned)m0; w64[2] = (unsigned)(m0 >> 32); w64[1] = (unsigned)m1; w64[3] = (unsigned)(m1 >> 32); } }
#pragma unroll
    for (int q = 0; q < 4; ++q) { unsigned* mrow = F.MASK() + (size_t)(qrow0 + q) * MASKW;
        if (lane <= ntile && lane < 64) mrow[lane] = lane < ntile ? (unsigned)mq[q] : 0u;
        if (NTB > 64 && ntile > 64 && lane == 0) { mrow[64] = w64[q]; mrow[65] = 0u; } }
    __syncthreads();
}

__device__ __forceinline__ void p3_indexer(const Frame& F) {
    for (int it = F.bid; it < 512; it += F.G) {
        const int half = it >> 8, ii = half ? 511 - (it & 255) : it;
        indexer_item(F, ii & 7, 63 - (ii >> 3));
    }
}

typedef short v4i16_t __attribute__((ext_vector_type(4)));
__device__ __forceinline__ s16x4 vtr(LAS const unsigned char* p) { return __builtin_bit_cast(s16x4, __builtin_amdgcn_ds_read_tr16_b64_v4i16((LAS v4i16_t*)p)); }

__device__ __forceinline__ void p4_attention(const Frame& F) {
    const int lane = fresh((int)threadIdx.x) & 63, wv = F.wave, tid = (int)threadIdx.x, hk = lane >> 5, l31 = lane & 31;
    float gb; { float a = fabsf(F.gq[lane]), bq = fabsf(F.gk[lane]);
#pragma unroll
        for (int o = 32; o > 0; o >>= 1) { a = fmaxf(a, __shfl_xor(a, o)); bq = fmaxf(bq, __shfl_xor(bq, o)); }
        gb = a * bq; }
    const float NMB = -8.f * gb * 1.02f * LOG2E;
    const int st_which = tid >> 8, st_r = (tid & 255) >> 3, st_c8 = tid & 7;
    const unsigned st_off = st_which ? (16384u + st_r * 128 + st_c8 * 16) : (st_r * 128 + ((st_c8 ^ (st_r & 7)) * 16));
    for (int it = F.bid; it < 512; it += F.G) {
        const int pr = it & 255, half = it >> 8, cp = pr & 3, bh = pr >> 2, b = bh >> 3, h = bh & 7, c4 = half ? 7 - cp : cp;
        const int qrow = b * SEQ + 256 * c4 + 32 * wv + l31;
        const int cch = 4 * c4 + (wv >> 1), nt = 2 + cch, ntmax = 2 + (4 * c4 + 3);
        bf16x8 qf[4];
#pragma unroll
        for (int ks = 0; ks < 4; ++ks) qf[ks] = *(const bf16x8*)(F.Q() + (size_t)qrow * 512 + h * 64 + 16 * ks + 8 * hk);
        const bf16_t* stsrc = (st_which ? F.VV() : F.K()) + (size_t)(b * TT) * 512 + h * 64 + st_c8 * 8;
        f32x16 o0 = {}, o1 = {}; float lsum = 0.f;
        u32x4 sa = *(const u32x4*)(stsrc + (size_t)st_r * 512), sb = *(const u32x4*)(stsrc + (size_t)(32 + st_r) * 512);
        u32x2 mw = *(const u32x2*)(F.MASK() + (size_t)qrow * MASKW);
        *(LAS u32x4*)(F.lds + st_off) = sa; *(LAS u32x4*)(F.lds + 4096 + st_off) = sb;
        sa = *(const u32x4*)(stsrc + (size_t)(64 + st_r) * 512); sb = *(const u32x4*)(stsrc + (size_t)(96 + st_r) * 512);
        __syncthreads();
        for (int j = 0; j < ntmax; ++j) {
            const int buf = j & 1;
            u32x2 mw_next = {0u, 0u}; u32x4 na = sa, nb = sb;
            if (j + 2 < ntmax) { int k0 = 64 * (j + 2) + st_r, k1 = k0 + 32; k0 = k0 < TT ? k0 : TT - 1; k1 = k1 < TT ? k1 : TT - 1;
                na = *(const u32x4*)(stsrc + (size_t)k0 * 512); nb = *(const u32x4*)(stsrc + (size_t)k1 * 512); }
            if (j + 1 < nt) mw_next = *(const u32x2*)(F.MASK() + (size_t)qrow * MASKW + 2 * (j + 1));
            if (j < nt) {
                LAS const unsigned char* kb = F.lds + buf * 8192; LAS const unsigned char* vb = F.lds + 16384 + buf * 8192;
                f32x16 s[2];
#pragma unroll
                for (int hh = 0; hh < 2; ++hh)
#pragma unroll
                    for (int r = 0; r < 16; ++r) s[hh][r] = NMB;
#pragma unroll
                for (int ks = 0; ks < 4; ++ks)
#pragma unroll
                    for (int hh = 0; hh < 2; ++hh) { const bf16x8 kf = *(LAS const bf16x8*)(kb + (32 * hh + l31) * 128 + (((2 * ks + hk) ^ (l31 & 7)) * 16)); s[hh] = MFMA32(kf, qf[ks], s[hh]); }
                bf16x8 pf[2][2];
#pragma unroll
                for (int hh = 0; hh < 2; ++hh) {
                    const unsigned w2 = (hh ? mw.y : mw.x) >> (4 * hk);
                    float p[16];
#pragma unroll
                    for (int r = 0; r < 16; ++r) { p[r] = __uint_as_float(__float_as_uint(__builtin_amdgcn_exp2f(s[hh][r])) & (unsigned)__builtin_amdgcn_sbfe((int)w2, (r & 3) + 8 * (r >> 2), 1)); lsum += p[r]; }
#pragma unroll
                    for (int s2 = 0; s2 < 2; ++s2) { u32x4 w; w.x = cvt_pk_bf16(p[8 * s2 + 0], p[8 * s2 + 1]); w.y = cvt_pk_bf16(p[8 * s2 + 2], p[8 * s2 + 3]);
                        w.z = cvt_pk_bf16(p[8 * s2 + 4], p[8 * s2 + 5]); w.w = cvt_pk_bf16(p[8 * s2 + 6], p[8 * s2 + 7]); pf[hh][s2] = __builtin_bit_cast(bf16x8, w); }
                }
                const int i16 = lane & 15, g1 = (lane >> 4) & 1;
#pragma unroll
                for (int hh = 0; hh < 2; ++hh) {
                    LAS const unsigned char* vp = vb + (32 * hh + 4 * hk + (i16 >> 2)) * 128 + (16 * g1 + 4 * (i16 & 3)) * 2;
#pragma unroll
                    for (int s2 = 0; s2 < 2; ++s2) {
                        { const s16x4 lo = vtr(vp + (16 * s2) * 128), hi = vtr(vp + (16 * s2 + 8) * 128);
                          const bf16x8 vf = {lo[0], lo[1], lo[2], lo[3], hi[0], hi[1], hi[2], hi[3]}; o0 = MFMA32(vf, pf[hh][s2], o0); }
                        { const s16x4 lo = vtr(vp + (16 * s2) * 128 + 64), hi = vtr(vp + (16 * s2 + 8) * 128 + 64);
                          const bf16x8 vf = {lo[0], lo[1], lo[2], lo[3], hi[0], hi[1], hi[2], hi[3]}; o1 = MFMA32(vf, pf[hh][s2], o1); }
                    }
                }
            }
            if (j + 1 < ntmax) { *(LAS u32x4*)(F.lds + (buf ^ 1) * 8192 + st_off) = sa; *(LAS u32x4*)(F.lds + (buf ^ 1) * 8192 + 4096 + st_off) = sb; }
            mw = mw_next; sa = na; sb = nb;
            __syncthreads();
        }
        lsum += __shfl_xor(lsum, 32);
        const float inv = 1.f / lsum;
        bf16_t* dst = F.MIX() + (size_t)qrow * 1024 + h * 64 + 4 * hk;
#pragma unroll
        for (int g = 0; g < 4; ++g) {
            u32x2 w; w.x = cvt_pk_bf16(o0[4 * g] * inv, o0[4 * g + 1] * inv); w.y = cvt_pk_bf16(o0[4 * g + 2] * inv, o0[4 * g + 3] * inv); *(u32x2*)(dst + 8 * g) = w;
            u32x2 w1; w1.x = cvt_pk_bf16(o1[4 * g] * inv, o1[4 * g + 1] * inv); w1.y = cvt_pk_bf16(o1[4 * g + 2] * inv, o1[4 * g + 3] * inv); *(u32x2*)(dst + 32 + 8 * g) = w1; }
    }
}

template <int N> __device__ __forceinline__ void bitonic_sort_desc(float (&a)[N]) {
#pragma unroll
    for (int k = 2; k <= N; k <<= 1)
#pragma unroll
        for (int j = k >> 1; j > 0; j >>= 1)
#pragma unroll
            for (int i = 0; i < N; ++i) { const int l = i ^ j; if (l > i) { const bool desc = ((i & k) == 0) || (k == N); const float x = a[i], y = a[l];
                const float mx = fmaxf(x, y), mn = fminf(x, y); a[i] = desc ? mx : mn; a[l] = desc ? mn : mx; } }
}
__device__ __forceinline__ void merge_top16(float (&a)[16], const float (&b)[16]) {
#pragma unroll
    for (int i = 0; i < 16; ++i) a[i] = fmaxf(a[i], b[15 - i]);
#pragma unroll
    for (int j = 8; j > 0; j >>= 1)
#pragma unroll
        for (int i = 0; i < 16; ++i) { const int l = i ^ j; if (l > i) { const float x = a[i], y = a[l]; a[i] = fmaxf(x, y); a[l] = fminf(x, y); } }
}
__device__ __forceinline__ void cex(float& x, int& px, float& y, int& py) { const bool sw = y > x; const float tx = sw ? y : x, ty = sw ? x : y; const int tp = sw ? py : px, tq = sw ? px : py; x = tx; y = ty; px = tp; py = tq; }

__host__ __device__ constexpr int cand_cnt(int i) { return 16 / (i + 1); }
__host__ __device__ constexpr int cand_off(int i) { int s = 0; for (int k = 0; k < i; ++k) s += cand_cnt(k); return s; }
static_assert(cand_off(16) == 50, "candidates");
template <int N> __device__ __forceinline__ void bitonic_sort_desc_kv(float (&a)[N], int (&p)[N]) {
#pragma unroll
    for (int k = 2; k <= N; k <<= 1)
#pragma unroll
        for (int j = k >> 1; j > 0; j >>= 1)
#pragma unroll
            for (int i = 0; i < N; ++i) { const int l = i ^ j; if (l > i) { const bool desc = ((i & k) == 0) || (k == N);
                if (desc) cex(a[i], p[i], a[l], p[l]); else cex(a[l], p[l], a[i], p[i]); } }
}
__device__ __forceinline__ void merge_top16_kv(float (&a)[16], int (&pa)[16], const float (&b)[16], const int (&pb)[16]) {
#pragma unroll
    for (int i = 0; i < 16; ++i) { const bool sw = b[15 - i] > a[i]; a[i] = sw ? b[15 - i] : a[i]; pa[i] = sw ? pb[15 - i] : pa[i]; }
#pragma unroll
    for (int j = 8; j > 0; j >>= 1)
#pragma unroll
        for (int i = 0; i < 16; ++i) { const int l = i ^ j; if (l > i) cex(a[i], pa[i], a[l], pa[l]); }
}
__device__ __forceinline__ void sub_top16(const Frame& F, LAS const unsigned char* skl, const bf16_t* qrow, float (&top)[16]) {
    const int lane = F.lane, hk = lane >> 5, l31 = lane & 31;
    bf16x8 bq[8];
#pragma unroll
    for (int ks = 0; ks < 8; ++ks) bq[ks] = *(const bf16x8*)(qrow + 16 * ks + 8 * hk);
#pragma unroll
    for (int mt = 0; mt < 4; ++mt) {
        f32x16 acc = {};
        const int key = 32 * mt + l31;
#pragma unroll
        for (int ks = 0; ks < 8; ++ks) { const bf16x8 a = *(LAS const bf16x8*)(skl + key * 256 + (((2 * ks + hk) ^ (key & 15)) * 16)); acc = MFMA32(a, bq[ks], acc); }
        float cur[16];
#pragma unroll
        for (int r = 0; r < 16; ++r) { const unsigned kidx = (unsigned)(32 * mt + (r & 3) + 8 * (r >> 2) + 4 * hk); cur[r] = __uint_as_float((__float_as_uint(acc[r]) & ~127u) | kidx); }
        bitonic_sort_desc<16>(cur);
        if (mt == 0) {
#pragma unroll
            for (int i = 0; i < 16; ++i) top[i] = cur[i]; }
        else merge_top16(top, cur);
        __builtin_amdgcn_sched_barrier(0);
    }
    float oth[16];
#pragma unroll
    for (int i = 0; i < 16; ++i) oth[i] = __shfl_xor(top[i], 32);
    merge_top16(top, oth);
}

__host__ __device__ constexpr int p1_units() { return (MPAD / 256) * (NZP / 256); }
__host__ __device__ __forceinline__ int p1_first_idle(int G) { const int maxu = (p1_units() + G - 1) / G; return p1_units() - (maxu - 1) * G; }
__host__ __device__ __forceinline__ int tables_rows_p1(int G) { const int r = (G - p1_first_idle(G)) * 8 * 24; return r < 2 * NEXP ? r : 2 * NEXP; }
__device__ __forceinline__ void p7b_tables(const Frame& F, const int widx, const int nworkers, const int rbeg, const int rend) {
    const int lane = fresh((int)threadIdx.x) & 63;
    f32x4 g[4];
#pragma unroll
    for (int i = 0; i < 4; ++i) g[i] = *(const f32x4*)(F.g2 + 16 * lane + 4 * i);
#pragma unroll 1
    for (int r0 = rbeg + widx * 8; r0 < rend; r0 += nworkers * 8) {
        const bool isv = r0 >= NEXP; const int e0 = isv ? r0 - NEXP : r0;
        const float* src = (isv ? F.pv : F.pu) + (size_t)e0 * 1024 + 16 * lane;
        f32x4 v[8][4]; float mx[8];
#pragma unroll
        for (int r = 0; r < 8; ++r)
#pragma unroll
            for (int i = 0; i < 4; ++i) v[r][i] = *(const f32x4*)(src + (size_t)r * 1024 + 4 * i);
#pragma unroll
        for (int r = 0; r < 8; ++r) { float m = 0.f;
#pragma unroll
            for (int i = 0; i < 4; ++i) { if (!isv) v[r][i] = v[r][i] * g[i];
                m = fmaxf(m, fmaxf(fmaxf(fabsf(v[r][i][0]), fabsf(v[r][i][1])), fmaxf(fabsf(v[r][i][2]), fabsf(v[r][i][3])))); }
            mx[r] = m; }
#pragma unroll
        for (int o = 32; o > 0; o >>= 1) {
#pragma unroll
            for (int r = 0; r < 8; ++r) mx[r] = fmaxf(mx[r], __shfl_xor(mx[r], o)); }
        unsigned char* dst = (isv ? F.V8() : F.U8()) + (size_t)(lane >> 3) * (NEXP * 128) + 16 * (lane & 7);
#pragma unroll
        for (int r = 0; r < 8; ++r) { const float sc = mx[r] > 0.f ? mx[r] * (1.f / 440.f) : 1.f, inv = 1.f / sc;
            u32x4 w;
#pragma unroll
            for (int i = 0; i < 4; ++i) { int p = __builtin_amdgcn_cvt_pk_fp8_f32(v[r][i][0] * inv, v[r][i][1] * inv, 0, false); p = __builtin_amdgcn_cvt_pk_fp8_f32(v[r][i][2] * inv, v[r][i][3] * inv, p, true); w[i] = (unsigned)p; }
            *(u32x4*)(dst + (size_t)(e0 + r) * 128) = w;
            if (lane == 0) (isv ? F.SV() : F.SU())[e0 + r] = sc; }
    }
}

__device__ __forceinline__ void p7_routing(const Frame& F) {
    const int lane = F.lane, hk = lane >> 5, l31 = lane & 31;
    for (int idx = F.tid; idx < 2 * 128 * 16; idx += NTHR) { const int tb = idx >> 11, key = (idx >> 4) & 127, c16 = idx & 15;
        const u32x4 v = *(const u32x4*)(F.SK() + (size_t)tb * 16384 + key * 128 + c16 * 8);
        *(LAS u32x4*)(F.lds + tb * 32768 + key * 256 + ((c16 ^ (key & 15)) * 16)) = v; }
    LAS unsigned* ctab = (LAS unsigned*)(F.lds + 131072);
    if (F.tid < 50) { int n = F.tid, i = 0; while (n >= cand_cnt(i)) { n -= cand_cnt(i); ++i; } ctab[F.tid] = (unsigned)((i << 4) | n); }
    LAS float* lt = (LAS float*)(F.lds + 65536) + F.wave * 2048;
    __syncthreads();
    constexpr int RW = 6;
    if (F.wave >= RW) { p7b_tables(F, F.bid * (8 - RW) + (F.wave - RW), F.G * (8 - RW), tables_rows_p1(F.G), 2 * NEXP); return; }
    pg8::StaticOrder S; S.init(MREAL, 2048, F.G, F.bid);
    for (int li = F.wave; ; li += RW) {
        pg8::Unit un; if (!S.next(li >> 3, un)) break;
        const int tt = un.pm * 8 + (li & 7), head = un.pn, tok = tt * 32 + l31;
        const bf16_t* qrow = F.QP() + (size_t)tok * 2048 + head * 256;
        float t1[16], t2[16];
        sub_top16(F, F.lds, qrow, t1);
        sub_top16(F, F.lds + 32768, qrow + 128, t2);
#pragma unroll
        for (int i = 0; i < 16; ++i) { lt[i * 64 + lane] = t1[i]; lt[(16 + i) * 64 + lane] = t2[i]; }
        float cv[4][16];
#pragma unroll
        for (int k = 50; k < 64; ++k) cv[k >> 4][k & 15] = -3.0e38f;
#pragma unroll
        for (int i = 0; i < 16; ++i)
#pragma unroll
            for (int j = 0; j < 16; ++j) if ((i + 1) * (j + 1) <= 16) {
                const int n = cand_off(i) + j;
                const float sum = __uint_as_float(__float_as_uint(t1[i]) & ~127u) + __uint_as_float(__float_as_uint(t2[j]) & ~127u);
                cv[n >> 4][n & 15] = __uint_as_float((__float_as_uint(sum) & ~63u) | (unsigned)n); }
#pragma unroll
        for (int g = 0; g < 4; ++g) bitonic_sort_desc<16>(cv[g]);
        merge_top16(cv[0], cv[1]); merge_top16(cv[2], cv[3]); merge_top16(cv[0], cv[2]);
        float sv[16]; int ev[16];
#pragma unroll
        for (int k = 0; k < 16; ++k) { const unsigned ij = ctab[__float_as_uint(cv[0][k]) & 63u];
            const unsigned a = __float_as_uint(lt[(ij >> 4) * 64 + lane]), bb = __float_as_uint(lt[(16 + (ij & 15)) * 64 + lane]);
            sv[k] = __uint_as_float(a & ~127u) + __uint_as_float(bb & ~127u); ev[k] = (int)(((a & 127u) << 7) | (bb & 127u)); }
        float mx = sv[0];
#pragma unroll
        for (int k = 1; k < 16; ++k) mx = fmaxf(mx, sv[k]);
        float ge[16], gs = 0.f;
#pragma unroll
        for (int k = 0; k < 16; ++k) { ge[k] = __expf(sv[k] - mx); gs += ge[k]; }
        const float ginv = 1.f / gs;
        if (hk == 0) {
            int* ed = F.EID() + (size_t)tok * 128 + head * 16; float* gd = F.GATE() + (size_t)tok * 128 + head * 16;
#pragma unroll
            for (int k = 0; k < 16; k += 4) { *(int4*)(ed + k) = make_int4(ev[k], ev[k + 1], ev[k + 2], ev[k + 3]);
                *(f32x4*)(gd + k) = (f32x4){ge[k] * ginv, ge[k + 1] * ginv, ge[k + 2] * ginv, ge[k + 3] * ginv}; }
        }
    }
}

typedef float f32x2 __attribute__((ext_vector_type(2)));
#define XQ_WORD(pass, s) (4096 + 64 * (8 * (pass) + (s)))
#define XQ_TOK 32
#define XQ_CHUNKS (MREAL / (8 * XQ_TOK))
__device__ __forceinline__ int next_item(const Frame& F, unsigned* ctl, int qpass, int cur) {
    volatile LAS int* slot = (volatile LAS int*)(F.lds + LDS_BYTES - 32);
    __syncthreads();
    if (F.tid == 0) { int res = -1;
        for (int d = 0; d < 8; ++d) { const int s = (cur + d) & 7; unsigned* c = ctl + XQ_WORD(qpass, s);
            if (__hip_atomic_load(c, __ATOMIC_RELAXED, __HIP_MEMORY_SCOPE_AGENT) >= (unsigned)XQ_CHUNKS) continue;
            const unsigned idx = __hip_atomic_fetch_add(c, 1u, __ATOMIC_RELAXED, __HIP_MEMORY_SCOPE_AGENT);
            if (idx < (unsigned)XQ_CHUNKS) { res = (s << 16) | (int)idx; break; } }
        *slot = res; }
    __syncthreads();
    return *slot;
}
#define P8_LOAD8(R, EV, BASE, OFF) _Pragma("unroll") for (int ii = 0; ii < 8; ++ii) { const int e_ = __shfl((EV), 8 * ii + xg); R[ii] = *(const u32x4*)((BASE) + ((unsigned)e_ * 128u + (OFF))); }
#define P8U_DOT8(R, P0) _Pragma("unroll") for (int ii = 0; ii < 8; ++ii) { f32x2 sacc = {0.f, 0.f};                                 \
        _Pragma("unroll") for (int q = 0; q < 4; ++q) { sacc += hv2[2 * q] * __builtin_amdgcn_cvt_pk_f32_fp8((int)R[ii][q], false); sacc += hv2[2 * q + 1] * __builtin_amdgcn_cvt_pk_f32_fp8((int)R[ii][q], true); } \
        p[(P0) + ii] = sacc[0] + sacc[1]; }
template <int QPASS>
__device__ __forceinline__ void p8u_sliced(const Frame& F) {
    unsigned* ctl = (unsigned*)(F.ws + WS_CTL);
    int cur = (int)(xb_xcc_id() & 7u);
    for (;;) { const int itm = next_item(F, ctl, QPASS, cur); if (itm < 0) break;
        const int s = itm >> 16, chunk = itm & 0xffff; cur = s;
        const int lane = fresh((int)threadIdx.x) & 63, xg = lane >> 3, ch = lane & 7;
        const int t0 = chunk * (8 * XQ_TOK) + F.wave * XQ_TOK;
        const unsigned char* ubase = F.U8() + (size_t)s * (NEXP * 128);
        const unsigned uoff = 16u * ch;
        const bool b2 = lane & 4, b1 = lane & 2, b0 = lane & 1;
        const int kout = 64 * (b2 ? 1 : 0) + 32 * (b1 ? 1 : 0) + 16 * (b0 ? 1 : 0) + xg;
        float* part = F.PART() + (size_t)s * ((size_t)MREAL * 128);
        int e_lo = F.EID()[(unsigned)(t0 * 128 + lane)], e_hi = F.EID()[(unsigned)(t0 * 128 + 64 + lane)];
        int n_lo = F.EID()[(unsigned)((t0 + 1) * 128 + lane)], n_hi = F.EID()[(unsigned)((t0 + 1) * 128 + 64 + lane)];
        u32x4 ha = *(const u32x4*)(F.H1B() + (unsigned)(t0 * 1024 + 128 * s + 16 * ch)), hb = *(const u32x4*)(F.H1B() + (unsigned)(t0 * 1024 + 128 * s + 16 * ch + 8));
        u32x4 rA[8], rB[8];
        P8_LOAD8(rA, e_lo, ubase, uoff)
#pragma unroll 1
        for (int i = 0; i < XQ_TOK; ++i) {
            const int t = t0 + i, tn = t0 + (i < XQ_TOK - 1 ? i + 1 : XQ_TOK - 1), tnn = t0 + (i < XQ_TOK - 2 ? i + 2 : XQ_TOK - 1);
            const int nn_lo = F.EID()[(unsigned)(tnn * 128 + lane)], nn_hi = F.EID()[(unsigned)(tnn * 128 + 64 + lane)];
            const u32x4 nha = *(const u32x4*)(F.H1B() + (unsigned)(tn * 1024 + 128 * s + 16 * ch)), nhb = *(const u32x4*)(F.H1B() + (unsigned)(tn * 1024 + 128 * s + 16 * ch + 8));
            f32x2 hv2[8];
            hv2[0] = (f32x2){bflo(ha.x), bfhi(ha.x)}; hv2[1] = (f32x2){bflo(ha.y), bfhi(ha.y)}; hv2[2] = (f32x2){bflo(ha.z), bfhi(ha.z)}; hv2[3] = (f32x2){bflo(ha.w), bfhi(ha.w)};
            hv2[4] = (f32x2){bflo(hb.x), bfhi(hb.x)}; hv2[5] = (f32x2){bflo(hb.y), bfhi(hb.y)}; hv2[6] = (f32x2){bflo(hb.z), bfhi(hb.z)}; hv2[7] = (f32x2){bflo(hb.w), bfhi(hb.w)};
            float p[16];
            P8_LOAD8(rB, e_hi, ubase, uoff)
            __builtin_amdgcn_sched_barrier(0);
            P8U_DOT8(rA, 0)
            __builtin_amdgcn_sched_barrier(0);
            P8_LOAD8(rA, n_lo, ubase, uoff)
            __builtin_amdgcn_sched_barrier(0);
            P8U_DOT8(rB, 8)
            float r8[8], r4[4], r2[2];
#pragma unroll
            for (int q = 0; q < 8; ++q) { const float mine = b2 ? p[q + 8] : p[q], theirs = b2 ? p[q] : p[q + 8]; r8[q] = mine + __shfl_xor(theirs, 4); }
#pragma unroll
            for (int q = 0; q < 4; ++q) { const float mine = b1 ? r8[q + 4] : r8[q], theirs = b1 ? r8[q] : r8[q + 4]; r4[q] = mine + __shfl_xor(theirs, 2); }
#pragma unroll
            for (int q = 0; q < 2; ++q) { const float mine = b0 ? r4[q + 2] : r4[q], theirs = b0 ? r4[q] : r4[q + 2]; r2[q] = mine + __shfl_xor(theirs, 1); }
            part[(unsigned)(t * 128 + kout)] = r2[0]; part[(unsigned)(t * 128 + kout + 8)] = r2[1];
            e_lo = n_lo; e_hi = n_hi; n_lo = nn_lo; n_hi = nn_hi; ha = nha; hb = nhb;
            __builtin_amdgcn_sched_barrier(0);
        }
    }
}
__device__ __forceinline__ void p8c_combine(const Frame& F) {
    for (int idx = F.bid * NTHR + fresh((int)threadIdx.x); idx < MREAL * 128; idx += F.G * NTHR) {
        const int t = idx >> 7; const int e = F.EID()[idx];
        float sum = 0.f;
#pragma unroll
        for (int s = 0; s < 8; ++s) sum += F.PART()[(size_t)s * ((size_t)MREAL * 128) + idx];
        const float a = sum * F.SU()[e] * rsqrtf(F.SUMSQ()[t] * (1.f / 1024.f) + RMS_EPS);
        F.CB()[idx] = 0.5f * a * (1.f + erff(a * 0.70710678118654752f)) * F.GATE()[idx] * F.SV()[e];
    }
}
#define P8V_FMA8(R, C) _Pragma("unroll") for (int ii = 0; ii < 8; ++ii) { const f32x2 c2 = {C[ii], C[ii]};                            \
        _Pragma("unroll") for (int q = 0; q < 4; ++q) { acc2[2 * q] += c2 * __builtin_amdgcn_cvt_pk_f32_fp8((int)R[ii][q], false); acc2[2 * q + 1] += c2 * __builtin_amdgcn_cvt_pk_f32_fp8((int)R[ii][q], true); } }
#define P8V_COEF8(C, CV) _Pragma("unroll") for (int ii = 0; ii < 8; ++ii) C[ii] = __shfl((CV), 8 * ii + xg);
template <int QPASS>
__device__ __forceinline__ void p8v_experts(const Frame& F) {
    unsigned* ctl = (unsigned*)(F.ws + WS_CTL);
    int cur = (int)(xb_xcc_id() & 7u);
    for (;;) { const int itm = next_item(F, ctl, QPASS, cur); if (itm < 0) break;
        const int s = itm >> 16, chunk = itm & 0xffff; cur = s;
        const int lane = fresh((int)threadIdx.x) & 63, xg = lane >> 3, ch = lane & 7;
        const int t0 = chunk * (8 * XQ_TOK) + F.wave * XQ_TOK;
        const unsigned char* vbase = F.V8() + (size_t)s * (NEXP * 128);
        const unsigned voff = 16u * ch;
        const bool b5 = lane & 32, b4 = lane & 16, b3 = lane & 8;
        const int col = 128 * s + 16 * ch + (b5 ? 8 : 0) + (b4 ? 4 : 0) + (b3 ? 2 : 0);
        int e_lo = F.EID()[(unsigned)(t0 * 128 + lane)], e_hi = F.EID()[(unsigned)(t0 * 128 + 64 + lane)];
        int n_lo = F.EID()[(unsigned)((t0 + 1) * 128 + lane)], n_hi = F.EID()[(unsigned)((t0 + 1) * 128 + 64 + lane)];
        float c_lo = F.CB()[(unsigned)(t0 * 128 + lane)], c_hi = F.CB()[(unsigned)(t0 * 128 + 64 + lane)];
        u32x4 rA[8], rB[8];
        P8_LOAD8(rA, e_lo, vbase, voff)
#pragma unroll 1
        for (int i = 0; i < XQ_TOK; ++i) {
            const int t = t0 + i, tn = t0 + (i < XQ_TOK - 1 ? i + 1 : XQ_TOK - 1), tnn = t0 + (i < XQ_TOK - 2 ? i + 2 : XQ_TOK - 1);
            const int nn_lo = F.EID()[(unsigned)(tnn * 128 + lane)], nn_hi = F.EID()[(unsigned)(tnn * 128 + 64 + lane)];
            const float nc_lo = F.CB()[(unsigned)(tn * 128 + lane)], nc_hi = F.CB()[(unsigned)(tn * 128 + 64 + lane)];
            const unsigned h1w = *(const unsigned*)(F.H1B() + (unsigned)(t * 1024 + col)); const f32x2 h1 = {bflo(h1w), bfhi(h1w)};
            f32x2 acc2[8]; float cc[8];
#pragma unroll
            for (int q = 0; q < 8; ++q) acc2[q] = (f32x2){0.f, 0.f};
            P8_LOAD8(rB, e_hi, vbase, voff)
            P8V_COEF8(cc, c_lo)
            __builtin_amdgcn_sched_barrier(0);
            P8V_FMA8(rA, cc)
            __builtin_amdgcn_sched_barrier(0);
            P8_LOAD8(rA, n_lo, vbase, voff)
            P8V_COEF8(cc, c_hi)
            __builtin_amdgcn_sched_barrier(0);
            P8V_FMA8(rB, cc)
            __builtin_amdgcn_sched_barrier(0);
            float acc[16];
#pragma unroll
            for (int q = 0; q < 8; ++q) { acc[2 * q] = acc2[q][0]; acc[2 * q + 1] = acc2[q][1]; }
            float r8[8], r4[4], r2[2];
#pragma unroll
            for (int q = 0; q < 8; ++q) { const float mine = b5 ? acc[q + 8] : acc[q], theirs = b5 ? acc[q] : acc[q + 8]; r8[q] = mine + __shfl_xor(theirs, 32); }
#pragma unroll
            for (int q = 0; q < 4; ++q) { const float mine = b4 ? r8[q + 4] : r8[q], theirs = b4 ? r8[q] : r8[q + 4]; r4[q] = mine + __shfl_xor(theirs, 16); }
#pragma unroll
            for (int q = 0; q < 2; ++q) { const float mine = b3 ? r4[q + 2] : r4[q], theirs = b3 ? r4[q] : r4[q + 2]; r2[q] = mine + __shfl_xor(theirs, 8); }
            *(f32x2*)(F.out + (unsigned)(t * 1024 + col)) = (f32x2){h1[0] + r2[0], h1[1] + r2[1]};
            e_lo = n_lo; e_hi = n_hi; n_lo = nn_lo; n_hi = nn_hi; c_lo = nc_lo; c_hi = nc_hi;
            __builtin_amdgcn_sched_barrier(0);
        }
    }
}

constexpr int NPHASE = 10;
__global__ void __launch_bounds__(NTHR, 2) mk_fwd(Args args) {
    extern __shared__ __attribute__((aligned(16))) unsigned char lds_raw[];
    Frame F;
    F.lds = (LAS unsigned char*)lds_raw;
    F.tid = threadIdx.x; F.lane = F.tid & 63; F.wave = __builtin_amdgcn_readfirstlane(F.tid >> 6); F.G = gridDim.x; F.bid = blockIdx.x;
    F.x = args.in[0]; F.meta = args.in[1]; F.g1 = args.in[2]; F.w_in = args.in[3]; F.gq = args.in[4]; F.gk = args.in[5]; F.pool_w = args.in[6]; F.pool_scale = args.in[7];
    F.w_out = args.in[8]; F.g2 = args.in[9]; F.wq = args.in[10]; F.sk1 = args.in[11]; F.sk2 = args.in[12]; F.pu = args.in[13]; F.pv = args.in[14];
    F.out = args.out; F.ws = args.ws; unsigned char* ws = args.ws;
    const int lo = args.ph_lo, hi = args.ph_hi;
#ifndef PHASE_MASK
#define PHASE_MASK 0x3ff
#endif
#define IN(k) (((PHASE_MASK >> (k)) & 1) && lo <= (k) && (k) < hi)
    volatile LAS unsigned* bst = (volatile LAS unsigned*)(F.lds + LDS_BYTES - 16);
    if (F.tid == 0) { bst[0] = 0u; bst[1] = 0u; }
    __syncthreads();
    XcdBarrier bar = xcd_barrier_post((unsigned*)(ws + WS_CTL), bst);
#define GSYNC(k) do { if (IN(k) && IN((k) + 1)) xcd_barrier(bar); } while (0)
    if (IN(0)) { p0_prologue(F); }
    GSYNC(0);
    if (IN(1)) { { pg8::Gemm g{F.XN(), F.WIN(), MPAD, NZP, 1024}; pg8::StaticOrder S; S.init(MPAD, NZP, F.G, F.bid); EpiIn E{F.Q(), F.K(), F.VV(), F.QI(), F.KI(), F.UP(), F.WI(), F.gq, F.gk}; pg8::gemm_phase<EpiIn, pg8::StaticOrder>(F.lds, g, S, E);
        if (F.bid >= p1_first_idle(F.G)) p7b_tables(F, (F.bid - p1_first_idle(F.G)) * 8 + F.wave, (F.G - p1_first_idle(F.G)) * 8, 0, tables_rows_p1(F.G)); } }
    GSYNC(1);
    if (IN(3)) { p2_weff(F); p2_pool(F); p3_indexer(F); }
    GSYNC(3);
    if (IN(4)) { p4_attention(F); }
    GSYNC(4);
    if (IN(5)) { { pg8::Gemm g{F.MIX(), F.WOUT(), MREAL, 1024, 1024}; pg8::StaticOrder S; S.init(MREAL, 1024, F.G, F.bid); EpiOut E{F.x, F.out, F.H1B(), F.SUMSQ()}; pg8::gemm_phase<EpiOut, pg8::StaticOrder>(F.lds, g, S, E); } }
    GSYNC(5);
    if (IN(6)) { { pg8::Gemm g{F.H1B(), F.WQ(), MREAL, 2048, 1024}; pg8::StaticOrder S; S.init(MREAL, 2048, F.G, F.bid); EpiQP E{F.QP(), F.SUMSQ()}; pg8::gemm_phase<EpiQP, pg8::StaticOrder>(F.lds, g, S, E); } }
    if (IN(7)) { p7_routing(F); }
    GSYNC(7);
    if (IN(8)) { p8u_sliced<0>(F); xcd_barrier(bar); p8c_combine(F); }
    GSYNC(8);
    if (IN(9)) { p8v_experts<1>(F); }

#undef IN
#undef GSYNC
}
}

extern "C" void kernel_launch(void* const* d_in, const int* in_sizes, int n_in, void* d_out, int out_size, void* d_ws, size_t ws_size, hipStream_t stream) {
    static int grid = 0;
    if (grid == 0) {
        if (n_in != 15 || out_size != mk::MREAL * 1024 || ws_size < mk::WS_END) { fprintf(stderr, "kernel_launch: unexpected problem (n_in %d out %d ws %zu)\n", n_in, out_size, ws_size); grid = -1; return; }
        int dev = 0, cus = 0;
        if (hipGetDevice(&dev) != hipSuccess || hipDeviceGetAttribute(&cus, hipDeviceAttributeMultiprocessorCount, dev) != hipSuccess) { grid = -1; return; }
        if (hipFuncSetAttribute((const void*)mk::mk_fwd, hipFuncAttributeMaxDynamicSharedMemorySize, mk::LDS_BYTES) != hipSuccess) { fprintf(stderr, "kernel_launch: hipFuncSetAttribute failed\n"); grid = -1; return; }
        int per_cu = 0;
        if (hipOccupancyMaxActiveBlocksPerMultiprocessor(&per_cu, (const void*)mk::mk_fwd, mk::NTHR, mk::LDS_BYTES) != hipSuccess || per_cu < 1) { fprintf(stderr, "kernel_launch: occupancy query says %d\n", per_cu); grid = -1; return; }
        grid = cus;
    }
    if (grid < 0) return;
    if (hipMemsetAsync((char*)d_ws + mk::WS_CTL, 0, 32768, stream) != hipSuccess) { fprintf(stderr, "kernel_launch: memset failed\n"); return; }
    mk::Args a{};
    for (int i = 0; i < 15; ++i) a.in[i] = (const float*)d_in[i];
    a.out = (float*)d_out; a.ws = (unsigned char*)d_ws; a.ph_lo = 0; a.ph_hi = mk::NPHASE;
    void* kargs[] = {&a};
    hipError_t e = hipLaunchCooperativeKernel((const void*)mk::mk_fwd, dim3(grid), dim3(mk::NTHR), kargs, mk::LDS_BYTES, stream);
    if (e != hipSuccess) fprintf(stderr, "kernel_launch: cooperative launch failed: %s (grid %d)\n", hipGetErrorString(e), grid);

}
```

```cpp
#include <hip/hip_runtime.h>
#include <cstdio>
#include <cstdint>
namespace pg8 {
#define PG8_LAS __attribute__((address_space(3)))
typedef unsigned short bf16_t;
typedef short bf16x8 __attribute__((ext_vector_type(8)));
typedef float f32x4 __attribute__((ext_vector_type(4)));
typedef unsigned u32x4 __attribute__((ext_vector_type(4)));
constexpr int BM = 256, BK = 64, HALF = 128, HTB = HALF * BK * 2  , STAGE_BYTES = 8 * HTB, NXCD = 8, WGM = 8;

__host__ __device__ __forceinline__ int lds_byte(int r, int c) { const int st = (r >> 4) * 2 + (c >> 5), rr = r & 15, cc = c & 31, ob = rr * 64 + cc * 2; return st * 1024 + (ob ^ (((ob >> 9) & 1) << 5)); }
__host__ __device__ __forceinline__ void stage_rc(int b, int& R, int& C) { const int st = b / 1024, sb = b % 1024, swz = sb ^ (((sb >> 9) & 1) << 5); R = (st >> 1) * 16 + swz / 64; C = (st & 1) * 32 + (swz % 64) / 2; }
__host__ __device__ __forceinline__ int perm32(int rho) { const int n = rho >> 4, i = rho & 15; return 8 * (i >> 2) + 4 * n + (i & 3); }

struct Unit { int pm, pn; };
struct Gemm { const bf16_t* A; const bf16_t* Bt; int M, N, K; };
struct StaticOrder {
    int nM, nN, nwg, G, c;
    __host__ __device__ void init(int M, int N, int G_, int c_) { nM = M / BM; nN = N / BM; nwg = nM * nN; G = G_; c = c_; }
    __host__ __device__ bool next(int i, Unit& u) const {
        const long L = (long)i * G + c; if (L >= nwg) return false;
        int wgid = (int)L; { const int q = nwg / NXCD, r = nwg % NXCD, xcd = wgid % NXCD, off = wgid / NXCD; wgid = (xcd < r ? xcd * (q + 1) : r * (q + 1) + (xcd - r) * q) + off; }
        const int nig = WGM * nN, gid = wgid / nig, fm = gid * WGM, gsz = (nM - fm) < WGM ? (nM - fm) : WGM;
        u.pm = fm + ((wgid % nig) % gsz); u.pn = (wgid % nig) / gsz; return true;
    }
    __device__ __forceinline__ void a_ready(const Unit&) const {}
    __device__ __forceinline__ void done(const Unit&) const {}
};
__device__ __forceinline__ unsigned cvt_pk_bf16(float lo, float hi) { unsigned r; asm volatile("v_cvt_pk_bf16_f32 %0, %1, %2" : "=v"(r) : "v"(lo), "v"(hi)); return r; }
template <class Epi, class Sched>
__device__ __forceinline__ void gemm_phase(PG8_LAS unsigned char* lds, const Gemm g, const Sched& S, const Epi& E) {
    int tid_ = threadIdx.x; asm volatile("" : "+v"(tid_));
    const int tid = tid_, wid = __builtin_amdgcn_readfirstlane(tid >> 6), lane = tid & 63, wr = wid >> 2, wc = wid & 3, fr = lane & 15, fq = lane >> 4;
    const int K = g.K, nt = K / BK;
    unsigned voffA[2], voffB[2];
#pragma unroll
    for (int i = 0; i < 2; ++i) { int R, C; stage_rc(tid * 16 + i * 8192, R, C); const int Rb = Epi::PERM ? ((R & ~31) + perm32(R & 31)) : R;
        voffA[i] = (unsigned)(R * K + C) * 2u; voffB[i] = (unsigned)(Rb * K + C) * 2u; }
    const size_t kstep = (size_t)(BK * 2);
    const size_t hstep = (size_t)HALF * K * 2;
    const size_t tstep = 2 * hstep;
    const unsigned ldsw = (unsigned)wid * 1024u;
    const int aoff = lds_byte(wr * 64 + fr, fq * 8), boff = lds_byte(wc * 32 + fr, fq * 8);
#define PG8_SA(b, h) (((b) * 2 + (h)) * HTB)
#define PG8_SB(b, h) ((4 + (b) * 2 + (h)) * HTB)
#define PG8_STAGE(bufoff, gbase, voff) do { _Pragma("unroll") for (int _i = 0; _i < 2; ++_i) \
        __builtin_amdgcn_global_load_lds((const unsigned*)((const char*)(gbase) + (voff)[_i]), (PG8_LAS unsigned*)(lds + (bufoff) + ldsw + _i * 8192), 16, 0, 0); } while (0)
#define PG8_LDA(dst, b, h) do { _Pragma("unroll") for (int m = 0; m < 4; ++m) _Pragma("unroll") for (int k = 0; k < 2; ++k) dst[m][k] = *(const PG8_LAS bf16x8*)(lds + PG8_SA(b, h) + aoff + m * 2048 + k * 1024); } while (0)
#define PG8_LDB(dst, b, h) do { _Pragma("unroll") for (int n = 0; n < 2; ++n) _Pragma("unroll") for (int k = 0; k < 2; ++k) dst[n][k] = *(const PG8_LAS bf16x8*)(lds + PG8_SB(b, h) + boff + n * 2048 + k * 1024); } while (0)
#define PG8_MMA(ai, bj, At, Bt) do { __builtin_amdgcn_s_setprio(1); _Pragma("unroll") for (int m = 0; m < 4; ++m) _Pragma("unroll") for (int n = 0; n < 2; ++n) _Pragma("unroll") for (int k = 0; k < 2; ++k) \
        acc[ai][bj][m][n] = __builtin_amdgcn_mfma_f32_16x16x32_bf16(Bt[n][k], At[m][k], acc[ai][bj][m][n], 0, 0, 0); __builtin_amdgcn_s_setprio(0); } while (0)
#define PG8_WAIT_V(n) asm volatile("s_waitcnt vmcnt(" #n ")" ::: "memory")
#define PG8_WAIT_L(n) asm volatile("s_waitcnt lgkmcnt(" #n ")" ::: "memory")
#define PG8_BAR __builtin_amdgcn_s_barrier()
#define PG8_SCHED __builtin_amdgcn_sched_barrier(0)
    Unit cur, nxt; int ui = 0;
    if (!S.next(0, cur)) return;
    f32x4 acc[2][2][4][2];
#pragma unroll
    for (int a = 0; a < 2; ++a)
#pragma unroll
        for (int b = 0; b < 2; ++b)
#pragma unroll
            for (int m = 0; m < 4; ++m)
#pragma unroll
                for (int n = 0; n < 2; ++n) acc[a][b][m][n] = (f32x4){0.f, 0.f, 0.f, 0.f};
    bf16x8 At[4][2], B0[2][2], B1[2][2];
    const char* cA = (const char*)g.A + (size_t)cur.pm * tstep; const char* cB = (const char*)g.Bt + (size_t)cur.pn * tstep;
    S.a_ready(cur);
    PG8_STAGE(PG8_SB(0, 0), cB, voffB); PG8_STAGE(PG8_SA(0, 0), cA, voffA); PG8_STAGE(PG8_SB(0, 1), cB + hstep, voffB); PG8_STAGE(PG8_SA(0, 1), cA + hstep, voffA);
    if (wr == 1) PG8_BAR;
    PG8_WAIT_V(4); PG8_BAR;
    PG8_STAGE(PG8_SB(1, 0), cB + kstep, voffB); PG8_STAGE(PG8_SA(1, 0), cA + kstep, voffA); PG8_STAGE(PG8_SB(1, 1), cB + hstep + kstep, voffB);
    PG8_WAIT_V(6); PG8_BAR;
    for (;;) {
        const bool has_next = S.next(ui + 1, nxt);
        const char* nA = has_next ? (const char*)g.A + (size_t)nxt.pm * tstep : cA; const char* nB = has_next ? (const char*)g.Bt + (size_t)nxt.pn * tstep : cB;
        for (int t = 0; t < nt; t += 2) {
            const bool last = (t == nt - 2);
            const char* a1 = cA + (size_t)(t + 1) * kstep;
            const char* a2 = last ? nA : cA + (size_t)(t + 2) * kstep; const char* b2 = last ? nB : cB + (size_t)(t + 2) * kstep;
            const char* a3 = a2 + kstep; const char* b3 = b2 + kstep;
            if (last && has_next) S.a_ready(nxt);
            PG8_LDB(B0, 0, 0); PG8_SCHED; PG8_LDA(At, 0, 0); PG8_STAGE(PG8_SA(1, 1), a1 + hstep, voffA);
            PG8_WAIT_L(8); PG8_BAR; PG8_WAIT_L(0); PG8_MMA(0, 0, At, B0); PG8_BAR; PG8_SCHED;
            PG8_LDB(B1, 0, 1); PG8_STAGE(PG8_SB(0, 0), b2, voffB);
            PG8_BAR; PG8_WAIT_L(0); PG8_MMA(0, 1, At, B1); PG8_BAR;
            PG8_LDA(At, 0, 1); PG8_STAGE(PG8_SA(0, 0), a2, voffA);
            PG8_BAR; PG8_WAIT_L(0); PG8_MMA(1, 0, At, B0); PG8_BAR; PG8_SCHED;
            PG8_STAGE(PG8_SB(0, 1), b2 + hstep, voffB);
            PG8_WAIT_V(6); PG8_BAR; PG8_MMA(1, 1, At, B1); PG8_BAR;
            PG8_LDB(B0, 1, 0); PG8_SCHED; PG8_LDA(At, 1, 0); PG8_STAGE(PG8_SA(0, 1), a2 + hstep, voffA);
            PG8_WAIT_L(8); PG8_BAR; PG8_WAIT_L(0); PG8_MMA(0, 0, At, B0); PG8_BAR; PG8_SCHED;
            PG8_LDB(B1, 1, 1); PG8_STAGE(PG8_SB(1, 0), b3, voffB);
            PG8_BAR; PG8_WAIT_L(0); PG8_MMA(0, 1, At, B1); PG8_BAR;
            PG8_LDA(At, 1, 1); PG8_STAGE(PG8_SA(1, 0), a3, voffA);
            PG8_BAR; PG8_WAIT_L(0); PG8_MMA(1, 0, At, B0); PG8_BAR; PG8_SCHED;
            PG8_STAGE(PG8_SB(1, 1), b3 + hstep, voffB);
            PG8_WAIT_V(6); PG8_BAR; PG8_MMA(1, 1, At, B1); PG8_BAR;
        }
        if constexpr (!Epi::AFTER_DRAIN) { E(acc, cur, wr, wc, fr, fq); S.done(cur); }
        if (!has_next) break;
#pragma unroll
        for (int a = 0; a < 2; ++a)
#pragma unroll
            for (int b = 0; b < 2; ++b)
#pragma unroll
                for (int m = 0; m < 4; ++m)
#pragma unroll
                    for (int n = 0; n < 2; ++n) acc[a][b][m][n] = (f32x4){0.f, 0.f, 0.f, 0.f};
        cur = nxt; cA = nA; cB = nB; ++ui;
    }
    PG8_WAIT_V(0);
    if (wr == 0) PG8_BAR;
    PG8_BAR;
    if constexpr (Epi::AFTER_DRAIN) { E.fused(acc, cur, wr, wc, fr, fq, lds, wid, lane); S.done(cur); }
#undef PG8_SA
#undef PG8_SB
#undef PG8_STAGE
#undef PG8_LDA
#undef PG8_LDB
#undef PG8_MMA
#undef PG8_WAIT_V
#undef PG8_WAIT_L
#undef PG8_BAR
#undef PG8_SCHED
}
}
#define XB_TMO      128
#define XB_XCNT(j)  (256  + 64 * (j))
#define XB_XSUB(j)  (1280 + 64 * (j))
#define XB_XGEN(j)  (2304 + 64 * (j))
#define XB_TOP      3328
#define XB_TOPGEN   3392
#define XCD_BAR_WORDS 3456
#define XB_SPIN_CAP (1u << 18)

__device__ __forceinline__ unsigned xb_ld(unsigned* p)              { return __hip_atomic_load(p, __ATOMIC_RELAXED, __HIP_MEMORY_SCOPE_AGENT); }
__device__ __forceinline__ unsigned xb_add(unsigned* p, unsigned v) { return __hip_atomic_fetch_add(p, v, __ATOMIC_RELAXED, __HIP_MEMORY_SCOPE_AGENT); }
__device__ __forceinline__ unsigned xb_xcc_id() { return (unsigned)__builtin_amdgcn_s_getreg((3 << 11) | 20) & 0xFu; }
#define XB_SPIN(cond, bar) do { unsigned _sp = 0; while (cond) { __builtin_amdgcn_s_sleep(1); \
    if ((++_sp & 255u) == 0u) { if (xb_ld(&(bar)[XB_TMO])) break; if (_sp > XB_SPIN_CAP) { atomicAdd(&(bar)[XB_TMO], 1u); break; } } } } while (0)

struct XcdBarrier {
    unsigned* bar; unsigned x;
    volatile __attribute__((address_space(3))) unsigned* st;
};

__device__ __forceinline__ XcdBarrier xcd_barrier_post(unsigned* bar, volatile __attribute__((address_space(3))) unsigned* st) {
    XcdBarrier b; b.bar = bar; b.x = xb_xcc_id(); b.st = st;
    if (threadIdx.x == 0) (void)xb_add(&bar[XB_XCNT(b.x)], 1u);
    return b;
}
__device__ __forceinline__ void xcd_barrier_complete(unsigned* bar, unsigned x, unsigned& nloc, unsigned& nx) {
    const unsigned G = gridDim.x * gridDim.y * gridDim.z;
    unsigned sum, cnt, mine, sp = 0u;
    for (;;) {
        sum = 0u; cnt = 0u; mine = 0u;
#pragma unroll
        for (unsigned j = 0; j < 16; ++j) { const unsigned c = xb_ld(&bar[XB_XCNT(j)]); sum += c; cnt += (c > 0u) ? 1u : 0u; mine = (j == x) ? c : mine; }
        if (sum == G) break;
        __builtin_amdgcn_s_sleep(1);
        if ((++sp & 255u) == 0u) { if (xb_ld(&bar[XB_TMO])) break; if (sp > XB_SPIN_CAP) { atomicAdd(&bar[XB_TMO], 1u); break; } }
    }
    nloc = mine > 0u ? mine : 1u; nx = cnt > 0u ? cnt : 1u;
}

__device__ __forceinline__ void xcd_barrier(const XcdBarrier& b) {
    asm volatile("s_waitcnt vmcnt(0)" ::: "memory");
    __syncthreads();
    if (threadIdx.x == 0) {
        unsigned* bar = b.bar;
        __builtin_amdgcn_s_waitcnt(0);
        unsigned nloc = b.st[0], nx = b.st[1];
        if (nloc == 0u) { xcd_barrier_complete(bar, b.x, nloc, nx); b.st[0] = nloc; b.st[1] = nx; }
        const unsigned old = xb_add(&bar[XB_XSUB(b.x)], 1u);
        const unsigned gen = old / nloc;
        if (old + 1u == (gen + 1u) * nloc) {
            __builtin_amdgcn_fence(__ATOMIC_RELEASE, "agent");
            asm volatile("s_waitcnt vmcnt(0)" ::: "memory");
            const unsigned og = xb_add(&bar[XB_TOP], 1u);
            const unsigned tg = og / nx;
            if (og + 1u == (tg + 1u) * nx) xb_add(&bar[XB_TOPGEN], 1u);
            else XB_SPIN(xb_ld(&bar[XB_TOPGEN]) == tg, bar);
            __builtin_amdgcn_fence(__ATOMIC_ACQUIRE, "agent");
            xb_add(&bar[XB_XGEN(b.x)], 1u);
            asm volatile("s_waitcnt vmcnt(0)" ::: "memory");
        } else {
            XB_SPIN(xb_ld(&bar[XB_XGEN(b.x)]) == gen, bar);
            __builtin_amdgcn_fence(__ATOMIC_ACQUIRE, "agent");
            asm volatile("s_waitcnt vmcnt(0)" ::: "memory");
        }
    }
    __syncthreads();
}

namespace mk {
using pg8::bf16_t; using pg8::bf16x8; using pg8::f32x4; using pg8::u32x4; using pg8::cvt_pk_bf16;
typedef float f32x16 __attribute__((ext_vector_type(16)));
typedef unsigned u32x2 __attribute__((ext_vector_type(2)));
typedef short s16x4 __attribute__((ext_vector_type(4)));
#define LAS __attribute__((address_space(3)))
#define MFMA32(a, b, c) __builtin_amdgcn_mfma_f32_32x32x16_bf16((a), (b), (c), 0, 0, 0)

constexpr int DM = 1024, NB = 8, SEQ = 2048, TT = 2064, NMETA = 16;
constexpr int MREAL = NB * SEQ, MROWS = MREAL + NMETA, MPAD = 16640;
constexpr int NZ = 2632, NZP = 2816;
constexpr int OFF_Q = 0, OFF_K = 512, OFF_V = 1024, OFF_POOL = 1536, OFF_IQ = 2048, OFF_IK = 2560, OFF_IW = 2624;
constexpr int NEXP = 16384;
constexpr float RMS_EPS = 1e-6f, LOG2E = 1.4426950408889634f;
constexpr int NTHR = 512, LDS_BYTES = 163840;
constexpr int MASKW = 66;
constexpr int SCW = 2112;

constexpr size_t WS_CTL = 0;
constexpr size_t WS_SUMSQ = 65536;
constexpr size_t WS_WIN = WS_SUMSQ + 65536;
constexpr size_t WS_WOUT = WS_WIN + (size_t)NZP * 1024 * 2;
constexpr size_t WS_WQ = WS_WOUT + (size_t)1024 * 1024 * 2;
constexpr size_t WS_SK = WS_WQ + (size_t)2048 * 1024 * 2;
constexpr size_t WS_KI = WS_SK + 65536;
constexpr size_t WS_WI = WS_KI + (size_t)NB * TT * 64 * 2;
constexpr size_t WS_MASK = WS_WI + (size_t)MREAL * 8 * 4;
constexpr size_t WS_XN = WS_MASK + (size_t)MREAL * MASKW * 4;
constexpr size_t WS_MIX = WS_XN + (size_t)MPAD * 1024 * 2;
constexpr size_t WS_Q = WS_MIX + (size_t)MREAL * 1024 * 2;
constexpr size_t WS_K = WS_Q + (size_t)MREAL * 512 * 2;
constexpr size_t WS_VV = WS_K + (size_t)NB * TT * 512 * 2;
constexpr size_t WS_QI = WS_VV + (size_t)NB * TT * 512 * 2;
constexpr size_t WS_UP = WS_QI + (size_t)MREAL * 512 * 2;
constexpr size_t WS_U8 = WS_UP + (size_t)MROWS * 512 * 2;
constexpr size_t WS_SCL = WS_U8 + (size_t)NEXP * 1024;
constexpr size_t WS_C = WS_SCL + 131072;
constexpr size_t WS_V8 = WS_C + (size_t)MREAL * 128 * 4;
constexpr size_t WS_H1B = WS_V8 + (size_t)NEXP * 1024;
constexpr size_t WS_EID = WS_H1B + (size_t)MREAL * 1024 * 2;
constexpr size_t WS_TW = WS_EID + (size_t)MREAL * 128 * 8;
constexpr size_t WS_END = WS_TW + (size_t)1024 * 512 * 2;
constexpr size_t WS_QP = WS_Q;
static_assert(WS_END <= 268435456ull, "workspace");
static_assert((WS_MASK % 16) == 0 && (WS_XN % 256) == 0 && (WS_UP % 256) == 0 && (WS_K % 256) == 0 && (WS_U8 % 256) == 0, "align");
static_assert(WS_QP + (size_t)MREAL * 2048 * 2 <= WS_UP, "QP fits over Q..QI");
static_assert(WS_MIX == WS_XN + (size_t)MPAD * 1024 * 2 && WS_XN + (size_t)8 * MREAL * 128 * 4 <= WS_Q, "PART (f32 [8][16384][128]) fits over XN | MIX (dead after the input / output projections)");

struct Args { const float* in[15]; float* out; unsigned char* ws; int ph_lo, ph_hi; };

struct Frame {
    const float *x, *meta, *g1, *w_in, *gq, *gk, *pool_w, *pool_scale, *w_out, *g2, *wq, *sk1, *sk2, *pu, *pv;
    float* out; unsigned char* ws; LAS unsigned char* lds;
    int tid, lane, wave, G, bid;
#define WSPTR(name, type, off) __device__ __forceinline__ type* name() const { return (type*)(ws + (off)); }
    WSPTR(SUMSQ, float, WS_SUMSQ) WSPTR(WIN, bf16_t, WS_WIN) WSPTR(WOUT, bf16_t, WS_WOUT) WSPTR(WQ, bf16_t, WS_WQ) WSPTR(SK, bf16_t, WS_SK)
    WSPTR(KI, bf16_t, WS_KI) WSPTR(WI, float, WS_WI) WSPTR(MASK, unsigned, WS_MASK) WSPTR(XN, bf16_t, WS_XN) WSPTR(H1B, bf16_t, WS_H1B) WSPTR(MIX, bf16_t, WS_MIX)
    WSPTR(Q, bf16_t, WS_Q) WSPTR(K, bf16_t, WS_K) WSPTR(VV, bf16_t, WS_VV) WSPTR(QI, bf16_t, WS_QI) WSPTR(UP, bf16_t, WS_UP) WSPTR(QP, bf16_t, WS_QP)
    WSPTR(U8, unsigned char, WS_U8) WSPTR(V8, unsigned char, WS_V8) WSPTR(SU, float, WS_SCL) WSPTR(SV, float, WS_SCL + NEXP * 4)
    WSPTR(TW, bf16_t, WS_TW) WSPTR(PART, bf16_t  , WS_XN) WSPTR(EID, bf16_t  , WS_EID) WSPTR(GATE, float, WS_EID + (size_t)MREAL * 128 * 4) WSPTR(CB, bf16_t  , WS_C)
#undef WSPTR
};


__device__ __forceinline__ int fresh(int v) { asm volatile("" : "+v"(v)); return v; }
__device__ __forceinline__ bf16_t f2bf(float f) { return (bf16_t)(cvt_pk_bf16(f, 0.f) & 0xffffu); }
__device__ __forceinline__ float bf2f(bf16_t b) { return __uint_as_float(((unsigned)b) << 16); }
__device__ __forceinline__ float bflo(unsigned w) { return __uint_as_float(w << 16); }
__device__ __forceinline__ float bfhi(unsigned w) { return __uint_as_float(w & 0xffff0000u); }
__device__ __forceinline__ float wave_sum(float v) {
#pragma unroll
    for (int o = 32; o > 0; o >>= 1) v += __shfl_xor(v, o);
    return v; }
__device__ __forceinline__ float half_sum32(float v) {
#pragma unroll
    for (int o = 16; o > 0; o >>= 1) v += __shfl_xor(v, o);
    return v; }

__host__ __device__ __forceinline__ int win_src_col(int np) {
    const int pn = np >> 8, cl = np & 255, bj = cl >> 7, wc = (cl >> 5) & 3, w = cl & 31;
    if (pn < 2) return OFF_Q + (4 * pn + wc) * 64 + 32 * bj + w;
    if (pn < 4) return OFF_K + (4 * (pn - 2) + wc) * 64 + 32 * bj + w;
    if (pn < 8) return np;
    if (pn < 10) return OFF_IQ + (4 * (pn - 8) + wc) * 64 + 32 * bj + w;
    if (wc == 0) return OFF_IK + 32 * bj + w;
    if (wc == 1 && bj == 0 && w < 8) return OFF_IW + w;
    return -1;
}
template <bool WINPERM>
__device__ __forceinline__ void transpose_tile(const Frame& F, LAS float* tile, const float* W, int ldw, int N, bf16_t* Wt, int ldt, const float* kscale, int k0, int n0) {
    const int lane = F.lane, kk = lane >> 4, n4 = (lane & 15) * 4;
    int src = n0 + n4; bool ok = src < N;
    if (WINPERM) { src = win_src_col(n0 + n4); ok = src >= 0; }
    f32x4 v[16];
#pragma unroll
    for (int p = 0; p < 16; ++p) { v[p] = (f32x4){0.f, 0.f, 0.f, 0.f}; if (ok) v[p] = *(const f32x4*)(W + (size_t)(k0 + 4 * p + kk) * ldw + src); }
#pragma unroll
    for (int p = 0; p < 16; ++p) { const float s = kscale ? kscale[k0 + 4 * p + kk] : 1.f;
#pragma unroll
        for (int i = 0; i < 4; ++i) tile[(4 * p + kk) * 65 + n4 + i] = v[p][i] * s; }
#pragma unroll
    for (int k8 = 0; k8 < 8; ++k8) { float x[8];
#pragma unroll
        for (int i = 0; i < 8; ++i) x[i] = tile[(8 * k8 + i) * 65 + lane];
        u32x4 w; w.x = cvt_pk_bf16(x[0], x[1]); w.y = cvt_pk_bf16(x[2], x[3]); w.z = cvt_pk_bf16(x[4], x[5]); w.w = cvt_pk_bf16(x[6], x[7]);
        *(u32x4*)(Wt + (size_t)(n0 + lane) * ldt + k0 + 8 * k8) = w; }
}

__device__ __forceinline__ void p0_prologue(const Frame& F) {
    const int gtid = F.bid * NTHR + F.tid, gsz = F.G * NTHR, lane = F.lane;
    const int gw = F.bid * 8 + F.wave, nw = F.G * 8;
    for (int u = gw; u < MPAD / 4; u += nw) {
        f32x4 v[4][4]; float ss[4];
#pragma unroll
        for (int r = 0; r < 4; ++r) { const int row = 4 * u + r;
            const float* src = row < MREAL ? F.x + (size_t)row * 1024 : F.meta + (size_t)(row < MROWS ? row - MREAL : 0) * 1024;
#pragma unroll
            for (int i = 0; i < 4; ++i) v[r][i] = *(const f32x4*)(src + 256 * i + 4 * lane); }
        f32x4 g[4];
#pragma unroll
        for (int i = 0; i < 4; ++i) g[i] = *(const f32x4*)(F.g1 + 256 * i + 4 * lane);
#pragma unroll
        for (int r = 0; r < 4; ++r) { float s = 0.f;
#pragma unroll
            for (int i = 0; i < 4; ++i) s += v[r][i][0] * v[r][i][0] + v[r][i][1] * v[r][i][1] + v[r][i][2] * v[r][i][2] + v[r][i][3] * v[r][i][3];
            ss[r] = s; }
#pragma unroll
        for (int o = 32; o > 0; o >>= 1) {
#pragma unroll
            for (int r = 0; r < 4; ++r) ss[r] += __shfl_xor(ss[r], o); }
#pragma unroll
        for (int r = 0; r < 4; ++r) { const int row = 4 * u + r; const float rs = row < MROWS ? rsqrtf(ss[r] * (1.f / 1024.f) + RMS_EPS) : 0.f;
            bf16_t* dst = F.XN() + (size_t)row * 1024;
#pragma unroll
            for (int i = 0; i < 4; ++i) { u32x2 w; w.x = cvt_pk_bf16(v[r][i][0] * rs * g[i][0], v[r][i][1] * rs * g[i][1]); w.y = cvt_pk_bf16(v[r][i][2] * rs * g[i][2], v[r][i][3] * rs * g[i][3]);
                *(u32x2*)(dst + 256 * i + 4 * lane) = w; } }
    }
    { LAS float* tile = (LAS float*)F.lds + F.wave * (64 * 65);
      for (int t = gw; t < 704 + 256 + 512; t += nw) {
          if (t < 704) transpose_tile<true>(F, tile, F.w_in, NZ, NZ, F.WIN(), 1024, nullptr, (t & 15) * 64, (t >> 4) * 64);
          else if (t < 960) { const int q = t - 704, kt = q & 15;
              if (kt < 8) transpose_tile<false>(F, tile, F.w_out, 1024, 1024, F.WOUT(), 1024, nullptr, kt * 64, (q >> 4) * 64);
              else transpose_tile<false>(F, tile, F.w_out + (size_t)512 * 1024, 1024, 1024, F.TW(), 512, nullptr, (kt - 8) * 64, (q >> 4) * 64); }
          else { const int q = t - 960; transpose_tile<false>(F, tile, F.wq, 2048, 2048, F.WQ(), 1024, F.g2, (q & 15) * 64, (q >> 4) * 64); } } }
    for (int idx = gtid; idx < 2 * 128 * 128; idx += gsz) F.SK()[idx] = f2bf(idx < 16384 ? F.sk1[idx] : F.sk2[idx - 16384]);
    for (int idx = gtid; idx < MREAL; idx += gsz) F.SUMSQ()[idx] = 0.f;
}

struct EpiIn {
    static constexpr bool PERM = true, AFTER_DRAIN = false;
    bf16_t *Q, *K, *VV, *QI, *KI, *UP; float* WI; const float *gq, *gk;
    __device__ __forceinline__ static u32x4 pk8(const f32x4 a, const f32x4 b) { u32x4 w; w.x = cvt_pk_bf16(a[0], a[1]); w.y = cvt_pk_bf16(a[2], a[3]); w.z = cvt_pk_bf16(b[0], b[1]); w.w = cvt_pk_bf16(b[2], b[3]); return w; }
    __device__ __forceinline__ void operator()(const f32x4 (&acc)[2][2][4][2], const pg8::Unit& u, int wr, int wc, int fr, int fq) const {
        const int pn = u.pn;
        const int kind = pn < 2 ? 0 : pn < 4 ? 1 : pn < 6 ? 2 : pn < 8 ? 3 : pn < 10 ? 4 : 5;
        const bool headk = (kind <= 1) || kind == 4 || (kind == 5 && wc == 0);
        const float* gp = (kind == 1 ? gk : gq) + 8 * fq;
        const int head = 4 * (pn & 1) + wc;
        float frq[2][4];
#pragma unroll
        for (int n = 0; n < 2; ++n)
#pragma unroll
            for (int i = 0; i < 4; ++i) frq[n][i] = __builtin_amdgcn_exp2f(-(float)(8 * fq + 4 * n + i) * 0.41524101186092029f) * 0.15915494309189535f;
#pragma unroll
        for (int ai = 0; ai < 2; ++ai)
#pragma unroll
            for (int m = 0; m < 4; ++m) {
                int row_ = u.pm * 256 + ai * 128 + wr * 64 + m * 16 + fr; asm volatile("" : "+v"(row_));
                const int row = row_;
                const bool real = row < MREAL, valid = row < MROWS;
                const int b = real ? row >> 11 : 0, pos = real ? (row & 2047) + NMETA : (valid ? row - MREAL : 0);
                f32x4 v[2][2];
#pragma unroll
                for (int bj = 0; bj < 2; ++bj)
#pragma unroll
                    for (int n = 0; n < 2; ++n) v[bj][n] = acc[ai][bj][m][n];
                if (kind <= 1) {
                    float ss = 0.f;
#pragma unroll
                    for (int bj = 0; bj < 2; ++bj)
#pragma unroll
                        for (int n = 0; n < 2; ++n) ss += v[bj][n][0] * v[bj][n][0] + v[bj][n][1] * v[bj][n][1] + v[bj][n][2] * v[bj][n][2] + v[bj][n][3] * v[bj][n][3];
                    ss += __shfl_xor(ss, 16); ss += __shfl_xor(ss, 32);
                    const float rs = rsqrtf(ss * (1.f / 64.f) + RMS_EPS);
#pragma unroll
                    for (int bj = 0; bj < 2; ++bj)
#pragma unroll
                        for (int n = 0; n < 2; ++n) v[bj][n] = v[bj][n] * (kind == 0 ? rs * (0.125f * LOG2E) : rs) * *(const f32x4*)(gp + 32 * bj + 4 * n);
                }
                if (headk) {
                    const float fpos = (float)pos;
#pragma unroll
                    for (int n = 0; n < 2; ++n) { f32x4 cs, sn;
#pragma unroll
                        for (int i = 0; i < 4; ++i) { const float rev = __builtin_amdgcn_fractf(fpos * frq[n][i]); cs[i] = __builtin_amdgcn_cosf(rev); sn[i] = __builtin_amdgcn_sinf(rev); }
                        const f32x4 x1 = v[0][n], x2 = v[1][n];
                        v[0][n] = x1 * cs - x2 * sn; v[1][n] = x2 * cs + x1 * sn; }
                }
                if (kind == 0 || kind == 4) { if (real) { bf16_t* d = (kind ? QI : Q) + (size_t)row * 512 + head * 64 + 8 * fq;
#pragma unroll
                        for (int bj = 0; bj < 2; ++bj) *(u32x4*)(d + 32 * bj) = pk8(v[bj][0], v[bj][1]); } }
                else if (kind == 1 || kind == 2) { if (valid) { const int col = (kind == 1 ? head * 64 : (pn - 4) * 256 + 32 * wc) + 8 * fq; const int cstep = kind == 1 ? 32 : 128; bf16_t* base = kind == 1 ? K : VV;
                        const int nrep = real ? 1 : NB;
                        for (int rb = 0; rb < nrep; ++rb) { bf16_t* d = base + (size_t)((real ? b : rb) * TT + pos) * 512 + col;
#pragma unroll
                            for (int bj = 0; bj < 2; ++bj) *(u32x4*)(d + cstep * bj) = pk8(v[bj][0], v[bj][1]); } } }
                else if (kind == 3) { if (valid) { bf16_t* d = UP + (size_t)row * 512 + (pn - 6) * 256 + 32 * wc + 8 * fq;
#pragma unroll
                        for (int bj = 0; bj < 2; ++bj) *(u32x4*)(d + 128 * bj) = pk8(v[bj][0], v[bj][1]); } }
                else {
                    if (wc == 0) { if (valid) { const int nrep = real ? 1 : NB;
                            for (int rb = 0; rb < nrep; ++rb) { bf16_t* d = KI + (size_t)((real ? b : rb) * TT + pos) * 64 + 8 * fq;
#pragma unroll
                                for (int bj = 0; bj < 2; ++bj) *(u32x4*)(d + 32 * bj) = pk8(v[bj][0], v[bj][1]); } } }
                    else if (wc == 1 && fq == 0 && real) { *(f32x4*)(WI + (size_t)row * 8) = v[0][0] * 0.044194173824159216f; *(f32x4*)(WI + (size_t)row * 8 + 4) = v[0][1] * 0.044194173824159216f; }
                }
                asm volatile("" ::: "memory");
            }
    }
};
struct EpiOut {
    static constexpr bool PERM = false, AFTER_DRAIN = false;
    const float* X; float* out; bf16_t* H1B; float* sumsq;
    __device__ __forceinline__ void operator()(const f32x4 (&acc)[2][2][4][2], const pg8::Unit& u, int wr, int wc, int fr, int fq) const {
        const int row0 = u.pm * 256 + wr * 64 + fr, col0 = u.pn * 256 + wc * 32 + 4 * fq;
#pragma unroll
        for (int ai = 0; ai < 2; ++ai)
#pragma unroll
            for (int m = 0; m < 4; ++m) { const int row = row0 + ai * 128 + m * 16; const size_t off = (size_t)row * 1024 + col0; float ss = 0.f;
#pragma unroll
                for (int bj = 0; bj < 2; ++bj)
#pragma unroll
                    for (int n = 0; n < 2; ++n) { const f32x4 xv = *(const f32x4*)(X + off + bj * 128 + n * 16); const f32x4 h = xv + acc[ai][bj][m][n];
                        u32x2 w; w.x = cvt_pk_bf16(h[0], h[1]); w.y = cvt_pk_bf16(h[2], h[3]); *(u32x2*)(H1B + off + bj * 128 + n * 16) = w;
                        ss += h[0] * h[0] + h[1] * h[1] + h[2] * h[2] + h[3] * h[3]; }
                ss += __shfl_xor(ss, 16); ss += __shfl_xor(ss, 32);
                if (fq == 0) atomicAdd(sumsq + row, ss); }
    }
};
struct EpiQP {
    static constexpr bool PERM = true, AFTER_DRAIN = false;
    bf16_t* O; const float* sumsq;
    __device__ __forceinline__ void operator()(const f32x4 (&acc)[2][2][4][2], const pg8::Unit& u, int wr, int wc, int fr, int fq) const {
        const int row0 = u.pm * 256 + wr * 64 + fr, col0 = u.pn * 256 + wc * 32 + 8 * fq;
#pragma unroll
        for (int ai = 0; ai < 2; ++ai)
#pragma unroll
            for (int m = 0; m < 4; ++m) { const int row = row0 + ai * 128 + m * 16; bf16_t* rowp = O + (size_t)row * 2048 + col0;
                const float rs = rsqrtf(sumsq[row] * (1.f / 1024.f) + RMS_EPS);
#pragma unroll
                for (int bj = 0; bj < 2; ++bj) { const f32x4 v0 = acc[ai][bj][m][0] * rs, v1 = acc[ai][bj][m][1] * rs;
                    u32x4 w; w.x = cvt_pk_bf16(v0[0], v0[1]); w.y = cvt_pk_bf16(v0[2], v0[3]); w.z = cvt_pk_bf16(v1[0], v1[1]); w.w = cvt_pk_bf16(v1[2], v1[3]);
                    *(u32x4*)(rowp + bj * 128) = w; } }
    }
};

__device__ __forceinline__ int zrow_of(int b, int pos) { return pos < NMETA ? MREAL + pos : b * SEQ + pos - NMETA; }

__device__ __forceinline__ bf16_t f2bf_c(float f) { unsigned u = __float_as_uint(f); u += 0x7FFFu + ((u >> 16) & 1u); return (bf16_t)(u >> 16); }
__device__ __forceinline__ void p2_weff(const Frame& F) {
    const int lane = fresh((int)threadIdx.x) & 63, hk = lane >> 5, l31 = lane & 31;
    for (int t = F.bid * 8 + F.wave; t < 512; t += F.G * 8) {
        const int n0 = (t & 31) * 32, gc0 = (t >> 5) * 32, g = gc0 >> 7;
        f32x16 acc = {};
        const bf16_t* ap = F.TW() + (size_t)(n0 + l31) * 512 + g * 128 + 8 * hk;
        const float* bp = F.pool_w + (size_t)(gc0 + l31) * 128 + 8 * hk; const float* sp = F.pool_scale + g * 128 + 8 * hk;
#pragma unroll
        for (int ks = 0; ks < 8; ++ks) {
            const bf16x8 a = *(const bf16x8*)(ap + 16 * ks);
            const f32x4 w0 = *(const f32x4*)(bp + 16 * ks) * *(const f32x4*)(sp + 16 * ks), w1 = *(const f32x4*)(bp + 16 * ks + 4) * *(const f32x4*)(sp + 16 * ks + 4);
            u32x4 bw; bw.x = cvt_pk_bf16(w0[0], w0[1]); bw.y = cvt_pk_bf16(w0[2], w0[3]); bw.z = cvt_pk_bf16(w1[0], w1[1]); bw.w = cvt_pk_bf16(w1[2], w1[3]);
            acc = MFMA32(a, __builtin_bit_cast(bf16x8, bw), acc); }
#pragma unroll
        for (int r = 0; r < 16; ++r) F.WOUT()[(size_t)(n0 + (r & 3) + 8 * (r >> 2) + 4 * hk) * 1024 + 512 + gc0 + l31] = f2bf_c(acc[r]);
    }
}
__device__ __forceinline__ void p2_pool(const Frame& F) {
    const int lane = fresh((int)threadIdx.x) & 63, g = lane >> 4, w = 2 << g;
    const float iw = 1.f / (float)w;
    for (int row0 = (F.bid * 8 + F.wave) * 2; row0 < MREAL; row0 += F.G * 8 * 2) {
        u32x4 x[2][16];
#pragma unroll
        for (int r = 0; r < 2; ++r) { const int row = row0 + r, b = row >> 11, pos = (row & 2047) + NMETA;
#pragma unroll
            for (int ii = 0; ii < 16; ++ii) { x[r][ii] = (u32x4){0u, 0u, 0u, 0u};
                if (ii < w) x[r][ii] = *(const u32x4*)(F.UP() + (size_t)zrow_of(b, pos - ii) * 512 + 8 * lane); } }
#pragma unroll
        for (int r = 0; r < 2; ++r) { float sum[8];
#pragma unroll
            for (int i = 0; i < 8; ++i) sum[i] = 0.f;
#pragma unroll
            for (int ii = 0; ii < 16; ++ii) { const u32x4 v = x[r][ii];
                sum[0] += bflo(v.x); sum[1] += bfhi(v.x); sum[2] += bflo(v.y); sum[3] += bfhi(v.y); sum[4] += bflo(v.z); sum[5] += bfhi(v.z); sum[6] += bflo(v.w); sum[7] += bfhi(v.w); }
            const u32x4 v0 = x[r][0];
            u32x4 o; o.x = cvt_pk_bf16(sum[0] * iw - bflo(v0.x), sum[1] * iw - bfhi(v0.x)); o.y = cvt_pk_bf16(sum[2] * iw - bflo(v0.y), sum[3] * iw - bfhi(v0.y));
            o.z = cvt_pk_bf16(sum[4] * iw - bflo(v0.z), sum[5] * iw - bfhi(v0.z)); o.w = cvt_pk_bf16(sum[6] * iw - bflo(v0.w), sum[7] * iw - bfhi(v0.w));
            *(u32x4*)(F.MIX() + (size_t)(row0 + r) * 1024 + 512 + 8 * lane) = o; }
    }
}

__device__ __forceinline__ void indexer_item(const Frame& F, const int b, const int qt32) {
    constexpr int NTB = 65;
    const int lane = fresh((int)threadIdx.x) & 63, tid = (int)threadIdx.x, wv = F.wave, hk = lane >> 5, l31 = lane & 31;
    const int c = qt32 >> 1, nvis = 80 + 64 * c, ntile = 3 + 2 * c, nsteps = (ntile + 3) >> 2;
    const int qrow0 = b * SEQ + qt32 * 32 + 4 * wv;
    constexpr int NST = (NTB + 3) / 4;
    const int blk = l31 >> 3, hf = (l31 >> 2) & 1, e = l31 & 3;
    const int ql = 2 * hf + (blk >> 1), head = 4 * (blk & 1) + e;
    bf16x8 af[4];
    { const bf16_t* qip = F.QI() + (size_t)(qrow0 + ql) * 512 + head * 64 + 8 * hk;
#pragma unroll
      for (int ks = 0; ks < 4; ++ks) af[ks] = *(const bf16x8*)(qip + 16 * ks); }
    float wreg[16];
#pragma unroll
    for (int r = 0; r < 16; ++r) wreg[r] = F.WI()[(size_t)(qrow0 + 2 * hk + (r >> 3)) * 8 + (r & 7)];
    const int st_key = tid >> 3, st_c8 = tid & 7;
    const unsigned st_off = st_key * 128 + ((st_c8 ^ (st_key & 7)) * 16);
    const bf16_t* kisrc = F.KI() + (size_t)(b * TT) * 64 + st_c8 * 8;
    u32x4 sa, sb;
    { int k0 = st_key, k1 = 64 + st_key; sa = *(const u32x4*)(kisrc + (size_t)k0 * 64); sb = *(const u32x4*)(kisrc + (size_t)k1 * 64); }
    *(LAS u32x4*)(F.lds + st_off) = sa; *(LAS u32x4*)(F.lds + 8192 + st_off) = sb;
    if (nsteps > 1) { int k0 = 128 + st_key, k1 = 192 + st_key; k0 = k0 < TT ? k0 : TT - 1; k1 = k1 < TT ? k1 : TT - 1; sa = *(const u32x4*)(kisrc + (size_t)k0 * 64); sb = *(const u32x4*)(kisrc + (size_t)k1 * 64); }
    __syncthreads();
    unsigned comp[2][NTB];
#pragma unroll
    for (int st = 0; st < NST; ++st) {
        if (st < nsteps) {
            const int buf = st & 1;
            u32x4 na = sa, nb = sb;
            if (st + 2 < nsteps) { int k0 = 128 * (st + 2) + st_key, k1 = k0 + 64; k0 = k0 < TT ? k0 : TT - 1; k1 = k1 < TT ? k1 : TT - 1; na = *(const u32x4*)(kisrc + (size_t)k0 * 64); nb = *(const u32x4*)(kisrc + (size_t)k1 * 64); }
#pragma unroll
            for (int tl = 0; tl < 4; ++tl) { constexpr int dummy = 0; (void)dummy; const int j = 4 * st + tl;
                if (j < NTB) {
                    unsigned c0 = 0u, c1 = 0u;
                    if (j < ntile) {
                        LAS const unsigned char* kb = F.lds + buf * 16384 + (32 * tl + l31) * 128;
                        f32x16 acc = {};
#pragma unroll
                        for (int ks = 0; ks < 4; ++ks) { const bf16x8 bfr = *(LAS const bf16x8*)(kb + (((2 * ks + hk) ^ (l31 & 7)) * 16)); acc = MFMA32(af[ks], bfr, acc); }
                        float s0 = 0.f, s1 = 0.f;
#pragma unroll
                        for (int r = 0; r < 8; ++r) { s0 += wreg[r] * fmaxf(acc[r], 0.f); s1 += wreg[r + 8] * fmaxf(acc[r + 8], 0.f); }
                        const int key = 32 * j + l31;
                        if (key < nvis) { unsigned u0 = __float_as_uint(s0), u1 = __float_as_uint(s1); if (u0 == 0x80000000u) u0 = 0u; if (u1 == 0x80000000u) u1 = 0u;
                            c0 = ((u0 ^ ((u0 >> 31) ? 0xFFFFFFFFu : 0x80000000u)) & ~0xFFFu) | (unsigned)(4095 - key);
                            c1 = ((u1 ^ ((u1 >> 31) ? 0xFFFFFFFFu : 0x80000000u)) & ~0xFFFu) | (unsigned)(4095 - key); }
                    }
                    comp[0][j] = c0; comp[1][j] = c1;
                    __builtin_amdgcn_sched_barrier(0);
                } }
            if (st + 1 < nsteps) { *(LAS u32x4*)(F.lds + (buf ^ 1) * 16384 + st_off) = sa; *(LAS u32x4*)(F.lds + (buf ^ 1) * 16384 + 8192 + st_off) = sb; }
            sa = na; sb = nb;
            __syncthreads();
        } else {
#pragma unroll
            for (int tl = 0; tl < 4; ++tl) { const int j = 4 * st + tl; if (j < NTB) { comp[0][j] = 0u; comp[1][j] = 0u; } }
        }
    }
    unsigned tA0 = 1u, tA1 = 1u, tB0 = 1u, tB1 = 1u;
    if (nvis > 256) { tA0 = tA1 = tB0 = tB1 = 0u; bool dA0 = false, dA1 = false, dB0 = false, dB1 = false;
#pragma unroll 1
        for (int bit = 31; bit >= 0; --bit) {
            const unsigned m = 1u << bit;
            const unsigned cand0 = (hk ? tB0 : tA0) | m, cand1 = (hk ? tB1 : tA1) | m;
            int p0 = 0, p1 = 0;
#define IDX_CNT(LO, HI) _Pragma("unroll") for (int j = (LO); j < (HI); ++j) { p0 += (comp[0][j] >= cand0) ? 1 : 0; p1 += (comp[1][j] >= cand1) ? 1 : 0; }
            IDX_CNT(0, 17)
            if (ntile > 17) { IDX_CNT(17, 33) if (ntile > 33) { IDX_CNT(33, 49) if (ntile > 49) { IDX_CNT(49, 65) } } }
#undef IDX_CNT
            p0 += __builtin_amdgcn_update_dpp(0, p0, 0xB1, 0xF, 0xF, false); p1 += __builtin_amdgcn_update_dpp(0, p1, 0xB1, 0xF, 0xF, false);
            p0 += __builtin_amdgcn_update_dpp(0, p0, 0x4E, 0xF, 0xF, false); p1 += __builtin_amdgcn_update_dpp(0, p1, 0x4E, 0xF, 0xF, false);
            p0 += __builtin_amdgcn_update_dpp(0, p0, 0x141, 0xF, 0xF, false); p1 += __builtin_amdgcn_update_dpp(0, p1, 0x141, 0xF, 0xF, false);
            p0 += __builtin_amdgcn_update_dpp(0, p0, 0x140, 0xF, 0xF, false); p1 += __builtin_amdgcn_update_dpp(0, p1, 0x140, 0xF, 0xF, false);
            const int cA0 = __builtin_amdgcn_readlane(p0, 0) + __builtin_amdgcn_readlane(p0, 16), cB0 = __builtin_amdgcn_readlane(p0, 32) + __builtin_amdgcn_readlane(p0, 48);
            const int cA1 = __builtin_amdgcn_readlane(p1, 0) + __builtin_amdgcn_readlane(p1, 16), cB1 = __builtin_amdgcn_readlane(p1, 32) + __builtin_amdgcn_readlane(p1, 48);
            if (!dA0 && cA0 >= 256) { tA0 |= m; dA0 = (cA0 == 256); }
            if (!dA1 && cA1 >= 256) { tA1 |= m; dA1 = (cA1 == 256); }
            if (!dB0 && cB0 >= 256) { tB0 |= m; dB0 = (cB0 == 256); }
            if (!dB1 && cB1 >= 256) { tB1 |= m; dB1 = (cB1 == 256); }
            if (dA0 && dA1 && dB0 && dB1) break; } }
    const unsigned t0 = hk ? tB0 : tA0, t1 = hk ? tB1 : tA1;
    int mq[4] = {0, 0, 0, 0};
    unsigned w64[4] = {0u, 0u, 0u, 0u};
#pragma unroll
    for (int j = 0; j < NTB; ++j) { const unsigned long long m0 = __ballot(comp[0][j] >= t0), m1 = __ballot(comp[1][j] >= t1);
        if (j < 64) {
            asm volatile("v_writelane_b32 %0, %2, %4\n\tv_writelane_b32 %1, %3, %4" : "+v"(mq[0]), "+v"(mq[2]) : "s"((int)(unsigned)m0), "s"((int)(unsigned)(m0 >> 32)), "i"(j < 64 ? j : 0));
            asm volatile("v_writelane_b32 %0, %2, %4\n\tv_writelane_b32 %1, %3, %4" : "+v"(mq[1]), "+v"(mq[3]) : "s"((int)(unsigned)m1), "s"((int)(unsigned)(m1 >> 32)), "i"(j < 64 ? j : 0));
        } else { w64[0] = (unsigned)m0; w64[2] = (unsigned)(m0 >> 32); w64[1] = (unsigned)m1; w64[3] = (unsigned)(m1 >> 32); } }
#pragma unroll
    for (int q = 0; q < 4; ++q) { unsigned* mrow = F.MASK() + (size_t)(qrow0 + q) * MASKW;
        if (lane <= ntile && lane < 64) mrow[lane] = lane < ntile ? (unsigned)mq[q] : 0u;
        if (NTB > 64 && ntile > 64 && lane == 0) { mrow[64] = w64[q]; mrow[65] = 0u; } }
    __syncthreads();
}

__device__ __forceinline__ void p3_indexer(const Frame& F) {
    for (int it = F.bid; it < 512; it += F.G) {
        const int half = it >> 8, ii = half ? 511 - (it & 255) : it;
        indexer_item(F, ii & 7, 63 - (ii >> 3));
    }
}

typedef short v4i16_t __attribute__((ext_vector_type(4)));
__device__ __forceinline__ s16x4 vtr(LAS const unsigned char* p) { return __builtin_bit_cast(s16x4, __builtin_amdgcn_ds_read_tr16_b64_v4i16((LAS v4i16_t*)p)); }

__device__ __forceinline__ void p4_attention(const Frame& F) {
    const int lane = fresh((int)threadIdx.x) & 63, wv = F.wave, tid = (int)threadIdx.x, hk = lane >> 5, l31 = lane & 31;
    float gb; { float a = fabsf(F.gq[lane]), bq = fabsf(F.gk[lane]);
#pragma unroll
        for (int o = 32; o > 0; o >>= 1) { a = fmaxf(a, __shfl_xor(a, o)); bq = fmaxf(bq, __shfl_xor(bq, o)); }
        gb = a * bq; }
    const float NMB = -8.f * gb * 1.02f * LOG2E;
    const int st_which = tid >> 8, st_r = (tid & 255) >> 3, st_c8 = tid & 7;
    const unsigned st_off = st_which ? (16384u + st_r * 128 + st_c8 * 16) : (st_r * 128 + ((st_c8 ^ (st_r & 7)) * 16));
    for (int it = F.bid; it < 512; it += F.G) {
        const int pr = it & 255, half = it >> 8, cp = pr & 3, bh = pr >> 2, b = bh >> 3, h = bh & 7, c4 = half ? 7 - cp : cp;
        const int qrow = b * SEQ + 256 * c4 + 32 * wv + l31;
        const int cch = 4 * c4 + (wv >> 1), nt = 2 + cch, ntmax = 2 + (4 * c4 + 3);
        bf16x8 qf[4];
#pragma unroll
        for (int ks = 0; ks < 4; ++ks) qf[ks] = *(const bf16x8*)(F.Q() + (size_t)qrow * 512 + h * 64 + 16 * ks + 8 * hk);
        const bf16_t* stsrc = (st_which ? F.VV() : F.K()) + (size_t)(b * TT) * 512 + h * 64 + st_c8 * 8;
        f32x16 o0 = {}, o1 = {}; float lsum = 0.f;
        u32x4 sa = *(const u32x4*)(stsrc + (size_t)st_r * 512), sb = *(const u32x4*)(stsrc + (size_t)(32 + st_r) * 512);
        u32x2 mw = *(const u32x2*)(F.MASK() + (size_t)qrow * MASKW);
        *(LAS u32x4*)(F.lds + st_off) = sa; *(LAS u32x4*)(F.lds + 4096 + st_off) = sb;
        sa = *(const u32x4*)(stsrc + (size_t)(64 + st_r) * 512); sb = *(const u32x4*)(stsrc + (size_t)(96 + st_r) * 512);
        __syncthreads();
        for (int j = 0; j < ntmax; ++j) {
            const int buf = j & 1;
            u32x2 mw_next = {0u, 0u}; u32x4 na = sa, nb = sb;
            if (j + 2 < ntmax) { int k0 = 64 * (j + 2) + st_r, k1 = k0 + 32; k0 = k0 < TT ? k0 : TT - 1; k1 = k1 < TT ? k1 : TT - 1;
                na = *(const u32x4*)(stsrc + (size_t)k0 * 512); nb = *(const u32x4*)(stsrc + (size_t)k1 * 512); }
            if (j + 1 < nt) mw_next = *(const u32x2*)(F.MASK() + (size_t)qrow * MASKW + 2 * (j + 1));
            if (j < nt) {
                LAS const unsigned char* kb = F.lds + buf * 8192; LAS const unsigned char* vb = F.lds + 16384 + buf * 8192;
                f32x16 s[2];
#pragma unroll
                for (int hh = 0; hh < 2; ++hh)
#pragma unroll
                    for (int r = 0; r < 16; ++r) s[hh][r] = NMB;
#pragma unroll
                for (int ks = 0; ks < 4; ++ks)
#pragma unroll
                    for (int hh = 0; hh < 2; ++hh) { const bf16x8 kf = *(LAS const bf16x8*)(kb + (32 * hh + l31) * 128 + (((2 * ks + hk) ^ (l31 & 7)) * 16)); s[hh] = MFMA32(kf, qf[ks], s[hh]); }
                bf16x8 pf[2][2];
#pragma unroll
                for (int hh = 0; hh < 2; ++hh) {
                    const unsigned w2 = (hh ? mw.y : mw.x) >> (4 * hk);
                    float p[16];
#pragma unroll
                    for (int r = 0; r < 16; ++r) { p[r] = __uint_as_float(__float_as_uint(__builtin_amdgcn_exp2f(s[hh][r])) & (unsigned)__builtin_amdgcn_sbfe((int)w2, (r & 3) + 8 * (r >> 2), 1)); lsum += p[r]; }
#pragma unroll
                    for (int s2 = 0; s2 < 2; ++s2) { u32x4 w; w.x = cvt_pk_bf16(p[8 * s2 + 0], p[8 * s2 + 1]); w.y = cvt_pk_bf16(p[8 * s2 + 2], p[8 * s2 + 3]);
                        w.z = cvt_pk_bf16(p[8 * s2 + 4], p[8 * s2 + 5]); w.w = cvt_pk_bf16(p[8 * s2 + 6], p[8 * s2 + 7]); pf[hh][s2] = __builtin_bit_cast(bf16x8, w); }
                }
                const int i16 = lane & 15, g1 = (lane >> 4) & 1;
#pragma unroll
                for (int hh = 0; hh < 2; ++hh) {
                    LAS const unsigned char* vp = vb + (32 * hh + 4 * hk + (i16 >> 2)) * 128 + (16 * g1 + 4 * (i16 & 3)) * 2;
#pragma unroll
                    for (int s2 = 0; s2 < 2; ++s2) {
                        { const s16x4 lo = vtr(vp + (16 * s2) * 128), hi = vtr(vp + (16 * s2 + 8) * 128);
                          const bf16x8 vf = {lo[0], lo[1], lo[2], lo[3], hi[0], hi[1], hi[2], hi[3]}; o0 = MFMA32(vf, pf[hh][s2], o0); }
                        { const s16x4 lo = vtr(vp + (16 * s2) * 128 + 64), hi = vtr(vp + (16 * s2 + 8) * 128 + 64);
                          const bf16x8 vf = {lo[0], lo[1], lo[2], lo[3], hi[0], hi[1], hi[2], hi[3]}; o1 = MFMA32(vf, pf[hh][s2], o1); }
                    }
                }
            }
            if (j + 1 < ntmax) { *(LAS u32x4*)(F.lds + (buf ^ 1) * 8192 + st_off) = sa; *(LAS u32x4*)(F.lds + (buf ^ 1) * 8192 + 4096 + st_off) = sb; }
            mw = mw_next; sa = na; sb = nb;
            __syncthreads();
        }
        lsum += __shfl_xor(lsum, 32);
        const float inv = 1.f / lsum;
        bf16_t* dst = F.MIX() + (size_t)qrow * 1024 + h * 64 + 4 * hk;
#pragma unroll
        for (int g = 0; g < 4; ++g) {
            u32x2 w; w.x = cvt_pk_bf16(o0[4 * g] * inv, o0[4 * g + 1] * inv); w.y = cvt_pk_bf16(o0[4 * g + 2] * inv, o0[4 * g + 3] * inv); *(u32x2*)(dst + 8 * g) = w;
            u32x2 w1; w1.x = cvt_pk_bf16(o1[4 * g] * inv, o1[4 * g + 1] * inv); w1.y = cvt_pk_bf16(o1[4 * g + 2] * inv, o1[4 * g + 3] * inv); *(u32x2*)(dst + 32 + 8 * g) = w1; }
    }
}

template <int N> __device__ __forceinline__ void bitonic_sort_desc(float (&a)[N]) {
#pragma unroll
    for (int k = 2; k <= N; k <<= 1)
#pragma unroll
        for (int j = k >> 1; j > 0; j >>= 1)
#pragma unroll
            for (int i = 0; i < N; ++i) { const int l = i ^ j; if (l > i) { const bool desc = ((i & k) == 0) || (k == N); const float x = a[i], y = a[l];
                const float mx = fmaxf(x, y), mn = fminf(x, y); a[i] = desc ? mx : mn; a[l] = desc ? mn : mx; } }
}
__device__ __forceinline__ void merge_top16(float (&a)[16], const float (&b)[16]) {
#pragma unroll
    for (int i = 0; i < 16; ++i) a[i] = fmaxf(a[i], b[15 - i]);
#pragma unroll
    for (int j = 8; j > 0; j >>= 1)
#pragma unroll
        for (int i = 0; i < 16; ++i) { const int l = i ^ j; if (l > i) { const float x = a[i], y = a[l]; a[i] = fmaxf(x, y); a[l] = fminf(x, y); } }
}
__device__ __forceinline__ void cex(float& x, int& px, float& y, int& py) { const bool sw = y > x; const float tx = sw ? y : x, ty = sw ? x : y; const int tp = sw ? py : px, tq = sw ? px : py; x = tx; y = ty; px = tp; py = tq; }

__host__ __device__ constexpr int cand_cnt(int i) { return 16 / (i + 1); }
__host__ __device__ constexpr int cand_off(int i) { int s = 0; for (int k = 0; k < i; ++k) s += cand_cnt(k); return s; }
static_assert(cand_off(16) == 50, "candidates");
template <int N> __device__ __forceinline__ void bitonic_sort_desc_kv(float (&a)[N], int (&p)[N]) {
#pragma unroll
    for (int k = 2; k <= N; k <<= 1)
#pragma unroll
        for (int j = k >> 1; j > 0; j >>= 1)
#pragma unroll
            for (int i = 0; i < N; ++i) { const int l = i ^ j; if (l > i) { const bool desc = ((i & k) == 0) || (k == N);
                if (desc) cex(a[i], p[i], a[l], p[l]); else cex(a[l], p[l], a[i], p[i]); } }
}
__device__ __forceinline__ void merge_top16_kv(float (&a)[16], int (&pa)[16], const float (&b)[16], const int (&pb)[16]) {
#pragma unroll
    for (int i = 0; i < 16; ++i) { const bool sw = b[15 - i] > a[i]; a[i] = sw ? b[15 - i] : a[i]; pa[i] = sw ? pb[15 - i] : pa[i]; }
#pragma unroll
    for (int j = 8; j > 0; j >>= 1)
#pragma unroll
        for (int i = 0; i < 16; ++i) { const int l = i ^ j; if (l > i) cex(a[i], pa[i], a[l], pa[l]); }
}
__device__ __forceinline__ void sub_top16(const Frame& F, LAS const unsigned char* skl, const bf16_t* qrow, float (&top)[16]) {
    const int lane = F.lane, hk = lane >> 5, l31 = lane & 31;
    bf16x8 bq[8];
#pragma unroll
    for (int ks = 0; ks < 8; ++ks) bq[ks] = *(const bf16x8*)(qrow + 16 * ks + 8 * hk);
#pragma unroll
    for (int mt = 0; mt < 4; ++mt) {
        f32x16 acc = {};
        const int key = 32 * mt + l31;
#pragma unroll
        for (int ks = 0; ks < 8; ++ks) { const bf16x8 a = *(LAS const bf16x8*)(skl + key * 256 + (((2 * ks + hk) ^ (key & 15)) * 16)); acc = MFMA32(a, bq[ks], acc); }
        float cur[16];
#pragma unroll
        for (int r = 0; r < 16; ++r) { const unsigned kidx = (unsigned)(32 * mt + (r & 3) + 8 * (r >> 2) + 4 * hk); cur[r] = __uint_as_float((__float_as_uint(acc[r]) & ~127u) | kidx); }
        bitonic_sort_desc<16>(cur);
        if (mt == 0) {
#pragma unroll
            for (int i = 0; i < 16; ++i) top[i] = cur[i]; }
        else merge_top16(top, cur);
        __builtin_amdgcn_sched_barrier(0);
    }
    float oth[16];
#pragma unroll
    for (int i = 0; i < 16; ++i) oth[i] = __shfl_xor(top[i], 32);
    merge_top16(top, oth);
}

__host__ __device__ constexpr int p1_units() { return (MPAD / 256) * (NZP / 256); }
__host__ __device__ __forceinline__ int p1_first_idle(int G) { const int maxu = (p1_units() + G - 1) / G; return p1_units() - (maxu - 1) * G; }
__host__ __device__ __forceinline__ int tables_rows_p1(int G) { const int r = (G - p1_first_idle(G)) * 8 * 24; return r < 2 * NEXP ? r : 2 * NEXP; }
__device__ __forceinline__ void p7b_tables(const Frame& F, const int widx, const int nworkers, const int rbeg, const int rend) {
    const int lane = fresh((int)threadIdx.x) & 63;
    f32x4 g[4];
#pragma unroll
    for (int i = 0; i < 4; ++i) g[i] = *(const f32x4*)(F.g2 + 16 * lane + 4 * i);
#pragma unroll 1
    for (int r0 = rbeg + widx * 8; r0 < rend; r0 += nworkers * 8) {
        const bool isv = r0 >= NEXP; const int e0 = isv ? r0 - NEXP : r0;
        const float* src = (isv ? F.pv : F.pu) + (size_t)e0 * 1024 + 16 * lane;
        f32x4 v[8][4]; float mx[8];
#pragma unroll
        for (int r = 0; r < 8; ++r)
#pragma unroll
            for (int i = 0; i < 4; ++i) v[r][i] = *(const f32x4*)(src + (size_t)r * 1024 + 4 * i);
#pragma unroll
        for (int r = 0; r < 8; ++r) { float m = 0.f;
#pragma unroll
            for (int i = 0; i < 4; ++i) { if (!isv) v[r][i] = v[r][i] * g[i];
                m = fmaxf(m, fmaxf(fmaxf(fabsf(v[r][i][0]), fabsf(v[r][i][1])), fmaxf(fabsf(v[r][i][2]), fabsf(v[r][i][3])))); }
            mx[r] = m; }
#pragma unroll
        for (int o = 32; o > 0; o >>= 1) {
#pragma unroll
            for (int r = 0; r < 8; ++r) mx[r] = fmaxf(mx[r], __shfl_xor(mx[r], o)); }
        unsigned char* dst = (isv ? F.V8() : F.U8()) + (size_t)(lane >> 3) * (NEXP * 128) + 16 * (lane & 7);
#pragma unroll
        for (int r = 0; r < 8; ++r) { const float sc = mx[r] > 0.f ? mx[r] * (1.f / 440.f) : 1.f, inv = 1.f / sc;
            u32x4 w;
#pragma unroll
            for (int i = 0; i < 4; ++i) { int p = __builtin_amdgcn_cvt_pk_fp8_f32(v[r][i][0] * inv, v[r][i][1] * inv, 0, false); p = __builtin_amdgcn_cvt_pk_fp8_f32(v[r][i][2] * inv, v[r][i][3] * inv, p, true); w[i] = (unsigned)p; }
            *(u32x4*)(dst + (size_t)(e0 + r) * 128) = w;
            if (lane == 0) (isv ? F.SV() : F.SU())[e0 + r] = sc; }
    }
}

__device__ __forceinline__ void p7_routing(const Frame& F) {
    const int lane = F.lane, hk = lane >> 5, l31 = lane & 31;
    for (int idx = F.tid; idx < 2 * 128 * 16; idx += NTHR) { const int tb = idx >> 11, key = (idx >> 4) & 127, c16 = idx & 15;
        const u32x4 v = *(const u32x4*)(F.SK() + (size_t)tb * 16384 + key * 128 + c16 * 8);
        *(LAS u32x4*)(F.lds + tb * 32768 + key * 256 + ((c16 ^ (key & 15)) * 16)) = v; }
    LAS unsigned* ctab = (LAS unsigned*)(F.lds + 131072);
    if (F.tid < 50) { int n = F.tid, i = 0; while (n >= cand_cnt(i)) { n -= cand_cnt(i); ++i; } ctab[F.tid] = (unsigned)((i << 4) | n); }
    LAS float* lt = (LAS float*)(F.lds + 65536) + F.wave * 2048;
    __syncthreads();
    constexpr int RW = 6;
    if (F.wave >= RW) { p7b_tables(F, F.bid * (8 - RW) + (F.wave - RW), F.G * (8 - RW), tables_rows_p1(F.G), 2 * NEXP); return; }
    pg8::StaticOrder S; S.init(MREAL, 2048, F.G, F.bid);
    for (int li = F.wave; ; li += RW) {
        pg8::Unit un; if (!S.next(li >> 3, un)) break;
        const int tt = un.pm * 8 + (li & 7), head = un.pn, tok = tt * 32 + l31;
        const bf16_t* qrow = F.QP() + (size_t)tok * 2048 + head * 256;
        float t1[16], t2[16];
        sub_top16(F, F.lds, qrow, t1);
        sub_top16(F, F.lds + 32768, qrow + 128, t2);
#pragma unroll
        for (int i = 0; i < 16; ++i) { lt[i * 64 + lane] = t1[i]; lt[(16 + i) * 64 + lane] = t2[i]; }
        float cv[4][16];
#pragma unroll
        for (int k = 50; k < 64; ++k) cv[k >> 4][k & 15] = -3.0e38f;
#pragma unroll
        for (int i = 0; i < 16; ++i)
#pragma unroll
            for (int j = 0; j < 16; ++j) if ((i + 1) * (j + 1) <= 16) {
                const int n = cand_off(i) + j;
                const float sum = __uint_as_float(__float_as_uint(t1[i]) & ~127u) + __uint_as_float(__float_as_uint(t2[j]) & ~127u);
                cv[n >> 4][n & 15] = __uint_as_float((__float_as_uint(sum) & ~63u) | (unsigned)n); }
#pragma unroll
        for (int g = 0; g < 4; ++g) bitonic_sort_desc<16>(cv[g]);
        merge_top16(cv[0], cv[1]); merge_top16(cv[2], cv[3]); merge_top16(cv[0], cv[2]);
        float sv[16]; int ev[16];
#pragma unroll
        for (int k = 0; k < 16; ++k) { const unsigned ij = ctab[__float_as_uint(cv[0][k]) & 63u];
            const unsigned a = __float_as_uint(lt[(ij >> 4) * 64 + lane]), bb = __float_as_uint(lt[(16 + (ij & 15)) * 64 + lane]);
            sv[k] = __uint_as_float(a & ~127u) + __uint_as_float(bb & ~127u); ev[k] = (int)(((a & 127u) << 7) | (bb & 127u)); }
        float mx = sv[0];
#pragma unroll
        for (int k = 1; k < 16; ++k) mx = fmaxf(mx, sv[k]);
        float ge[16], gs = 0.f;
#pragma unroll
        for (int k = 0; k < 16; ++k) { ge[k] = __expf(sv[k] - mx); gs += ge[k]; }
        const float ginv = 1.f / gs;
        if (hk == 0) {
            bf16_t* ed = F.EID() + (size_t)tok * 128 + head * 16; float* gd = F.GATE() + (size_t)tok * 128 + head * 16;
#pragma unroll
            for (int k = 0; k < 16; k += 8) *(u32x4*)(ed + k) = (u32x4){(unsigned)ev[k] | ((unsigned)ev[k + 1] << 16), (unsigned)ev[k + 2] | ((unsigned)ev[k + 3] << 16), (unsigned)ev[k + 4] | ((unsigned)ev[k + 5] << 16), (unsigned)ev[k + 6] | ((unsigned)ev[k + 7] << 16)};
#pragma unroll
            for (int k = 0; k < 16; k += 4) *(f32x4*)(gd + k) = (f32x4){ge[k] * ginv, ge[k + 1] * ginv, ge[k + 2] * ginv, ge[k + 3] * ginv};
        }
    }
}

typedef float f32x2 __attribute__((ext_vector_type(2)));
#define XQ_WORD(pass, s) (4096 + 64 * (8 * (pass) + (s)))
#define XQ_TOK 32
#define XQ_CHUNKS (MREAL / (8 * XQ_TOK))
__device__ __forceinline__ int next_item(const Frame& F, unsigned* ctl, int qpass, int cur) {
    volatile LAS int* slot = (volatile LAS int*)(F.lds + LDS_BYTES - 32);
    __syncthreads();
    if (F.tid == 0) { int res = -1;
        for (int d = 0; d < 8; ++d) { const int s = (cur + d) & 7; unsigned* c = ctl + XQ_WORD(qpass, s);
            if (__hip_atomic_load(c, __ATOMIC_RELAXED, __HIP_MEMORY_SCOPE_AGENT) >= (unsigned)XQ_CHUNKS) continue;
            const unsigned idx = __hip_atomic_fetch_add(c, 1u, __ATOMIC_RELAXED, __HIP_MEMORY_SCOPE_AGENT);
            if (idx < (unsigned)XQ_CHUNKS) { res = (s << 16) | (int)idx; break; } }
        *slot = res; }
    __syncthreads();
    return *slot;
}
#define P8_LOAD8(R, EV, BASE, OFF) _Pragma("unroll") for (int ii = 0; ii < 8; ++ii) { const int e_ = __shfl((EV), 8 * ii + xg); R[ii] = *(const u32x4*)((BASE) + ((unsigned)e_ * 128u + (OFF))); }
#define P8U_DOT8(R, P0) _Pragma("unroll") for (int ii = 0; ii < 8; ++ii) { f32x2 sacc = {0.f, 0.f};                                 \
        _Pragma("unroll") for (int q = 0; q < 4; ++q) { sacc += hv2[2 * q] * __builtin_amdgcn_cvt_pk_f32_fp8((int)R[ii][q], false); sacc += hv2[2 * q + 1] * __builtin_amdgcn_cvt_pk_f32_fp8((int)R[ii][q], true); } \
        p[(P0) + ii] = sacc[0] + sacc[1]; }
template <int QPASS>
__device__ __forceinline__ void p8u_sliced(const Frame& F) {
    unsigned* ctl = (unsigned*)(F.ws + WS_CTL);
    int cur = (int)(xb_xcc_id() & 7u);
    for (;;) { const int itm = next_item(F, ctl, QPASS, cur); if (itm < 0) break;
        const int s = itm >> 16, chunk = itm & 0xffff; cur = s;
        const int lane = fresh((int)threadIdx.x) & 63, xg = lane >> 3, ch = lane & 7;
        const int t0 = chunk * (8 * XQ_TOK) + F.wave * XQ_TOK;
        const unsigned char* ubase = F.U8() + (size_t)s * (NEXP * 128);
        const unsigned uoff = 16u * ch;
        const bool b2 = lane & 4, b1 = lane & 2, b0 = lane & 1;
        const int kout = 64 * (b2 ? 1 : 0) + 32 * (b1 ? 1 : 0) + 16 * (b0 ? 1 : 0) + xg;
        bf16_t* part = F.PART() + (size_t)s * ((size_t)MREAL * 128);
        int e_lo = (int)F.EID()[(unsigned)(t0 * 128 + lane)], e_hi = (int)F.EID()[(unsigned)(t0 * 128 + 64 + lane)];
        int n_lo = (int)F.EID()[(unsigned)((t0 + 1) * 128 + lane)], n_hi = (int)F.EID()[(unsigned)((t0 + 1) * 128 + 64 + lane)];
        u32x4 ha = *(const u32x4*)(F.H1B() + (unsigned)(t0 * 1024 + 128 * s + 16 * ch)), hb = *(const u32x4*)(F.H1B() + (unsigned)(t0 * 1024 + 128 * s + 16 * ch + 8));
        u32x4 rA[8], rB[8];
        P8_LOAD8(rA, e_lo, ubase, uoff)
#pragma unroll 1
        for (int i = 0; i < XQ_TOK; ++i) {
            const int t = t0 + i, tn = t0 + (i < XQ_TOK - 1 ? i + 1 : XQ_TOK - 1), tnn = t0 + (i < XQ_TOK - 2 ? i + 2 : XQ_TOK - 1);
            const int nn_lo = (int)F.EID()[(unsigned)(tnn * 128 + lane)], nn_hi = (int)F.EID()[(unsigned)(tnn * 128 + 64 + lane)];
            const u32x4 nha = *(const u32x4*)(F.H1B() + (unsigned)(tn * 1024 + 128 * s + 16 * ch)), nhb = *(const u32x4*)(F.H1B() + (unsigned)(tn * 1024 + 128 * s + 16 * ch + 8));
            f32x2 hv2[8];
            hv2[0] = (f32x2){bflo(ha.x), bfhi(ha.x)}; hv2[1] = (f32x2){bflo(ha.y), bfhi(ha.y)}; hv2[2] = (f32x2){bflo(ha.z), bfhi(ha.z)}; hv2[3] = (f32x2){bflo(ha.w), bfhi(ha.w)};
            hv2[4] = (f32x2){bflo(hb.x), bfhi(hb.x)}; hv2[5] = (f32x2){bflo(hb.y), bfhi(hb.y)}; hv2[6] = (f32x2){bflo(hb.z), bfhi(hb.z)}; hv2[7] = (f32x2){bflo(hb.w), bfhi(hb.w)};
            float p[16];
            P8_LOAD8(rB, e_hi, ubase, uoff)
            __builtin_amdgcn_sched_barrier(0);
            P8U_DOT8(rA, 0)
            __builtin_amdgcn_sched_barrier(0);
            P8_LOAD8(rA, n_lo, ubase, uoff)
            __builtin_amdgcn_sched_barrier(0);
            P8U_DOT8(rB, 8)
            float r8[8], r4[4], r2[2];
#pragma unroll
            for (int q = 0; q < 8; ++q) { const float mine = b2 ? p[q + 8] : p[q], theirs = b2 ? p[q] : p[q + 8]; r8[q] = mine + __shfl_xor(theirs, 4); }
#pragma unroll
            for (int q = 0; q < 4; ++q) { const float mine = b1 ? r8[q + 4] : r8[q], theirs = b1 ? r8[q] : r8[q + 4]; r4[q] = mine + __shfl_xor(theirs, 2); }
#pragma unroll
            for (int q = 0; q < 2; ++q) { const float mine = b0 ? r4[q + 2] : r4[q], theirs = b0 ? r4[q] : r4[q + 2]; r2[q] = mine + __shfl_xor(theirs, 1); }
            part[(unsigned)(t * 128 + kout)] = f2bf(r2[0]); part[(unsigned)(t * 128 + kout + 8)] = f2bf(r2[1]);
            e_lo = n_lo; e_hi = n_hi; n_lo = nn_lo; n_hi = nn_hi; ha = nha; hb = nhb;
            __builtin_amdgcn_sched_barrier(0);
        }
    }
}
__device__ __forceinline__ void p8c_combine(const Frame& F) {
    for (int idx = F.bid * NTHR + fresh((int)threadIdx.x); idx < MREAL * 128; idx += F.G * NTHR) {
        const int t = idx >> 7; const int e = (int)F.EID()[idx];
        float sum = 0.f;
#pragma unroll
        for (int s = 0; s < 8; ++s) sum += bf2f(F.PART()[(size_t)s * ((size_t)MREAL * 128) + idx]);
        const float a = sum * F.SU()[e] * rsqrtf(F.SUMSQ()[t] * (1.f / 1024.f) + RMS_EPS);
        F.CB()[idx] = f2bf(0.5f * a * (1.f + erff(a * 0.70710678118654752f)) * F.GATE()[idx] * F.SV()[e]);
    }
}
#define P8V_FMA8(R, C) _Pragma("unroll") for (int ii = 0; ii < 8; ++ii) { const f32x2 c2 = {C[ii], C[ii]};                            \
        _Pragma("unroll") for (int q = 0; q < 4; ++q) { acc2[2 * q] += c2 * __builtin_amdgcn_cvt_pk_f32_fp8((int)R[ii][q], false); acc2[2 * q + 1] += c2 * __builtin_amdgcn_cvt_pk_f32_fp8((int)R[ii][q], true); } }
#define P8V_COEF8(C, CV) _Pragma("unroll") for (int ii = 0; ii < 8; ++ii) C[ii] = __shfl((CV), 8 * ii + xg);
template <int QPASS>
__device__ __forceinline__ void p8v_experts(const Frame& F) {
    unsigned* ctl = (unsigned*)(F.ws + WS_CTL);
    int cur = (int)(xb_xcc_id() & 7u);
    for (;;) { const int itm = next_item(F, ctl, QPASS, cur); if (itm < 0) break;
        const int s = itm >> 16, chunk = itm & 0xffff; cur = s;
        const int lane = fresh((int)threadIdx.x) & 63, xg = lane >> 3, ch = lane & 7;
        const int t0 = chunk * (8 * XQ_TOK) + F.wave * XQ_TOK;
        const unsigned char* vbase = F.V8() + (size_t)s * (NEXP * 128);
        const unsigned voff = 16u * ch;
        const bool b5 = lane & 32, b4 = lane & 16, b3 = lane & 8;
        const int col = 128 * s + 16 * ch + (b5 ? 8 : 0) + (b4 ? 4 : 0) + (b3 ? 2 : 0);
        int e_lo = (int)F.EID()[(unsigned)(t0 * 128 + lane)], e_hi = (int)F.EID()[(unsigned)(t0 * 128 + 64 + lane)];
        int n_lo = (int)F.EID()[(unsigned)((t0 + 1) * 128 + lane)], n_hi = (int)F.EID()[(unsigned)((t0 + 1) * 128 + 64 + lane)];
        float c_lo = bf2f(F.CB()[(unsigned)(t0 * 128 + lane)]), c_hi = bf2f(F.CB()[(unsigned)(t0 * 128 + 64 + lane)]);
        u32x4 rA[8], rB[8];
        P8_LOAD8(rA, e_lo, vbase, voff)
#pragma unroll 1
        for (int i = 0; i < XQ_TOK; ++i) {
            const int t = t0 + i, tn = t0 + (i < XQ_TOK - 1 ? i + 1 : XQ_TOK - 1), tnn = t0 + (i < XQ_TOK - 2 ? i + 2 : XQ_TOK - 1);
            const int nn_lo = (int)F.EID()[(unsigned)(tnn * 128 + lane)], nn_hi = (int)F.EID()[(unsigned)(tnn * 128 + 64 + lane)];
            const float nc_lo = bf2f(F.CB()[(unsigned)(tn * 128 + lane)]), nc_hi = bf2f(F.CB()[(unsigned)(tn * 128 + 64 + lane)]);
            const unsigned h1w = *(const unsigned*)(F.H1B() + (unsigned)(t * 1024 + col)); const f32x2 h1 = {bflo(h1w), bfhi(h1w)};
            f32x2 acc2[8]; float cc[8];
#pragma unroll
            for (int q = 0; q < 8; ++q) acc2[q] = (f32x2){0.f, 0.f};
            P8_LOAD8(rB, e_hi, vbase, voff)
            P8V_COEF8(cc, c_lo)
            __builtin_amdgcn_sched_barrier(0);
            P8V_FMA8(rA, cc)
            __builtin_amdgcn_sched_barrier(0);
            P8_LOAD8(rA, n_lo, vbase, voff)
            P8V_COEF8(cc, c_hi)
            __builtin_amdgcn_sched_barrier(0);
            P8V_FMA8(rB, cc)
            __builtin_amdgcn_sched_barrier(0);
            float acc[16];
#pragma unroll
            for (int q = 0; q < 8; ++q) { acc[2 * q] = acc2[q][0]; acc[2 * q + 1] = acc2[q][1]; }
            float r8[8], r4[4], r2[2];
#pragma unroll
            for (int q = 0; q < 8; ++q) { const float mine = b5 ? acc[q + 8] : acc[q], theirs = b5 ? acc[q] : acc[q + 8]; r8[q] = mine + __shfl_xor(theirs, 32); }
#pragma unroll
            for (int q = 0; q < 4; ++q) { const float mine = b4 ? r8[q + 4] : r8[q], theirs = b4 ? r8[q] : r8[q + 4]; r4[q] = mine + __shfl_xor(theirs, 16); }
#pragma unroll
            for (int q = 0; q < 2; ++q) { const float mine = b3 ? r4[q + 2] : r4[q], theirs = b3 ? r4[q] : r4[q + 2]; r2[q] = mine + __shfl_xor(theirs, 8); }
            *(f32x2*)(F.out + (unsigned)(t * 1024 + col)) = (f32x2){h1[0] + r2[0], h1[1] + r2[1]};
            e_lo = n_lo; e_hi = n_hi; n_lo = nn_lo; n_hi = nn_hi; c_lo = nc_lo; c_hi = nc_hi;
            __builtin_amdgcn_sched_barrier(0);
        }
    }
}

constexpr int NPHASE = 10;
__global__ void __launch_bounds__(NTHR, 2) mk_fwd(Args args) {
    extern __shared__ __attribute__((aligned(16))) unsigned char lds_raw[];
    Frame F;
    F.lds = (LAS unsigned char*)lds_raw;
    F.tid = threadIdx.x; F.lane = F.tid & 63; F.wave = __builtin_amdgcn_readfirstlane(F.tid >> 6); F.G = gridDim.x; F.bid = blockIdx.x;
    F.x = args.in[0]; F.meta = args.in[1]; F.g1 = args.in[2]; F.w_in = args.in[3]; F.gq = args.in[4]; F.gk = args.in[5]; F.pool_w = args.in[6]; F.pool_scale = args.in[7];
    F.w_out = args.in[8]; F.g2 = args.in[9]; F.wq = args.in[10]; F.sk1 = args.in[11]; F.sk2 = args.in[12]; F.pu = args.in[13]; F.pv = args.in[14];
    F.out = args.out; F.ws = args.ws; unsigned char* ws = args.ws;
    const int lo = args.ph_lo, hi = args.ph_hi;
#ifndef PHASE_MASK
#define PHASE_MASK 0x3ff
#endif
#define IN(k) (((PHASE_MASK >> (k)) & 1) && lo <= (k) && (k) < hi)
    volatile LAS unsigned* bst = (volatile LAS unsigned*)(F.lds + LDS_BYTES - 16);
    if (F.tid == 0) { bst[0] = 0u; bst[1] = 0u; }
    __syncthreads();
    XcdBarrier bar = xcd_barrier_post((unsigned*)(ws + WS_CTL), bst);
#define GSYNC(k) do { if (IN(k) && IN((k) + 1)) xcd_barrier(bar); } while (0)
    if (IN(0)) { p0_prologue(F); }
    GSYNC(0);
    if (IN(1)) { { pg8::Gemm g{F.XN(), F.WIN(), MPAD, NZP, 1024}; pg8::StaticOrder S; S.init(MPAD, NZP, F.G, F.bid); EpiIn E{F.Q(), F.K(), F.VV(), F.QI(), F.KI(), F.UP(), F.WI(), F.gq, F.gk}; pg8::gemm_phase<EpiIn, pg8::StaticOrder>(F.lds, g, S, E);
        if (F.bid >= p1_first_idle(F.G)) p7b_tables(F, (F.bid - p1_first_idle(F.G)) * 8 + F.wave, (F.G - p1_first_idle(F.G)) * 8, 0, tables_rows_p1(F.G)); } }
    GSYNC(1);
    if (IN(3)) { p2_weff(F); p2_pool(F); p3_indexer(F); }
    GSYNC(3);
    if (IN(4)) { p4_attention(F); }
    GSYNC(4);
    if (IN(5)) { { pg8::Gemm g{F.MIX(), F.WOUT(), MREAL, 1024, 1024}; pg8::StaticOrder S; S.init(MREAL, 1024, F.G, F.bid); EpiOut E{F.x, F.out, F.H1B(), F.SUMSQ()}; pg8::gemm_phase<EpiOut, pg8::StaticOrder>(F.lds, g, S, E); } }
    GSYNC(5);
    if (IN(6)) { { pg8::Gemm g{F.H1B(), F.WQ(), MREAL, 2048, 1024}; pg8::StaticOrder S; S.init(MREAL, 2048, F.G, F.bid); EpiQP E{F.QP(), F.SUMSQ()}; pg8::gemm_phase<EpiQP, pg8::StaticOrder>(F.lds, g, S, E); } }
    if (IN(7)) { p7_routing(F); }
    GSYNC(7);
    if (IN(8)) { p8u_sliced<0>(F); xcd_barrier(bar); p8c_combine(F); }
    GSYNC(8);
    if (IN(9)) { p8v_experts<1>(F); }

#undef IN
#undef GSYNC
}
}

extern "C" void kernel_launch(void* const* d_in, const int* in_sizes, int n_in, void* d_out, int out_size, void* d_ws, size_t ws_size, hipStream_t stream) {
    static int grid = 0;
    if (grid == 0) {
        if (n_in != 15 || out_size != mk::MREAL * 1024 || ws_size < mk::WS_END) { fprintf(stderr, "kernel_launch: unexpected problem (n_in %d out %d ws %zu)\n", n_in, out_size, ws_size); grid = -1; return; }
        int dev = 0, cus = 0;
        if (hipGetDevice(&dev) != hipSuccess || hipDeviceGetAttribute(&cus, hipDeviceAttributeMultiprocessorCount, dev) != hipSuccess) { grid = -1; return; }
        if (hipFuncSetAttribute((const void*)mk::mk_fwd, hipFuncAttributeMaxDynamicSharedMemorySize, mk::LDS_BYTES) != hipSuccess) { fprintf(stderr, "kernel_launch: hipFuncSetAttribute failed\n"); grid = -1; return; }
        int per_cu = 0;
        if (hipOccupancyMaxActiveBlocksPerMultiprocessor(&per_cu, (const void*)mk::mk_fwd, mk::NTHR, mk::LDS_BYTES) != hipSuccess || per_cu < 1) { fprintf(stderr, "kernel_launch: occupancy query says %d\n", per_cu); grid = -1; return; }
        grid = cus;
    }
    if (grid < 0) return;
    if (hipMemsetAsync((char*)d_ws + mk::WS_CTL, 0, 32768, stream) != hipSuccess) { fprintf(stderr, "kernel_launch: memset failed\n"); return; }
    mk::Args a{};
    for (int i = 0; i < 15; ++i) a.in[i] = (const float*)d_in[i];
    a.out = (float*)d_out; a.ws = (unsigned char*)d_ws; a.ph_lo = 0; a.ph_hi = mk::NPHASE;
    void* kargs[] = {&a};
    hipError_t e = hipLaunchCooperativeKernel((const void*)mk::mk_fwd, dim3(grid), dim3(mk::NTHR), kargs, mk::LDS_BYTES, stream);
    if (e != hipSuccess) fprintf(stderr, "kernel_launch: cooperative launch failed: %s (grid %d)\n", hipGetErrorString(e), grid);

}
```

```cpp
#include <hip/hip_runtime.h>
#include <cstdio>
#include <cstdint>
namespace pg8 {
#define PG8_LAS __attribute__((address_space(3)))
typedef unsigned short bf16_t;
typedef short bf16x8 __attribute__((ext_vector_type(8)));
typedef float f32x4 __attribute__((ext_vector_type(4)));
typedef unsigned u32x4 __attribute__((ext_vector_type(4)));
constexpr int BM = 256, BK = 64, HALF = 128, HTB = HALF * BK * 2  , STAGE_BYTES = 8 * HTB, NXCD = 8, WGM = 8;

__host__ __device__ __forceinline__ int lds_byte(int r, int c) { const int st = (r >> 4) * 2 + (c >> 5), rr = r & 15, cc = c & 31, ob = rr * 64 + cc * 2; return st * 1024 + (ob ^ (((ob >> 9) & 1) << 5)); }
__host__ __device__ __forceinline__ void stage_rc(int b, int& R, int& C) { const int st = b / 1024, sb = b % 1024, swz = sb ^ (((sb >> 9) & 1) << 5); R = (st >> 1) * 16 + swz / 64; C = (st & 1) * 32 + (swz % 64) / 2; }
__host__ __device__ __forceinline__ int perm32(int rho) { const int n = rho >> 4, i = rho & 15; return 8 * (i >> 2) + 4 * n + (i & 3); }

struct Unit { int pm, pn; };
struct Gemm { const bf16_t* A; const bf16_t* Bt; int M, N, K; };
struct StaticOrder {
    int nM, nN, nwg, G, c;
    __host__ __device__ void init(int M, int N, int G_, int c_) { nM = M / BM; nN = N / BM; nwg = nM * nN; G = G_; c = c_; }
    __host__ __device__ bool next(int i, Unit& u) const {
        const long L = (long)i * G + c; if (L >= nwg) return false;
        int wgid = (int)L; { const int q = nwg / NXCD, r = nwg % NXCD, xcd = wgid % NXCD, off = wgid / NXCD; wgid = (xcd < r ? xcd * (q + 1) : r * (q + 1) + (xcd - r) * q) + off; }
        const int nig = WGM * nN, gid = wgid / nig, fm = gid * WGM, gsz = (nM - fm) < WGM ? (nM - fm) : WGM;
        u.pm = fm + ((wgid % nig) % gsz); u.pn = (wgid % nig) / gsz; return true;
    }
    __device__ __forceinline__ void a_ready(const Unit&) const {}
    __device__ __forceinline__ void done(const Unit&) const {}
};
__device__ __forceinline__ unsigned cvt_pk_bf16(float lo, float hi) { unsigned r; asm volatile("v_cvt_pk_bf16_f32 %0, %1, %2" : "=v"(r) : "v"(lo), "v"(hi)); return r; }
template <class Epi, class Sched>
__device__ __forceinline__ void gemm_phase(PG8_LAS unsigned char* lds, const Gemm g, const Sched& S, const Epi& E) {
    int tid_ = threadIdx.x; asm volatile("" : "+v"(tid_));
    const int tid = tid_, wid = __builtin_amdgcn_readfirstlane(tid >> 6), lane = tid & 63, wr = wid >> 2, wc = wid & 3, fr = lane & 15, fq = lane >> 4;
    const int K = g.K, nt = K / BK;
    unsigned voffA[2], voffB[2];
#pragma unroll
    for (int i = 0; i < 2; ++i) { int R, C; stage_rc(tid * 16 + i * 8192, R, C); const int Rb = Epi::PERM ? ((R & ~31) + perm32(R & 31)) : R;
        voffA[i] = (unsigned)(R * K + C) * 2u; voffB[i] = (unsigned)(Rb * K + C) * 2u; }
    const size_t kstep = (size_t)(BK * 2);
    const size_t hstep = (size_t)HALF * K * 2;
    const size_t tstep = 2 * hstep;
    const unsigned ldsw = (unsigned)wid * 1024u;
    const int aoff = lds_byte(wr * 64 + fr, fq * 8), boff = lds_byte(wc * 32 + fr, fq * 8);
#define PG8_SA(b, h) (((b) * 2 + (h)) * HTB)
#define PG8_SB(b, h) ((4 + (b) * 2 + (h)) * HTB)
#define PG8_STAGE(bufoff, gbase, voff) do { _Pragma("unroll") for (int _i = 0; _i < 2; ++_i) \
        __builtin_amdgcn_global_load_lds((const unsigned*)((const char*)(gbase) + (voff)[_i]), (PG8_LAS unsigned*)(lds + (bufoff) + ldsw + _i * 8192), 16, 0, 0); } while (0)
#define PG8_LDA(dst, b, h) do { _Pragma("unroll") for (int m = 0; m < 4; ++m) _Pragma("unroll") for (int k = 0; k < 2; ++k) dst[m][k] = *(const PG8_LAS bf16x8*)(lds + PG8_SA(b, h) + aoff + m * 2048 + k * 1024); } while (0)
#define PG8_LDB(dst, b, h) do { _Pragma("unroll") for (int n = 0; n < 2; ++n) _Pragma("unroll") for (int k = 0; k < 2; ++k) dst[n][k] = *(const PG8_LAS bf16x8*)(lds + PG8_SB(b, h) + boff + n * 2048 + k * 1024); } while (0)
#define PG8_MMA(ai, bj, At, Bt) do { __builtin_amdgcn_s_setprio(1); _Pragma("unroll") for (int m = 0; m < 4; ++m) _Pragma("unroll") for (int n = 0; n < 2; ++n) _Pragma("unroll") for (int k = 0; k < 2; ++k) \
        acc[ai][bj][m][n] = __builtin_amdgcn_mfma_f32_16x16x32_bf16(Bt[n][k], At[m][k], acc[ai][bj][m][n], 0, 0, 0); __builtin_amdgcn_s_setprio(0); } while (0)
#define PG8_WAIT_V(n) asm volatile("s_waitcnt vmcnt(" #n ")" ::: "memory")
#define PG8_WAIT_L(n) asm volatile("s_waitcnt lgkmcnt(" #n ")" ::: "memory")
#define PG8_BAR __builtin_amdgcn_s_barrier()
#define PG8_SCHED __builtin_amdgcn_sched_barrier(0)
    Unit cur, nxt; int ui = 0;
    if (!S.next(0, cur)) return;
    f32x4 acc[2][2][4][2];
#pragma unroll
    for (int a = 0; a < 2; ++a)
#pragma unroll
        for (int b = 0; b < 2; ++b)
#pragma unroll
            for (int m = 0; m < 4; ++m)
#pragma unroll
                for (int n = 0; n < 2; ++n) acc[a][b][m][n] = (f32x4){0.f, 0.f, 0.f, 0.f};
    bf16x8 At[4][2], B0[2][2], B1[2][2];
    const char* cA = (const char*)g.A + (size_t)cur.pm * tstep; const char* cB = (const char*)g.Bt + (size_t)cur.pn * tstep;
    S.a_ready(cur);
    PG8_STAGE(PG8_SB(0, 0), cB, voffB); PG8_STAGE(PG8_SA(0, 0), cA, voffA); PG8_STAGE(PG8_SB(0, 1), cB + hstep, voffB); PG8_STAGE(PG8_SA(0, 1), cA + hstep, voffA);
    if (wr == 1) PG8_BAR;
    PG8_WAIT_V(4); PG8_BAR;
    PG8_STAGE(PG8_SB(1, 0), cB + kstep, voffB); PG8_STAGE(PG8_SA(1, 0), cA + kstep, voffA); PG8_STAGE(PG8_SB(1, 1), cB + hstep + kstep, voffB);
    PG8_WAIT_V(6); PG8_BAR;
    for (;;) {
        const bool has_next = S.next(ui + 1, nxt);
        const char* nA = has_next ? (const char*)g.A + (size_t)nxt.pm * tstep : cA; const char* nB = has_next ? (const char*)g.Bt + (size_t)nxt.pn * tstep : cB;
        for (int t = 0; t < nt; t += 2) {
            const bool last = (t == nt - 2);
            const char* a1 = cA + (size_t)(t + 1) * kstep;
            const char* a2 = last ? nA : cA + (size_t)(t + 2) * kstep; const char* b2 = last ? nB : cB + (size_t)(t + 2) * kstep;
            const char* a3 = a2 + kstep; const char* b3 = b2 + kstep;
            if (last && has_next) S.a_ready(nxt);
            PG8_LDB(B0, 0, 0); PG8_SCHED; PG8_LDA(At, 0, 0); PG8_STAGE(PG8_SA(1, 1), a1 + hstep, voffA);
            PG8_WAIT_L(8); PG8_BAR; PG8_WAIT_L(0); PG8_MMA(0, 0, At, B0); PG8_BAR; PG8_SCHED;
            PG8_LDB(B1, 0, 1); PG8_STAGE(PG8_SB(0, 0), b2, voffB);
            PG8_BAR; PG8_WAIT_L(0); PG8_MMA(0, 1, At, B1); PG8_BAR;
            PG8_LDA(At, 0, 1); PG8_STAGE(PG8_SA(0, 0), a2, voffA);
            PG8_BAR; PG8_WAIT_L(0); PG8_MMA(1, 0, At, B0); PG8_BAR; PG8_SCHED;
            PG8_STAGE(PG8_SB(0, 1), b2 + hstep, voffB);
            PG8_WAIT_V(6); PG8_BAR; PG8_MMA(1, 1, At, B1); PG8_BAR;
            PG8_LDB(B0, 1, 0); PG8_SCHED; PG8_LDA(At, 1, 0); PG8_STAGE(PG8_SA(0, 1), a2 + hstep, voffA);
            PG8_WAIT_L(8); PG8_BAR; PG8_WAIT_L(0); PG8_MMA(0, 0, At, B0); PG8_BAR; PG8_SCHED;
            PG8_LDB(B1, 1, 1); PG8_STAGE(PG8_SB(1, 0), b3, voffB);
            PG8_BAR; PG8_WAIT_L(0); PG8_MMA(0, 1, At, B1); PG8_BAR;
            PG8_LDA(At, 1, 1); PG8_STAGE(PG8_SA(1, 0), a3, voffA);
            PG8_BAR; PG8_WAIT_L(0); PG8_MMA(1, 0, At, B0); PG8_BAR; PG8_SCHED;
            PG8_STAGE(PG8_SB(1, 1), b3 + hstep, voffB);
            PG8_WAIT_V(6); PG8_BAR; PG8_MMA(1, 1, At, B1); PG8_BAR;
        }
        if constexpr (!Epi::AFTER_DRAIN) { E(acc, cur, wr, wc, fr, fq); S.done(cur); }
        if (!has_next) break;
#pragma unroll
        for (int a = 0; a < 2; ++a)
#pragma unroll
            for (int b = 0; b < 2; ++b)
#pragma unroll
                for (int m = 0; m < 4; ++m)
#pragma unroll
                    for (int n = 0; n < 2; ++n) acc[a][b][m][n] = (f32x4){0.f, 0.f, 0.f, 0.f};
        cur = nxt; cA = nA; cB = nB; ++ui;
    }
    PG8_WAIT_V(0);
    if (wr == 0) PG8_BAR;
    PG8_BAR;
    if constexpr (Epi::AFTER_DRAIN) { E.fused(acc, cur, wr, wc, fr, fq, lds, wid, lane); S.done(cur); }
#undef PG8_SA
#undef PG8_SB
#undef PG8_STAGE
#undef PG8_LDA
#undef PG8_LDB
#undef PG8_MMA
#undef PG8_WAIT_V
#undef PG8_WAIT_L
#undef PG8_BAR
#undef PG8_SCHED
}
}
#define XB_TMO      128
#define XB_XCNT(j)  (256  + 64 * (j))
#define XB_XSUB(j)  (1280 + 64 * (j))
#define XB_XGEN(j)  (2304 + 64 * (j))
#define XB_TOP      3328
#define XB_TOPGEN   3392
#define XCD_BAR_WORDS 3456
#define XB_SPIN_CAP (1u << 18)

__device__ __forceinline__ unsigned xb_ld(unsigned* p)              { return __hip_atomic_load(p, __ATOMIC_RELAXED, __HIP_MEMORY_SCOPE_AGENT); }
__device__ __forceinline__ unsigned xb_add(unsigned* p, unsigned v) { return __hip_atomic_fetch_add(p, v, __ATOMIC_RELAXED, __HIP_MEMORY_SCOPE_AGENT); }
__device__ __forceinline__ unsigned xb_xcc_id() { return (unsigned)__builtin_amdgcn_s_getreg((3 << 11) | 20) & 0xFu; }
#define XB_SPIN(cond, bar) do { unsigned _sp = 0; while (cond) { __builtin_amdgcn_s_sleep(1); \
    if ((++_sp & 255u) == 0u) { if (xb_ld(&(bar)[XB_TMO])) break; if (_sp > XB_SPIN_CAP) { atomicAdd(&(bar)[XB_TMO], 1u); break; } } } } while (0)

struct XcdBarrier {
    unsigned* bar; unsigned x;
    volatile __attribute__((address_space(3))) unsigned* st;
};

__device__ __forceinline__ XcdBarrier xcd_barrier_post(unsigned* bar, volatile __attribute__((address_space(3))) unsigned* st) {
    XcdBarrier b; b.bar = bar; b.x = xb_xcc_id(); b.st = st;
    if (threadIdx.x == 0) (void)xb_add(&bar[XB_XCNT(b.x)], 1u);
    return b;
}
__device__ __forceinline__ void xcd_barrier_complete(unsigned* bar, unsigned x, unsigned& nloc, unsigned& nx) {
    const unsigned G = gridDim.x * gridDim.y * gridDim.z;
    unsigned sum, cnt, mine, sp = 0u;
    for (;;) {
        sum = 0u; cnt = 0u; mine = 0u;
#pragma unroll
        for (unsigned j = 0; j < 16; ++j) { const unsigned c = xb_ld(&bar[XB_XCNT(j)]); sum += c; cnt += (c > 0u) ? 1u : 0u; mine = (j == x) ? c : mine; }
        if (sum == G) break;
        __builtin_amdgcn_s_sleep(1);
        if ((++sp & 255u) == 0u) { if (xb_ld(&bar[XB_TMO])) break; if (sp > XB_SPIN_CAP) { atomicAdd(&bar[XB_TMO], 1u); break; } }
    }
    nloc = mine > 0u ? mine : 1u; nx = cnt > 0u ? cnt : 1u;
}

__device__ __forceinline__ void xcd_barrier(const XcdBarrier& b) {
    asm volatile("s_waitcnt vmcnt(0)" ::: "memory");
    __syncthreads();
    if (threadIdx.x == 0) {
        unsigned* bar = b.bar;
        __builtin_amdgcn_s_waitcnt(0);
        unsigned nloc = b.st[0], nx = b.st[1];
        if (nloc == 0u) { xcd_barrier_complete(bar, b.x, nloc, nx); b.st[0] = nloc; b.st[1] = nx; }
        const unsigned old = xb_add(&bar[XB_XSUB(b.x)], 1u);
        const unsigned gen = old / nloc;
        if (old + 1u == (gen + 1u) * nloc) {
            __builtin_amdgcn_fence(__ATOMIC_RELEASE, "agent");
            asm volatile("s_waitcnt vmcnt(0)" ::: "memory");
            const unsigned og = xb_add(&bar[XB_TOP], 1u);
            const unsigned tg = og / nx;
            if (og + 1u == (tg + 1u) * nx) xb_add(&bar[XB_TOPGEN], 1u);
            else XB_SPIN(xb_ld(&bar[XB_TOPGEN]) == tg, bar);
            __builtin_amdgcn_fence(__ATOMIC_ACQUIRE, "agent");
            xb_add(&bar[XB_XGEN(b.x)], 1u);
            asm volatile("s_waitcnt vmcnt(0)" ::: "memory");
        } else {
            XB_SPIN(xb_ld(&bar[XB_XGEN(b.x)]) == gen, bar);
            __builtin_amdgcn_fence(__ATOMIC_ACQUIRE, "agent");
            asm volatile("s_waitcnt vmcnt(0)" ::: "memory");
        }
    }
    __syncthreads();
}

namespace mk {
using pg8::bf16_t; using pg8::bf16x8; using pg8::f32x4; using pg8::u32x4; using pg8::cvt_pk_bf16;
typedef float f32x16 __attribute__((ext_vector_type(16)));
typedef unsigned u32x2 __attribute__((ext_vector_type(2)));
typedef short s16x4 __attribute__((ext_vector_type(4)));
#define LAS __attribute__((address_space(3)))
#define MFMA32(a, b, c) __builtin_amdgcn_mfma_f32_32x32x16_bf16((a), (b), (c), 0, 0, 0)

constexpr int DM = 1024, NB = 8, SEQ = 2048, TT = 2064, NMETA = 16;
constexpr int MREAL = NB * SEQ, MROWS = MREAL + NMETA, MPAD = 16640;
constexpr int NZ = 2632, NZP = 2816;
constexpr int OFF_Q = 0, OFF_K = 512, OFF_V = 1024, OFF_POOL = 1536, OFF_IQ = 2048, OFF_IK = 2560, OFF_IW = 2624;
constexpr int NEXP = 16384;
constexpr float RMS_EPS = 1e-6f, LOG2E = 1.4426950408889634f;
constexpr int NTHR = 512, LDS_BYTES = 163840;
constexpr int MASKW = 68;
constexpr int SCW = 2112;

constexpr size_t WS_CTL = 0;
constexpr size_t WS_SUMSQ = 65536;
constexpr size_t WS_WIN = WS_SUMSQ + 65536;
constexpr size_t WS_WOUT = WS_WIN + (size_t)NZP * 1024 * 2;
constexpr size_t WS_WQ = WS_WOUT + (size_t)1024 * 1024 * 2;
constexpr size_t WS_SK = WS_WQ + (size_t)2048 * 1024 * 2;
constexpr size_t WS_KI = WS_SK + 65536;
constexpr size_t WS_WI = WS_KI + (size_t)NB * TT * 64 * 2;
constexpr size_t WS_MASK = WS_WI + (size_t)MREAL * 8 * 4;
constexpr size_t WS_XN = WS_MASK + (size_t)MREAL * MASKW * 4;
constexpr size_t WS_MIX = WS_XN + (size_t)MPAD * 1024 * 2;
constexpr size_t WS_Q = WS_MIX + (size_t)MREAL * 1024 * 2;
constexpr size_t WS_K = WS_Q + (size_t)MREAL * 512 * 2;
constexpr size_t WS_VV = WS_K + (size_t)NB * TT * 512 * 2;
constexpr size_t WS_QI = WS_VV + (size_t)NB * TT * 512 * 2;
constexpr size_t WS_UP = WS_QI + (size_t)MREAL * 512 * 2;
constexpr size_t WS_U8 = WS_UP + (size_t)MROWS * 512 * 2;
constexpr size_t WS_SCL = WS_U8 + (size_t)NEXP * 1024;
constexpr size_t WS_C = WS_SCL + 131072;
constexpr size_t WS_V8 = WS_C + (size_t)MREAL * 128 * 4;
constexpr size_t WS_H1B = WS_V8 + (size_t)NEXP * 1024;
constexpr size_t WS_EID = WS_H1B + (size_t)MREAL * 1024 * 2;
constexpr size_t WS_TW = WS_EID + (size_t)MREAL * 128 * 8;
constexpr size_t WS_END = WS_TW + (size_t)1024 * 512 * 2;
constexpr size_t WS_QP = WS_Q;
static_assert(WS_END <= 268435456ull, "workspace");
static_assert((WS_MASK % 16) == 0 && (WS_XN % 256) == 0 && (WS_UP % 256) == 0 && (WS_K % 256) == 0 && (WS_U8 % 256) == 0, "align");
static_assert(WS_QP + (size_t)MREAL * 2048 * 2 <= WS_UP, "QP fits over Q..QI");
static_assert(WS_MIX == WS_XN + (size_t)MPAD * 1024 * 2 && WS_XN + (size_t)8 * MREAL * 128 * 4 <= WS_Q, "PART (f32 [8][16384][128]) fits over XN | MIX (dead after the input / output projections)");

struct Args { const float* in[15]; float* out; unsigned char* ws; int ph_lo, ph_hi; };

struct Frame {
    const float *x, *meta, *g1, *w_in, *gq, *gk, *pool_w, *pool_scale, *w_out, *g2, *wq, *sk1, *sk2, *pu, *pv;
    float* out; unsigned char* ws; LAS unsigned char* lds;
    int tid, lane, wave, G, bid;
#define WSPTR(name, type, off) __device__ __forceinline__ type* name() const { return (type*)(ws + (off)); }
    WSPTR(SUMSQ, float, WS_SUMSQ) WSPTR(WIN, bf16_t, WS_WIN) WSPTR(WOUT, bf16_t, WS_WOUT) WSPTR(WQ, bf16_t, WS_WQ) WSPTR(SK, bf16_t, WS_SK)
    WSPTR(KI, bf16_t, WS_KI) WSPTR(WI, float, WS_WI) WSPTR(MASK, unsigned, WS_MASK) WSPTR(XN, bf16_t, WS_XN) WSPTR(H1B, bf16_t, WS_H1B) WSPTR(MIX, bf16_t, WS_MIX)
    WSPTR(Q, bf16_t, WS_Q) WSPTR(K, bf16_t, WS_K) WSPTR(VV, bf16_t, WS_VV) WSPTR(QI, bf16_t, WS_QI) WSPTR(UP, bf16_t, WS_UP) WSPTR(QP, bf16_t, WS_QP)
    WSPTR(U8, unsigned char, WS_U8) WSPTR(V8, unsigned char, WS_V8) WSPTR(SU, float, WS_SCL) WSPTR(SV, float, WS_SCL + NEXP * 4)
    WSPTR(TW, bf16_t, WS_TW) WSPTR(PART, bf16_t  , WS_XN) WSPTR(EID, bf16_t  , WS_EID) WSPTR(GATE, float, WS_EID + (size_t)MREAL * 128 * 4) WSPTR(CB, bf16_t  , WS_C)
#undef WSPTR
};


__device__ __forceinline__ int fresh(int v) { asm volatile("" : "+v"(v)); return v; }
__device__ __forceinline__ bf16_t f2bf(float f) { return (bf16_t)(cvt_pk_bf16(f, 0.f) & 0xffffu); }
__device__ __forceinline__ float bf2f(bf16_t b) { return __uint_as_float(((unsigned)b) << 16); }
__device__ __forceinline__ float bflo(unsigned w) { return __uint_as_float(w << 16); }
__device__ __forceinline__ float bfhi(unsigned w) { return __uint_as_float(w & 0xffff0000u); }
__device__ __forceinline__ float wave_sum(float v) {
#pragma unroll
    for (int o = 32; o > 0; o >>= 1) v += __shfl_xor(v, o);
    return v; }
__device__ __forceinline__ float half_sum32(float v) {
#pragma unroll
    for (int o = 16; o > 0; o >>= 1) v += __shfl_xor(v, o);
    return v; }

__host__ __device__ __forceinline__ int win_src_col(int np) {
    const int pn = np >> 8, cl = np & 255, bj = cl >> 7, wc = (cl >> 5) & 3, w = cl & 31;
    if (pn < 2) return OFF_Q + (4 * pn + wc) * 64 + 32 * bj + w;
    if (pn < 4) return OFF_K + (4 * (pn - 2) + wc) * 64 + 32 * bj + w;
    if (pn < 8) return np;
    if (pn < 10) return OFF_IQ + (4 * (pn - 8) + wc) * 64 + 32 * bj + w;
    if (wc == 0) return OFF_IK + 32 * bj + w;
    if (wc == 1 && bj == 0 && w < 8) return OFF_IW + w;
    return -1;
}
template <bool WINPERM>
__device__ __forceinline__ void transpose_tile(const Frame& F, LAS float* tile, const float* W, int ldw, int N, bf16_t* Wt, int ldt, const float* kscale, int k0, int n0) {
    const int lane = F.lane, kk = lane >> 4, n4 = (lane & 15) * 4;
    int src = n0 + n4; bool ok = src < N;
    if (WINPERM) { src = win_src_col(n0 + n4); ok = src >= 0; }
    f32x4 v[16];
#pragma unroll
    for (int p = 0; p < 16; ++p) { v[p] = (f32x4){0.f, 0.f, 0.f, 0.f}; if (ok) v[p] = *(const f32x4*)(W + (size_t)(k0 + 4 * p + kk) * ldw + src); }
#pragma unroll
    for (int p = 0; p < 16; ++p) { const float s = kscale ? kscale[k0 + 4 * p + kk] : 1.f;
#pragma unroll
        for (int i = 0; i < 4; ++i) tile[(4 * p + kk) * 65 + n4 + i] = v[p][i] * s; }
#pragma unroll
    for (int k8 = 0; k8 < 8; ++k8) { float x[8];
#pragma unroll
        for (int i = 0; i < 8; ++i) x[i] = tile[(8 * k8 + i) * 65 + lane];
        u32x4 w; w.x = cvt_pk_bf16(x[0], x[1]); w.y = cvt_pk_bf16(x[2], x[3]); w.z = cvt_pk_bf16(x[4], x[5]); w.w = cvt_pk_bf16(x[6], x[7]);
        *(u32x4*)(Wt + (size_t)(n0 + lane) * ldt + k0 + 8 * k8) = w; }
}

__device__ __forceinline__ void p0_prologue(const Frame& F) {
    const int gtid = F.bid * NTHR + F.tid, gsz = F.G * NTHR, lane = F.lane;
    const int gw = F.bid * 8 + F.wave, nw = F.G * 8;
    for (int u = gw; u < MPAD / 4; u += nw) {
        f32x4 v[4][4]; float ss[4];
#pragma unroll
        for (int r = 0; r < 4; ++r) { const int row = 4 * u + r;
            const float* src = row < MREAL ? F.x + (size_t)row * 1024 : F.meta + (size_t)(row < MROWS ? row - MREAL : 0) * 1024;
#pragma unroll
            for (int i = 0; i < 4; ++i) v[r][i] = *(const f32x4*)(src + 256 * i + 4 * lane); }
        f32x4 g[4];
#pragma unroll
        for (int i = 0; i < 4; ++i) g[i] = *(const f32x4*)(F.g1 + 256 * i + 4 * lane);
#pragma unroll
        for (int r = 0; r < 4; ++r) { float s = 0.f;
#pragma unroll
            for (int i = 0; i < 4; ++i) s += v[r][i][0] * v[r][i][0] + v[r][i][1] * v[r][i][1] + v[r][i][2] * v[r][i][2] + v[r][i][3] * v[r][i][3];
            ss[r] = s; }
#pragma unroll
        for (int o = 32; o > 0; o >>= 1) {
#pragma unroll
            for (int r = 0; r < 4; ++r) ss[r] += __shfl_xor(ss[r], o); }
#pragma unroll
        for (int r = 0; r < 4; ++r) { const int row = 4 * u + r; const float rs = row < MROWS ? rsqrtf(ss[r] * (1.f / 1024.f) + RMS_EPS) : 0.f;
            bf16_t* dst = F.XN() + (size_t)row * 1024;
#pragma unroll
            for (int i = 0; i < 4; ++i) { u32x2 w; w.x = cvt_pk_bf16(v[r][i][0] * rs * g[i][0], v[r][i][1] * rs * g[i][1]); w.y = cvt_pk_bf16(v[r][i][2] * rs * g[i][2], v[r][i][3] * rs * g[i][3]);
                *(u32x2*)(dst + 256 * i + 4 * lane) = w; } }
    }
    { LAS float* tile = (LAS float*)F.lds + F.wave * (64 * 65);
      for (int t = gw; t < 704 + 256 + 512; t += nw) {
          if (t < 704) transpose_tile<true>(F, tile, F.w_in, NZ, NZ, F.WIN(), 1024, nullptr, (t & 15) * 64, (t >> 4) * 64);
          else if (t < 960) { const int q = t - 704, kt = q & 15;
              if (kt < 8) transpose_tile<false>(F, tile, F.w_out, 1024, 1024, F.WOUT(), 1024, nullptr, kt * 64, (q >> 4) * 64);
              else transpose_tile<false>(F, tile, F.w_out + (size_t)512 * 1024, 1024, 1024, F.TW(), 512, nullptr, (kt - 8) * 64, (q >> 4) * 64); }
          else { const int q = t - 960; transpose_tile<false>(F, tile, F.wq, 2048, 2048, F.WQ(), 1024, F.g2, (q & 15) * 64, (q >> 4) * 64); } } }
    for (int idx = gtid; idx < 2 * 128 * 128; idx += gsz) F.SK()[idx] = f2bf(idx < 16384 ? F.sk1[idx] : F.sk2[idx - 16384]);
    for (int idx = gtid; idx < MREAL; idx += gsz) F.SUMSQ()[idx] = 0.f;
}

__device__ __forceinline__ float sum_rows4(float s) {
    auto a = __builtin_amdgcn_permlane16_swap(__float_as_uint(s), __float_as_uint(s), false, false); s = __uint_as_float(a[0]) + __uint_as_float(a[1]);
    auto c = __builtin_amdgcn_permlane32_swap(__float_as_uint(s), __float_as_uint(s), false, false); return __uint_as_float(c[0]) + __uint_as_float(c[1]); }
struct EpiIn {
    static constexpr bool PERM = true, AFTER_DRAIN = false;
    bf16_t *Q, *K, *VV, *QI, *KI, *UP; float* WI; const float *gq, *gk;
    __device__ __forceinline__ static u32x4 pk8(const f32x4 a, const f32x4 b) { u32x4 w; w.x = cvt_pk_bf16(a[0], a[1]); w.y = cvt_pk_bf16(a[2], a[3]); w.z = cvt_pk_bf16(b[0], b[1]); w.w = cvt_pk_bf16(b[2], b[3]); return w; }
    __device__ __forceinline__ void operator()(const f32x4 (&acc)[2][2][4][2], const pg8::Unit& u, int wr, int wc, int fr, int fq) const {
        const int pn = u.pn;
        const int kind = pn < 2 ? 0 : pn < 4 ? 1 : pn < 6 ? 2 : pn < 8 ? 3 : pn < 10 ? 4 : 5;
        const bool headk = (kind <= 1) || kind == 4 || (kind == 5 && wc == 0);
        const float* gp = (kind == 1 ? gk : gq) + 8 * fq;
        const int head = 4 * (pn & 1) + wc;
        float frq[2][4];
#pragma unroll
        for (int n = 0; n < 2; ++n)
#pragma unroll
            for (int i = 0; i < 4; ++i) frq[n][i] = __builtin_amdgcn_exp2f(-(float)(8 * fq + 4 * n + i) * 0.41524101186092029f) * 0.15915494309189535f;
#pragma unroll
        for (int ai = 0; ai < 2; ++ai)
#pragma unroll
            for (int m = 0; m < 4; ++m) {
                int row_ = u.pm * 256 + ai * 128 + wr * 64 + m * 16 + fr; asm volatile("" : "+v"(row_));
                const int row = row_;
                const bool real = row < MREAL, valid = row < MROWS;
                const int b = real ? row >> 11 : 0, pos = real ? (row & 2047) + NMETA : (valid ? row - MREAL : 0);
                f32x4 v[2][2];
#pragma unroll
                for (int bj = 0; bj < 2; ++bj)
#pragma unroll
                    for (int n = 0; n < 2; ++n) v[bj][n] = acc[ai][bj][m][n];
                if (kind <= 1) {
                    float ss = 0.f;
#pragma unroll
                    for (int bj = 0; bj < 2; ++bj)
#pragma unroll
                        for (int n = 0; n < 2; ++n) ss += v[bj][n][0] * v[bj][n][0] + v[bj][n][1] * v[bj][n][1] + v[bj][n][2] * v[bj][n][2] + v[bj][n][3] * v[bj][n][3];
                    ss = sum_rows4(ss);
                    const float rs = rsqrtf(ss * (1.f / 64.f) + RMS_EPS);
#pragma unroll
                    for (int bj = 0; bj < 2; ++bj)
#pragma unroll
                        for (int n = 0; n < 2; ++n) v[bj][n] = v[bj][n] * (kind == 0 ? rs * (0.125f * LOG2E) : rs) * *(const f32x4*)(gp + 32 * bj + 4 * n);
                }
                if (headk) {
                    const float fpos = (float)pos;
#pragma unroll
                    for (int n = 0; n < 2; ++n) { f32x4 cs, sn;
#pragma unroll
                        for (int i = 0; i < 4; ++i) { const float rev = __builtin_amdgcn_fractf(fpos * frq[n][i]); cs[i] = __builtin_amdgcn_cosf(rev); sn[i] = __builtin_amdgcn_sinf(rev); }
                        const f32x4 x1 = v[0][n], x2 = v[1][n];
                        v[0][n] = x1 * cs - x2 * sn; v[1][n] = x2 * cs + x1 * sn; }
                }
                if (kind == 0 || kind == 4) { if (real) { bf16_t* d = (kind ? QI : Q) + (size_t)row * 512 + head * 64 + 8 * fq;
#pragma unroll
                        for (int bj = 0; bj < 2; ++bj) *(u32x4*)(d + 32 * bj) = pk8(v[bj][0], v[bj][1]); } }
                else if (kind == 1 || kind == 2) { if (valid) { const int col = (kind == 1 ? head * 64 : (pn - 4) * 256 + 32 * wc) + 8 * fq; const int cstep = kind == 1 ? 32 : 128; bf16_t* base = kind == 1 ? K : VV;
                        const int nrep = real ? 1 : NB;
                        for (int rb = 0; rb < nrep; ++rb) { bf16_t* d = base + (size_t)((real ? b : rb) * TT + pos) * 512 + col;
#pragma unroll
                            for (int bj = 0; bj < 2; ++bj) *(u32x4*)(d + cstep * bj) = pk8(v[bj][0], v[bj][1]); } } }
                else if (kind == 3) { if (valid) { bf16_t* d = UP + (size_t)row * 512 + (pn - 6) * 256 + 32 * wc + 8 * fq;
#pragma unroll
                        for (int bj = 0; bj < 2; ++bj) *(u32x4*)(d + 128 * bj) = pk8(v[bj][0], v[bj][1]); } }
                else {
                    if (wc == 0) { if (valid) { const int nrep = real ? 1 : NB;
                            for (int rb = 0; rb < nrep; ++rb) { bf16_t* d = KI + (size_t)((real ? b : rb) * TT + pos) * 64 + 8 * fq;
#pragma unroll
                                for (int bj = 0; bj < 2; ++bj) *(u32x4*)(d + 32 * bj) = pk8(v[bj][0], v[bj][1]); } } }
                    else if (wc == 1 && fq == 0 && real) { *(f32x4*)(WI + (size_t)row * 8) = v[0][0] * 0.044194173824159216f; *(f32x4*)(WI + (size_t)row * 8 + 4) = v[0][1] * 0.044194173824159216f; }
                }
                asm volatile("" ::: "memory");
            }
    }
};
struct EpiOut {
    static constexpr bool PERM = false, AFTER_DRAIN = false;
    const float* X; float* out; bf16_t* H1B; float* sumsq;
    __device__ __forceinline__ void operator()(const f32x4 (&acc)[2][2][4][2], const pg8::Unit& u, int wr, int wc, int fr, int fq) const {
        const int row0 = u.pm * 256 + wr * 64 + fr, col0 = u.pn * 256 + wc * 32 + 4 * fq;
#pragma unroll
        for (int ai = 0; ai < 2; ++ai)
#pragma unroll
            for (int m = 0; m < 4; ++m) { const int row = row0 + ai * 128 + m * 16; const size_t off = (size_t)row * 1024 + col0; float ss = 0.f;
#pragma unroll
                for (int bj = 0; bj < 2; ++bj)
#pragma unroll
                    for (int n = 0; n < 2; ++n) { const f32x4 xv = *(const f32x4*)(X + off + bj * 128 + n * 16); const f32x4 h = xv + acc[ai][bj][m][n];
                        u32x2 w; w.x = cvt_pk_bf16(h[0], h[1]); w.y = cvt_pk_bf16(h[2], h[3]); *(u32x2*)(H1B + off + bj * 128 + n * 16) = w;
                        ss += h[0] * h[0] + h[1] * h[1] + h[2] * h[2] + h[3] * h[3]; }
                ss = sum_rows4(ss);
                if (fq == 0) atomicAdd(sumsq + row, ss); }
    }
};
struct EpiQP {
    static constexpr bool PERM = true, AFTER_DRAIN = false;
    bf16_t* O; const float* sumsq;
    __device__ __forceinline__ void operator()(const f32x4 (&acc)[2][2][4][2], const pg8::Unit& u, int wr, int wc, int fr, int fq) const {
        const int row0 = u.pm * 256 + wr * 64 + fr, col0 = u.pn * 256 + wc * 32 + 8 * fq;
#pragma unroll
        for (int ai = 0; ai < 2; ++ai)
#pragma unroll
            for (int m = 0; m < 4; ++m) { const int row = row0 + ai * 128 + m * 16; bf16_t* rowp = O + (size_t)row * 2048 + col0;
                const float rs = rsqrtf(sumsq[row] * (1.f / 1024.f) + RMS_EPS);
#pragma unroll
                for (int bj = 0; bj < 2; ++bj) { const f32x4 v0 = acc[ai][bj][m][0] * rs, v1 = acc[ai][bj][m][1] * rs;
                    u32x4 w; w.x = cvt_pk_bf16(v0[0], v0[1]); w.y = cvt_pk_bf16(v0[2], v0[3]); w.z = cvt_pk_bf16(v1[0], v1[1]); w.w = cvt_pk_bf16(v1[2], v1[3]);
                    *(u32x4*)(rowp + bj * 128) = w; } }
    }
};

__device__ __forceinline__ int zrow_of(int b, int pos) { return pos < NMETA ? MREAL + pos : b * SEQ + pos - NMETA; }

__device__ __forceinline__ bf16_t f2bf_c(float f) { unsigned u = __float_as_uint(f); u += 0x7FFFu + ((u >> 16) & 1u); return (bf16_t)(u >> 16); }
__device__ __forceinline__ void p2_weff(const Frame& F) {
    const int lane = fresh((int)threadIdx.x) & 63, hk = lane >> 5, l31 = lane & 31;
    for (int t = F.bid * 8 + F.wave; t < 512; t += F.G * 8) {
        const int n0 = (t & 31) * 32, gc0 = (t >> 5) * 32, g = gc0 >> 7;
        f32x16 acc = {};
        const bf16_t* ap = F.TW() + (size_t)(n0 + l31) * 512 + g * 128 + 8 * hk;
        const float* bp = F.pool_w + (size_t)(gc0 + l31) * 128 + 8 * hk; const float* sp = F.pool_scale + g * 128 + 8 * hk;
#pragma unroll
        for (int ks = 0; ks < 8; ++ks) {
            const bf16x8 a = *(const bf16x8*)(ap + 16 * ks);
            const f32x4 w0 = *(const f32x4*)(bp + 16 * ks) * *(const f32x4*)(sp + 16 * ks), w1 = *(const f32x4*)(bp + 16 * ks + 4) * *(const f32x4*)(sp + 16 * ks + 4);
            u32x4 bw; bw.x = cvt_pk_bf16(w0[0], w0[1]); bw.y = cvt_pk_bf16(w0[2], w0[3]); bw.z = cvt_pk_bf16(w1[0], w1[1]); bw.w = cvt_pk_bf16(w1[2], w1[3]);
            acc = MFMA32(a, __builtin_bit_cast(bf16x8, bw), acc); }
#pragma unroll
        for (int r = 0; r < 16; ++r) F.WOUT()[(size_t)(n0 + (r & 3) + 8 * (r >> 2) + 4 * hk) * 1024 + 512 + gc0 + l31] = f2bf_c(acc[r]);
    }
}
__device__ __forceinline__ void p2_pool(const Frame& F) {
    const int lane = fresh((int)threadIdx.x) & 63, g = lane >> 4, w = 2 << g;
    const float iw = 1.f / (float)w;
    for (int row0 = (F.bid * 8 + F.wave) * 2; row0 < MREAL; row0 += F.G * 8 * 2) {
        u32x4 x[2][16];
#pragma unroll
        for (int r = 0; r < 2; ++r) { const int row = row0 + r, b = row >> 11, pos = (row & 2047) + NMETA;
#pragma unroll
            for (int ii = 0; ii < 16; ++ii) { x[r][ii] = (u32x4){0u, 0u, 0u, 0u};
                if (ii < w) x[r][ii] = *(const u32x4*)(F.UP() + (size_t)zrow_of(b, pos - ii) * 512 + 8 * lane); } }
#pragma unroll
        for (int r = 0; r < 2; ++r) { float sum[8];
#pragma unroll
            for (int i = 0; i < 8; ++i) sum[i] = 0.f;
#pragma unroll
            for (int ii = 0; ii < 16; ++ii) { const u32x4 v = x[r][ii];
                sum[0] += bflo(v.x); sum[1] += bfhi(v.x); sum[2] += bflo(v.y); sum[3] += bfhi(v.y); sum[4] += bflo(v.z); sum[5] += bfhi(v.z); sum[6] += bflo(v.w); sum[7] += bfhi(v.w); }
            const u32x4 v0 = x[r][0];
            u32x4 o; o.x = cvt_pk_bf16(sum[0] * iw - bflo(v0.x), sum[1] * iw - bfhi(v0.x)); o.y = cvt_pk_bf16(sum[2] * iw - bflo(v0.y), sum[3] * iw - bfhi(v0.y));
            o.z = cvt_pk_bf16(sum[4] * iw - bflo(v0.z), sum[5] * iw - bfhi(v0.z)); o.w = cvt_pk_bf16(sum[6] * iw - bflo(v0.w), sum[7] * iw - bfhi(v0.w));
            *(u32x4*)(F.MIX() + (size_t)(row0 + r) * 1024 + 512 + 8 * lane) = o; }
    }
}

__device__ __forceinline__ void indexer_item(const Frame& F, const int b, const int qt32) {
    constexpr int NTB = 65;
    const int lane = fresh((int)threadIdx.x) & 63, tid = (int)threadIdx.x, wv = F.wave, hk = lane >> 5, l31 = lane & 31;
    const int c = qt32 >> 1, nvis = 80 + 64 * c, ntile = 3 + 2 * c, nsteps = (ntile + 3) >> 2;
    const int qrow0 = b * SEQ + qt32 * 32 + 4 * wv;
    constexpr int NST = (NTB + 3) / 4;
    const int blk = l31 >> 3, hf = (l31 >> 2) & 1, e = l31 & 3;
    const int ql = 2 * hf + (blk >> 1), head = 4 * (blk & 1) + e;
    bf16x8 af[4];
    { const bf16_t* qip = F.QI() + (size_t)(qrow0 + ql) * 512 + head * 64 + 8 * hk;
#pragma unroll
      for (int ks = 0; ks < 4; ++ks) af[ks] = *(const bf16x8*)(qip + 16 * ks); }
    float wreg[16];
#pragma unroll
    for (int r = 0; r < 16; ++r) wreg[r] = F.WI()[(size_t)(qrow0 + 2 * hk + (r >> 3)) * 8 + (r & 7)];
    const int st_key = tid >> 3, st_c8 = tid & 7;
    const unsigned st_off = st_key * 128 + ((st_c8 ^ (st_key & 7)) * 16);
    const bf16_t* kisrc = F.KI() + (size_t)(b * TT) * 64 + st_c8 * 8;
    u32x4 sa, sb;
    { int k0 = st_key, k1 = 64 + st_key; sa = *(const u32x4*)(kisrc + (size_t)k0 * 64); sb = *(const u32x4*)(kisrc + (size_t)k1 * 64); }
    *(LAS u32x4*)(F.lds + st_off) = sa; *(LAS u32x4*)(F.lds + 8192 + st_off) = sb;
    if (nsteps > 1) { int k0 = 128 + st_key, k1 = 192 + st_key; k0 = k0 < TT ? k0 : TT - 1; k1 = k1 < TT ? k1 : TT - 1; sa = *(const u32x4*)(kisrc + (size_t)k0 * 64); sb = *(const u32x4*)(kisrc + (size_t)k1 * 64); }
    __syncthreads();
    unsigned comp[2][NTB];
#pragma unroll
    for (int st = 0; st < NST; ++st) {
        if (st < nsteps) {
            const int buf = st & 1;
            u32x4 na = sa, nb = sb;
            if (st + 2 < nsteps) { int k0 = 128 * (st + 2) + st_key, k1 = k0 + 64; k0 = k0 < TT ? k0 : TT - 1; k1 = k1 < TT ? k1 : TT - 1; na = *(const u32x4*)(kisrc + (size_t)k0 * 64); nb = *(const u32x4*)(kisrc + (size_t)k1 * 64); }
#pragma unroll
            for (int tl = 0; tl < 4; ++tl) { constexpr int dummy = 0; (void)dummy; const int j = 4 * st + tl;
                if (j < NTB) {
                    unsigned c0 = 0u, c1 = 0u;
                    if (j < ntile) {
                        LAS const unsigned char* kb = F.lds + buf * 16384 + (32 * tl + l31) * 128;
                        f32x16 acc = {};
#pragma unroll
                        for (int ks = 0; ks < 4; ++ks) { const bf16x8 bfr = *(LAS const bf16x8*)(kb + (((2 * ks + hk) ^ (l31 & 7)) * 16)); acc = MFMA32(af[ks], bfr, acc); }
                        float s0 = 0.f, s1 = 0.f;
#pragma unroll
                        for (int r = 0; r < 8; ++r) { s0 += wreg[r] * fmaxf(acc[r], 0.f); s1 += wreg[r + 8] * fmaxf(acc[r + 8], 0.f); }
                        const int key = 32 * j + l31;
                        if (key < nvis) { unsigned u0 = __float_as_uint(s0), u1 = __float_as_uint(s1); if (u0 == 0x80000000u) u0 = 0u; if (u1 == 0x80000000u) u1 = 0u;
                            c0 = ((u0 ^ ((u0 >> 31) ? 0xFFFFFFFFu : 0x80000000u)) & ~0xFFFu) | (unsigned)(4095 - key);
                            c1 = ((u1 ^ ((u1 >> 31) ? 0xFFFFFFFFu : 0x80000000u)) & ~0xFFFu) | (unsigned)(4095 - key); }
                    }
                    comp[0][j] = c0; comp[1][j] = c1;
                    __builtin_amdgcn_sched_barrier(0);
                } }
            if (st + 1 < nsteps) { *(LAS u32x4*)(F.lds + (buf ^ 1) * 16384 + st_off) = sa; *(LAS u32x4*)(F.lds + (buf ^ 1) * 16384 + 8192 + st_off) = sb; }
            sa = na; sb = nb;
            __syncthreads();
        } else {
#pragma unroll
            for (int tl = 0; tl < 4; ++tl) { const int j = 4 * st + tl; if (j < NTB) { comp[0][j] = 0u; comp[1][j] = 0u; } }
        }
    }
    unsigned tA0 = 1u, tA1 = 1u, tB0 = 1u, tB1 = 1u;
    if (nvis > 256) { tA0 = tA1 = tB0 = tB1 = 0u; bool dA0 = false, dA1 = false, dB0 = false, dB1 = false;
#pragma unroll 1
        for (int bit = 31; bit >= 0; --bit) {
            const unsigned m = 1u << bit;
            const unsigned cand0 = (hk ? tB0 : tA0) | m, cand1 = (hk ? tB1 : tA1) | m;
            int p0 = 0, p1 = 0;
#define IDX_CNT(LO, HI) _Pragma("unroll") for (int j = (LO); j < (HI); ++j) { p0 += (comp[0][j] >= cand0) ? 1 : 0; p1 += (comp[1][j] >= cand1) ? 1 : 0; }
            IDX_CNT(0, 17)
            if (ntile > 17) { IDX_CNT(17, 33) if (ntile > 33) { IDX_CNT(33, 49) if (ntile > 49) { IDX_CNT(49, 65) } } }
#undef IDX_CNT
            p0 += __builtin_amdgcn_update_dpp(0, p0, 0xB1, 0xF, 0xF, false); p1 += __builtin_amdgcn_update_dpp(0, p1, 0xB1, 0xF, 0xF, false);
            p0 += __builtin_amdgcn_update_dpp(0, p0, 0x4E, 0xF, 0xF, false); p1 += __builtin_amdgcn_update_dpp(0, p1, 0x4E, 0xF, 0xF, false);
            p0 += __builtin_amdgcn_update_dpp(0, p0, 0x141, 0xF, 0xF, false); p1 += __builtin_amdgcn_update_dpp(0, p1, 0x141, 0xF, 0xF, false);
            p0 += __builtin_amdgcn_update_dpp(0, p0, 0x140, 0xF, 0xF, false); p1 += __builtin_amdgcn_update_dpp(0, p1, 0x140, 0xF, 0xF, false);
            const int cA0 = __builtin_amdgcn_readlane(p0, 0) + __builtin_amdgcn_readlane(p0, 16), cB0 = __builtin_amdgcn_readlane(p0, 32) + __builtin_amdgcn_readlane(p0, 48);
            const int cA1 = __builtin_amdgcn_readlane(p1, 0) + __builtin_amdgcn_readlane(p1, 16), cB1 = __builtin_amdgcn_readlane(p1, 32) + __builtin_amdgcn_readlane(p1, 48);
            if (!dA0 && cA0 >= 256) { tA0 |= m; dA0 = (cA0 == 256); }
            if (!dA1 && cA1 >= 256) { tA1 |= m; dA1 = (cA1 == 256); }
            if (!dB0 && cB0 >= 256) { tB0 |= m; dB0 = (cB0 == 256); }
            if (!dB1 && cB1 >= 256) { tB1 |= m; dB1 = (cB1 == 256); }
            if (dA0 && dA1 && dB0 && dB1) break; } }
    const unsigned t0 = hk ? tB0 : tA0, t1 = hk ? tB1 : tA1;
    int mq[4] = {0, 0, 0, 0};
    unsigned w64[4] = {0u, 0u, 0u, 0u};
#pragma unroll
    for (int j = 0; j < NTB; ++j) { const unsigned long long m0 = __ballot(comp[0][j] >= t0), m1 = __ballot(comp[1][j] >= t1);
        if (j < 64) {
            asm volatile("v_writelane_b32 %0, %2, %4\n\tv_writelane_b32 %1, %3, %4" : "+v"(mq[0]), "+v"(mq[2]) : "s"((int)(unsigned)m0), "s"((int)(unsigned)(m0 >> 32)), "i"(j < 64 ? j : 0));
            asm volatile("v_writelane_b32 %0, %2, %4\n\tv_writelane_b32 %1, %3, %4" : "+v"(mq[1]), "+v"(mq[3]) : "s"((int)(unsigned)m1), "s"((int)(unsigned)(m1 >> 32)), "i"(j < 64 ? j : 0));
        } else { w64[0] = (unsigned)m0; w64[2] = (unsigned)(m0 >> 32); w64[1] = (unsigned)m1; w64[3] = (unsigned)(m1 >> 32); } }
#pragma unroll
    for (int q = 0; q < 4; ++q) { unsigned* mrow = F.MASK() + (size_t)(qrow0 + q) * MASKW;
        if (lane <= ntile + 2 && lane < 64) mrow[lane] = lane < ntile ? (unsigned)mq[q] : 0u;
        if (lane < 4 && 64 + lane <= ntile + 2) mrow[64 + lane] = (64 + lane < ntile) ? w64[q] : 0u; }
    __syncthreads();
}

__device__ __forceinline__ void p3_indexer(const Frame& F) {
    for (int it = F.bid; it < 512; it += F.G) {
        const int half = it >> 8, ii = half ? 511 - (it & 255) : it;
        indexer_item(F, ii & 7, 63 - (ii >> 3));
    }
}

typedef short v4i16_t __attribute__((ext_vector_type(4)));
__device__ __forceinline__ s16x4 vtr(LAS const unsigned char* p) { return __builtin_bit_cast(s16x4, __builtin_amdgcn_ds_read_tr16_b64_v4i16((LAS v4i16_t*)p)); }

__device__ __forceinline__ void p4_attention(const Frame& F) {
    const int lane = fresh((int)threadIdx.x) & 63, wv = F.wave, tid = (int)threadIdx.x, hk = lane >> 5, l31 = lane & 31;
    float gb; { float a = fabsf(F.gq[lane]), bq = fabsf(F.gk[lane]);
#pragma unroll
        for (int o = 32; o > 0; o >>= 1) { a = fmaxf(a, __shfl_xor(a, o)); bq = fmaxf(bq, __shfl_xor(bq, o)); }
        gb = a * bq; }
    const float NMB = -8.f * gb * 1.02f * LOG2E;
    const int st_which = tid >> 8, st_r = (tid & 255) >> 3, st_c8 = tid & 7;
    const unsigned st_off = st_which ? (32768u + st_r * 128 + st_c8 * 16) : (st_r * 128 + ((st_c8 ^ (st_r & 7)) * 16));
    for (int it = F.bid; it < 512; it += F.G) {
        const int pr = it & 255, half = it >> 8, cp = pr & 3, bh = pr >> 2, b = bh >> 3, h = bh & 7, c4 = half ? 7 - cp : cp;
        const int qrow = b * SEQ + 256 * c4 + 32 * wv + l31;
        const int cch = 4 * c4 + (wv >> 1), nt = (80 + 64 * cch + 127) >> 7, ntmax = (80 + 64 * (4 * c4 + 3) + 127) >> 7;
        bf16x8 qf[4];
#pragma unroll
        for (int ks = 0; ks < 4; ++ks) qf[ks] = *(const bf16x8*)(F.Q() + (size_t)qrow * 512 + h * 64 + 16 * ks + 8 * hk);
        const bf16_t* stsrc = (st_which ? F.VV() : F.K()) + (size_t)(b * TT) * 512 + h * 64 + st_c8 * 8;
        f32x16 o0 = {}, o1 = {}; float lsum = 0.f;
        u32x4 sa[4];
#pragma unroll
        for (int q = 0; q < 4; ++q) sa[q] = *(const u32x4*)(stsrc + (size_t)(32 * q + st_r) * 512);
        u32x4 mw = *(const u32x4*)(F.MASK() + (size_t)qrow * MASKW);
#pragma unroll
        for (int q = 0; q < 4; ++q) *(LAS u32x4*)(F.lds + 4096 * q + st_off) = sa[q];
        if (ntmax > 1) {
#pragma unroll
            for (int q = 0; q < 4; ++q) { int k = 128 + 32 * q + st_r; k = k < TT ? k : TT - 1; sa[q] = *(const u32x4*)(stsrc + (size_t)k * 512); } }
        __syncthreads();
        for (int j = 0; j < ntmax; ++j) {
            const int buf = j & 1;
            u32x4 mw_next = {0u, 0u, 0u, 0u}; u32x4 na[4];
#pragma unroll
            for (int q = 0; q < 4; ++q) na[q] = sa[q];
            if (j + 2 < ntmax) {
#pragma unroll
                for (int q = 0; q < 4; ++q) { int k = 128 * (j + 2) + 32 * q + st_r; k = k < TT ? k : TT - 1; na[q] = *(const u32x4*)(stsrc + (size_t)k * 512); } }
            if (j + 1 < nt) mw_next = *(const u32x4*)(F.MASK() + (size_t)qrow * MASKW + 4 * (j + 1));
            if (j < nt) {
                LAS const unsigned char* kb = F.lds + buf * 16384; LAS const unsigned char* vb = F.lds + 32768 + buf * 16384;
#pragma unroll
                for (int hp = 0; hp < 2; ++hp) {
                    f32x16 s[2];
#pragma unroll
                    for (int hh = 0; hh < 2; ++hh)
#pragma unroll
                        for (int r = 0; r < 16; ++r) s[hh][r] = NMB;
#pragma unroll
                    for (int ks = 0; ks < 4; ++ks)
#pragma unroll
                        for (int hh = 0; hh < 2; ++hh) { const bf16x8 kf = *(LAS const bf16x8*)(kb + (64 * hp + 32 * hh + l31) * 128 + (((2 * ks + hk) ^ (l31 & 7)) * 16)); s[hh] = MFMA32(kf, qf[ks], s[hh]); }
                    bf16x8 pf[2][2];
#pragma unroll
                    for (int hh = 0; hh < 2; ++hh) {
                        const unsigned w2 = mw[2 * hp + hh] >> (4 * hk);
                        float p[16];
#pragma unroll
                        for (int r = 0; r < 16; ++r) { p[r] = __uint_as_float(__float_as_uint(__builtin_amdgcn_exp2f(s[hh][r])) & (unsigned)__builtin_amdgcn_sbfe((int)w2, (r & 3) + 8 * (r >> 2), 1)); lsum += p[r]; }
#pragma unroll
                        for (int s2 = 0; s2 < 2; ++s2) { u32x4 w; w.x = cvt_pk_bf16(p[8 * s2 + 0], p[8 * s2 + 1]); w.y = cvt_pk_bf16(p[8 * s2 + 2], p[8 * s2 + 3]);
                            w.z = cvt_pk_bf16(p[8 * s2 + 4], p[8 * s2 + 5]); w.w = cvt_pk_bf16(p[8 * s2 + 6], p[8 * s2 + 7]); pf[hh][s2] = __builtin_bit_cast(bf16x8, w); }
                    }
                    const int i16 = lane & 15, g1 = (lane >> 4) & 1;
#pragma unroll
                    for (int hh = 0; hh < 2; ++hh) {
                        LAS const unsigned char* vp = vb + (64 * hp + 32 * hh + 4 * hk + (i16 >> 2)) * 128 + (16 * g1 + 4 * (i16 & 3)) * 2;
#pragma unroll
                        for (int s2 = 0; s2 < 2; ++s2) {
                            { const s16x4 lo = vtr(vp + (16 * s2) * 128), hi = vtr(vp + (16 * s2 + 8) * 128);
                              const bf16x8 vf = {lo[0], lo[1], lo[2], lo[3], hi[0], hi[1], hi[2], hi[3]}; o0 = MFMA32(vf, pf[hh][s2], o0); }
                            { const s16x4 lo = vtr(vp + (16 * s2) * 128 + 64), hi = vtr(vp + (16 * s2 + 8) * 128 + 64);
                              const bf16x8 vf = {lo[0], lo[1], lo[2], lo[3], hi[0], hi[1], hi[2], hi[3]}; o1 = MFMA32(vf, pf[hh][s2], o1); }
                        }
                    }
                }
            }
            if (j + 1 < ntmax) {
#pragma unroll
                for (int q = 0; q < 4; ++q) *(LAS u32x4*)(F.lds + (buf ^ 1) * 16384 + 4096 * q + st_off) = sa[q]; }
            mw = mw_next;
#pragma unroll
            for (int q = 0; q < 4; ++q) sa[q] = na[q];
            __syncthreads();
        }
        lsum += __shfl_xor(lsum, 32);
        const float inv = 1.f / lsum;
        bf16_t* dst = F.MIX() + (size_t)qrow * 1024 + h * 64 + 4 * hk;
#pragma unroll
        for (int g = 0; g < 4; ++g) {
            u32x2 w; w.x = cvt_pk_bf16(o0[4 * g] * inv, o0[4 * g + 1] * inv); w.y = cvt_pk_bf16(o0[4 * g + 2] * inv, o0[4 * g + 3] * inv); *(u32x2*)(dst + 8 * g) = w;
            u32x2 w1; w1.x = cvt_pk_bf16(o1[4 * g] * inv, o1[4 * g + 1] * inv); w1.y = cvt_pk_bf16(o1[4 * g + 2] * inv, o1[4 * g + 3] * inv); *(u32x2*)(dst + 32 + 8 * g) = w1; }
    }
}

template <int N> __device__ __forceinline__ void bitonic_sort_desc(float (&a)[N]) {
#pragma unroll
    for (int k = 2; k <= N; k <<= 1)
#pragma unroll
        for (int j = k >> 1; j > 0; j >>= 1)
#pragma unroll
            for (int i = 0; i < N; ++i) { const int l = i ^ j; if (l > i) { const bool desc = ((i & k) == 0) || (k == N); const float x = a[i], y = a[l];
                const float mx = fmaxf(x, y), mn = fminf(x, y); a[i] = desc ? mx : mn; a[l] = desc ? mn : mx; } }
}
__device__ __forceinline__ void merge_top16(float (&a)[16], const float (&b)[16]) {
#pragma unroll
    for (int i = 0; i < 16; ++i) a[i] = fmaxf(a[i], b[15 - i]);
#pragma unroll
    for (int j = 8; j > 0; j >>= 1)
#pragma unroll
        for (int i = 0; i < 16; ++i) { const int l = i ^ j; if (l > i) { const float x = a[i], y = a[l]; a[i] = fmaxf(x, y); a[l] = fminf(x, y); } }
}
__device__ __forceinline__ void cex(float& x, int& px, float& y, int& py) { const bool sw = y > x; const float tx = sw ? y : x, ty = sw ? x : y; const int tp = sw ? py : px, tq = sw ? px : py; x = tx; y = ty; px = tp; py = tq; }

__host__ __device__ constexpr int cand_cnt(int i) { return 16 / (i + 1); }
__host__ __device__ constexpr int cand_off(int i) { int s = 0; for (int k = 0; k < i; ++k) s += cand_cnt(k); return s; }
static_assert(cand_off(16) == 50, "candidates");
template <int N> __device__ __forceinline__ void bitonic_sort_desc_kv(float (&a)[N], int (&p)[N]) {
#pragma unroll
    for (int k = 2; k <= N; k <<= 1)
#pragma unroll
        for (int j = k >> 1; j > 0; j >>= 1)
#pragma unroll
            for (int i = 0; i < N; ++i) { const int l = i ^ j; if (l > i) { const bool desc = ((i & k) == 0) || (k == N);
                if (desc) cex(a[i], p[i], a[l], p[l]); else cex(a[l], p[l], a[i], p[i]); } }
}
__device__ __forceinline__ void merge_top16_kv(float (&a)[16], int (&pa)[16], const float (&b)[16], const int (&pb)[16]) {
#pragma unroll
    for (int i = 0; i < 16; ++i) { const bool sw = b[15 - i] > a[i]; a[i] = sw ? b[15 - i] : a[i]; pa[i] = sw ? pb[15 - i] : pa[i]; }
#pragma unroll
    for (int j = 8; j > 0; j >>= 1)
#pragma unroll
        for (int i = 0; i < 16; ++i) { const int l = i ^ j; if (l > i) cex(a[i], pa[i], a[l], pa[l]); }
}
__device__ __forceinline__ void sub_top16(const Frame& F, LAS const unsigned char* skl, const bf16_t* qrow, float (&top)[16]) {
    const int lane = F.lane, hk = lane >> 5, l31 = lane & 31;
    bf16x8 bq[8];
#pragma unroll
    for (int ks = 0; ks < 8; ++ks) bq[ks] = *(const bf16x8*)(qrow + 16 * ks + 8 * hk);
#pragma unroll
    for (int mt = 0; mt < 4; ++mt) {
        f32x16 acc = {};
        const int key = 32 * mt + l31;
#pragma unroll
        for (int ks = 0; ks < 8; ++ks) { const bf16x8 a = *(LAS const bf16x8*)(skl + key * 256 + (((2 * ks + hk) ^ (key & 15)) * 16)); acc = MFMA32(a, bq[ks], acc); }
        float cur[16];
#pragma unroll
        for (int r = 0; r < 16; ++r) { const unsigned kidx = (unsigned)(32 * mt + (r & 3) + 8 * (r >> 2) + 4 * hk); cur[r] = __uint_as_float((__float_as_uint(acc[r]) & ~127u) | kidx); }
        bitonic_sort_desc<16>(cur);
        if (mt == 0) {
#pragma unroll
            for (int i = 0; i < 16; ++i) top[i] = cur[i]; }
        else merge_top16(top, cur);
        __builtin_amdgcn_sched_barrier(0);
    }
    float oth[16];
#pragma unroll
    for (int i = 0; i < 16; ++i) oth[i] = __shfl_xor(top[i], 32);
    merge_top16(top, oth);
}

__host__ __device__ constexpr int p1_units() { return (MPAD / 256) * (NZP / 256); }
__host__ __device__ __forceinline__ int p1_first_idle(int G) { const int maxu = (p1_units() + G - 1) / G; return p1_units() - (maxu - 1) * G; }
__host__ __device__ __forceinline__ int tables_rows_p1(int G) { const int r = (G - p1_first_idle(G)) * 8 * 24; return r < 2 * NEXP ? r : 2 * NEXP; }
__device__ __forceinline__ void p7b_tables(const Frame& F, const int widx, const int nworkers, const int rbeg, const int rend) {
    const int lane = fresh((int)threadIdx.x) & 63;
    f32x4 g[4];
#pragma unroll
    for (int i = 0; i < 4; ++i) g[i] = *(const f32x4*)(F.g2 + 16 * lane + 4 * i);
#pragma unroll 1
    for (int r0 = rbeg + widx * 8; r0 < rend; r0 += nworkers * 8) {
        const bool isv = r0 >= NEXP; const int e0 = isv ? r0 - NEXP : r0;
        const float* src = (isv ? F.pv : F.pu) + (size_t)e0 * 1024 + 16 * lane;
        f32x4 v[8][4]; float mx[8];
#pragma unroll
        for (int r = 0; r < 8; ++r)
#pragma unroll
            for (int i = 0; i < 4; ++i) v[r][i] = *(const f32x4*)(src + (size_t)r * 1024 + 4 * i);
#pragma unroll
        for (int r = 0; r < 8; ++r) { float m = 0.f;
#pragma unroll
            for (int i = 0; i < 4; ++i) { if (!isv) v[r][i] = v[r][i] * g[i];
                m = fmaxf(m, fmaxf(fmaxf(fabsf(v[r][i][0]), fabsf(v[r][i][1])), fmaxf(fabsf(v[r][i][2]), fabsf(v[r][i][3])))); }
            mx[r] = m; }
#pragma unroll
        for (int o = 32; o > 0; o >>= 1) {
#pragma unroll
            for (int r = 0; r < 8; ++r) mx[r] = fmaxf(mx[r], __shfl_xor(mx[r], o)); }
        unsigned char* dst = (isv ? F.V8() : F.U8()) + (size_t)(lane >> 3) * (NEXP * 128) + 16 * (lane & 7);
#pragma unroll
        for (int r = 0; r < 8; ++r) { const float sc = mx[r] > 0.f ? mx[r] * (1.f / 440.f) : 1.f, inv = 1.f / sc;
            u32x4 w;
#pragma unroll
            for (int i = 0; i < 4; ++i) { int p = __builtin_amdgcn_cvt_pk_fp8_f32(v[r][i][0] * inv, v[r][i][1] * inv, 0, false); p = __builtin_amdgcn_cvt_pk_fp8_f32(v[r][i][2] * inv, v[r][i][3] * inv, p, true); w[i] = (unsigned)p; }
            *(u32x4*)(dst + (size_t)(e0 + r) * 128) = w;
            if (lane == 0) (isv ? F.SV() : F.SU())[e0 + r] = sc; }
    }
}

__device__ __forceinline__ void p7_routing(const Frame& F) {
    const int lane = F.lane, hk = lane >> 5, l31 = lane & 31;
    for (int idx = F.tid; idx < 2 * 128 * 16; idx += NTHR) { const int tb = idx >> 11, key = (idx >> 4) & 127, c16 = idx & 15;
        const u32x4 v = *(const u32x4*)(F.SK() + (size_t)tb * 16384 + key * 128 + c16 * 8);
        *(LAS u32x4*)(F.lds + tb * 32768 + key * 256 + ((c16 ^ (key & 15)) * 16)) = v; }
    LAS unsigned* ctab = (LAS unsigned*)(F.lds + 131072);
    if (F.tid < 50) { int n = F.tid, i = 0; while (n >= cand_cnt(i)) { n -= cand_cnt(i); ++i; } ctab[F.tid] = (unsigned)((i << 4) | n); }
    LAS float* lt = (LAS float*)(F.lds + 65536) + F.wave * 2048;
    __syncthreads();
    constexpr int RW = 6;
    if (F.wave >= RW) { p7b_tables(F, F.bid * (8 - RW) + (F.wave - RW), F.G * (8 - RW), tables_rows_p1(F.G), 2 * NEXP); return; }
    pg8::StaticOrder S; S.init(MREAL, 2048, F.G, F.bid);
    for (int li = F.wave; ; li += RW) {
        pg8::Unit un; if (!S.next(li >> 3, un)) break;
        const int tt = un.pm * 8 + (li & 7), head = un.pn, tok = tt * 32 + l31;
        const bf16_t* qrow = F.QP() + (size_t)tok * 2048 + head * 256;
        float t1[16], t2[16];
        sub_top16(F, F.lds, qrow, t1);
        sub_top16(F, F.lds + 32768, qrow + 128, t2);
#pragma unroll
        for (int i = 0; i < 16; ++i) { lt[i * 64 + lane] = t1[i]; lt[(16 + i) * 64 + lane] = t2[i]; }
        float cv[4][16];
#pragma unroll
        for (int k = 50; k < 64; ++k) cv[k >> 4][k & 15] = -3.0e38f;
#pragma unroll
        for (int i = 0; i < 16; ++i)
#pragma unroll
            for (int j = 0; j < 16; ++j) if ((i + 1) * (j + 1) <= 16) {
                const int n = cand_off(i) + j;
                const float sum = __uint_as_float(__float_as_uint(t1[i]) & ~127u) + __uint_as_float(__float_as_uint(t2[j]) & ~127u);
                cv[n >> 4][n & 15] = __uint_as_float((__float_as_uint(sum) & ~63u) | (unsigned)n); }
#pragma unroll
        for (int g = 0; g < 4; ++g) bitonic_sort_desc<16>(cv[g]);
        merge_top16(cv[0], cv[1]); merge_top16(cv[2], cv[3]); merge_top16(cv[0], cv[2]);
        float sv[16]; int ev[16];
#pragma unroll
        for (int k = 0; k < 16; ++k) { const unsigned ij = ctab[__float_as_uint(cv[0][k]) & 63u];
            const unsigned a = __float_as_uint(lt[(ij >> 4) * 64 + lane]), bb = __float_as_uint(lt[(16 + (ij & 15)) * 64 + lane]);
            sv[k] = __uint_as_float(a & ~127u) + __uint_as_float(bb & ~127u); ev[k] = (int)(((a & 127u) << 7) | (bb & 127u)); }
        float mx = sv[0];
#pragma unroll
        for (int k = 1; k < 16; ++k) mx = fmaxf(mx, sv[k]);
        float ge[16], gs = 0.f;
#pragma unroll
        for (int k = 0; k < 16; ++k) { ge[k] = __expf(sv[k] - mx); gs += ge[k]; }
        const float ginv = 1.f / gs;
        if (hk == 0) {
            bf16_t* ed = F.EID() + (size_t)tok * 128 + head * 16; float* gd = F.GATE() + (size_t)tok * 128 + head * 16;
#pragma unroll
            for (int k = 0; k < 16; k += 8) *(u32x4*)(ed + k) = (u32x4){(unsigned)ev[k] | ((unsigned)ev[k + 1] << 16), (unsigned)ev[k + 2] | ((unsigned)ev[k + 3] << 16), (unsigned)ev[k + 4] | ((unsigned)ev[k + 5] << 16), (unsigned)ev[k + 6] | ((unsigned)ev[k + 7] << 16)};
#pragma unroll
            for (int k = 0; k < 16; k += 4) *(f32x4*)(gd + k) = (f32x4){ge[k] * ginv, ge[k + 1] * ginv, ge[k + 2] * ginv, ge[k + 3] * ginv};
        }
    }
}

typedef float f32x2 __attribute__((ext_vector_type(2)));
#define XQ_WORD(pass, s) (4096 + 64 * (8 * (pass) + (s)))
#define XQ_TOK 32
#define XQ_CHUNKS (MREAL / (8 * XQ_TOK))
__device__ __forceinline__ int next_item(const Frame& F, unsigned* ctl, int qpass, int cur) {
    volatile LAS int* slot = (volatile LAS int*)(F.lds + LDS_BYTES - 32);
    __syncthreads();
    if (F.tid == 0) { int res = -1;
        for (int d = 0; d < 8; ++d) { const int s = (cur + d) & 7; unsigned* c = ctl + XQ_WORD(qpass, s);
            if (__hip_atomic_load(c, __ATOMIC_RELAXED, __HIP_MEMORY_SCOPE_AGENT) >= (unsigned)XQ_CHUNKS) continue;
            const unsigned idx = __hip_atomic_fetch_add(c, 1u, __ATOMIC_RELAXED, __HIP_MEMORY_SCOPE_AGENT);
            if (idx < (unsigned)XQ_CHUNKS) { res = (s << 16) | (int)idx; break; } }
        *slot = res; }
    __syncthreads();
    return *slot;
}
__device__ __forceinline__ float swap32_sum(float a, float b) { auto r = __builtin_amdgcn_permlane32_swap(__float_as_uint(a), __float_as_uint(b), false, false); return __uint_as_float(r[0]) + __uint_as_float(r[1]); }
__device__ __forceinline__ float swap16_sum(float a, float b) { auto r = __builtin_amdgcn_permlane16_swap(__float_as_uint(a), __float_as_uint(b), false, false); return __uint_as_float(r[0]) + __uint_as_float(r[1]); }
__device__ __forceinline__ float ror8_sum(float mine, float theirs) { return mine + __uint_as_float((unsigned)__builtin_amdgcn_update_dpp(0, (int)__float_as_uint(theirs), 0x128, 0xF, 0xF, false)); }
template <int CTRL> __device__ __forceinline__ float dpp_sum(float mine, float theirs) { return mine + __uint_as_float((unsigned)__builtin_amdgcn_update_dpp(0, (int)__float_as_uint(theirs), CTRL, 0xF, 0xF, false)); }
#define P8_LOAD8(R, EV, BASE, OFF) _Pragma("unroll") for (int ii = 0; ii < 8; ++ii) { const int e_ = __shfl((EV), 8 * ii + xg); R[ii] = *(const u32x4*)((BASE) + ((unsigned)e_ * 128u + (OFF))); }
#define P8U_DOT8(R, P0) _Pragma("unroll") for (int ii = 0; ii < 8; ++ii) { f32x2 sacc = {0.f, 0.f};                                 \
        _Pragma("unroll") for (int q = 0; q < 4; ++q) { sacc += hv2[2 * q] * __builtin_amdgcn_cvt_pk_f32_fp8((int)R[ii][q], false); sacc += hv2[2 * q + 1] * __builtin_amdgcn_cvt_pk_f32_fp8((int)R[ii][q], true); } \
        p[(P0) + ii] = sacc[0] + sacc[1]; }
template <int QPASS>
__device__ __forceinline__ void p8u_sliced(const Frame& F) {
    unsigned* ctl = (unsigned*)(F.ws + WS_CTL);
    int cur = (int)(xb_xcc_id() & 7u);
    for (;;) { const int itm = next_item(F, ctl, QPASS, cur); if (itm < 0) break;
        const int s = itm >> 16, chunk = itm & 0xffff; cur = s;
        const int lane = fresh((int)threadIdx.x) & 63, xg = lane >> 3, ch = lane & 7;
        const int t0 = chunk * (8 * XQ_TOK) + F.wave * XQ_TOK;
        const unsigned char* ubase = F.U8() + (size_t)s * (NEXP * 128);
        const unsigned uoff = 16u * ch;
        const bool b2 = lane & 4, b1 = lane & 2, b0 = lane & 1;
        const int kout = 64 * (b2 ? 1 : 0) + 32 * (b0 ? 1 : 0) + 16 * (b1 ? 1 : 0) + xg;
        bf16_t* part = F.PART() + (size_t)s * ((size_t)MREAL * 128);
        int e_lo = (int)F.EID()[(unsigned)(t0 * 128 + lane)], e_hi = (int)F.EID()[(unsigned)(t0 * 128 + 64 + lane)];
        int n_lo = (int)F.EID()[(unsigned)((t0 + 1) * 128 + lane)], n_hi = (int)F.EID()[(unsigned)((t0 + 1) * 128 + 64 + lane)];
        u32x4 ha = *(const u32x4*)(F.H1B() + (unsigned)(t0 * 1024 + 128 * s + 16 * ch)), hb = *(const u32x4*)(F.H1B() + (unsigned)(t0 * 1024 + 128 * s + 16 * ch + 8));
        u32x4 rA[8], rB[8];
        P8_LOAD8(rA, e_lo, ubase, uoff)
#pragma unroll 1
        for (int i = 0; i < XQ_TOK; ++i) {
            const int t = t0 + i, tn = t0 + (i < XQ_TOK - 1 ? i + 1 : XQ_TOK - 1), tnn = t0 + (i < XQ_TOK - 2 ? i + 2 : XQ_TOK - 1);
            const int nn_lo = (int)F.EID()[(unsigned)(tnn * 128 + lane)], nn_hi = (int)F.EID()[(unsigned)(tnn * 128 + 64 + lane)];
            const u32x4 nha = *(const u32x4*)(F.H1B() + (unsigned)(tn * 1024 + 128 * s + 16 * ch)), nhb = *(const u32x4*)(F.H1B() + (unsigned)(tn * 1024 + 128 * s + 16 * ch + 8));
            f32x2 hv2[8];
            hv2[0] = (f32x2){bflo(ha.x), bfhi(ha.x)}; hv2[1] = (f32x2){bflo(ha.y), bfhi(ha.y)}; hv2[2] = (f32x2){bflo(ha.z), bfhi(ha.z)}; hv2[3] = (f32x2){bflo(ha.w), bfhi(ha.w)};
            hv2[4] = (f32x2){bflo(hb.x), bfhi(hb.x)}; hv2[5] = (f32x2){bflo(hb.y), bfhi(hb.y)}; hv2[6] = (f32x2){bflo(hb.z), bfhi(hb.z)}; hv2[7] = (f32x2){bflo(hb.w), bfhi(hb.w)};
            float p[16];
            P8_LOAD8(rB, e_hi, ubase, uoff)
            __builtin_amdgcn_sched_barrier(0);
            P8U_DOT8(rA, 0)
            __builtin_amdgcn_sched_barrier(0);
            P8_LOAD8(rA, n_lo, ubase, uoff)
            __builtin_amdgcn_sched_barrier(0);
            P8U_DOT8(rB, 8)
            float r8[8], r4[4], r2[2];
#pragma unroll
            for (int q = 0; q < 8; ++q) r8[q] = dpp_sum<0x141>(b2 ? p[q + 8] : p[q], b2 ? p[q] : p[q + 8]);
#pragma unroll
            for (int q = 0; q < 4; ++q) r4[q] = dpp_sum<0xB1>(b0 ? r8[q + 4] : r8[q], b0 ? r8[q] : r8[q + 4]);
#pragma unroll
            for (int q = 0; q < 2; ++q) r2[q] = dpp_sum<0x4E>(b1 ? r4[q + 2] : r4[q], b1 ? r4[q] : r4[q + 2]);
            part[(unsigned)(t * 128 + kout)] = f2bf(r2[0]); part[(unsigned)(t * 128 + kout + 8)] = f2bf(r2[1]);
            e_lo = n_lo; e_hi = n_hi; n_lo = nn_lo; n_hi = nn_hi; ha = nha; hb = nhb;
            __builtin_amdgcn_sched_barrier(0);
        }
    }
}
__device__ __forceinline__ void p8c_combine(const Frame& F) {
    for (int idx = F.bid * NTHR + fresh((int)threadIdx.x); idx < MREAL * 128; idx += F.G * NTHR) {
        const int t = idx >> 7; const int e = (int)F.EID()[idx];
        float sum = 0.f;
#pragma unroll
        for (int s = 0; s < 8; ++s) sum += bf2f(F.PART()[(size_t)s * ((size_t)MREAL * 128) + idx]);
        const float a = sum * F.SU()[e] * rsqrtf(F.SUMSQ()[t] * (1.f / 1024.f) + RMS_EPS);
        F.CB()[idx] = f2bf(0.5f * a * (1.f + erff(a * 0.70710678118654752f)) * F.GATE()[idx] * F.SV()[e]);
    }
}
#define P8V_FMA8(R, C) _Pragma("unroll") for (int ii = 0; ii < 8; ++ii) { const f32x2 c2 = {C[ii], C[ii]};                            \
        _Pragma("unroll") for (int q = 0; q < 4; ++q) { acc2[2 * q] += c2 * __builtin_amdgcn_cvt_pk_f32_fp8((int)R[ii][q], false); acc2[2 * q + 1] += c2 * __builtin_amdgcn_cvt_pk_f32_fp8((int)R[ii][q], true); } }
#define P8V_COEF8(C, CV) _Pragma("unroll") for (int ii = 0; ii < 8; ++ii) C[ii] = __shfl((CV), 8 * ii + xg);
template <int QPASS>
__device__ __forceinline__ void p8v_experts(const Frame& F) {
    unsigned* ctl = (unsigned*)(F.ws + WS_CTL);
    int cur = (int)(xb_xcc_id() & 7u);
    for (;;) { const int itm = next_item(F, ctl, QPASS, cur); if (itm < 0) break;
        const int s = itm >> 16, chunk = itm & 0xffff; cur = s;
        const int lane = fresh((int)threadIdx.x) & 63, xg = lane >> 3, ch = lane & 7;
        const int t0 = chunk * (8 * XQ_TOK) + F.wave * XQ_TOK;
        const unsigned char* vbase = F.V8() + (size_t)s * (NEXP * 128);
        const unsigned voff = 16u * ch;
        const bool b5 = lane & 32, b4 = lane & 16, b3 = lane & 8;
        const int col = 128 * s + 16 * ch + (b5 ? 8 : 0) + (b4 ? 4 : 0) + (b3 ? 2 : 0);
        int e_lo = (int)F.EID()[(unsigned)(t0 * 128 + lane)], e_hi = (int)F.EID()[(unsigned)(t0 * 128 + 64 + lane)];
        int n_lo = (int)F.EID()[(unsigned)((t0 + 1) * 128 + lane)], n_hi = (int)F.EID()[(unsigned)((t0 + 1) * 128 + 64 + lane)];
        float c_lo = bf2f(F.CB()[(unsigned)(t0 * 128 + lane)]), c_hi = bf2f(F.CB()[(unsigned)(t0 * 128 + 64 + lane)]);
        u32x4 rA[8], rB[8];
        P8_LOAD8(rA, e_lo, vbase, voff)
#pragma unroll 1
        for (int i = 0; i < XQ_TOK; ++i) {
            const int t = t0 + i, tn = t0 + (i < XQ_TOK - 1 ? i + 1 : XQ_TOK - 1), tnn = t0 + (i < XQ_TOK - 2 ? i + 2 : XQ_TOK - 1);
            const int nn_lo = (int)F.EID()[(unsigned)(tnn * 128 + lane)], nn_hi = (int)F.EID()[(unsigned)(tnn * 128 + 64 + lane)];
            const float nc_lo = bf2f(F.CB()[(unsigned)(tn * 128 + lane)]), nc_hi = bf2f(F.CB()[(unsigned)(tn * 128 + 64 + lane)]);
            const unsigned h1w = *(const unsigned*)(F.H1B() + (unsigned)(t * 1024 + col)); const f32x2 h1 = {bflo(h1w), bfhi(h1w)};
            f32x2 acc2[8]; float cc[8];
#pragma unroll
            for (int q = 0; q < 8; ++q) acc2[q] = (f32x2){0.f, 0.f};
            P8_LOAD8(rB, e_hi, vbase, voff)
            P8V_COEF8(cc, c_lo)
            __builtin_amdgcn_sched_barrier(0);
            P8V_FMA8(rA, cc)
            __builtin_amdgcn_sched_barrier(0);
            P8_LOAD8(rA, n_lo, vbase, voff)
            P8V_COEF8(cc, c_hi)
            __builtin_amdgcn_sched_barrier(0);
            P8V_FMA8(rB, cc)
            __builtin_amdgcn_sched_barrier(0);
            float acc[16];
#pragma unroll
            for (int q = 0; q < 8; ++q) { acc[2 * q] = acc2[q][0]; acc[2 * q + 1] = acc2[q][1]; }
            float r8[8], r4[4], r2[2];
#pragma unroll
            for (int q = 0; q < 8; ++q) r8[q] = swap32_sum(acc[q], acc[q + 8]);
#pragma unroll
            for (int q = 0; q < 4; ++q) r4[q] = swap16_sum(r8[q], r8[q + 4]);
#pragma unroll
            for (int q = 0; q < 2; ++q) r2[q] = ror8_sum(b3 ? r4[q + 2] : r4[q], b3 ? r4[q] : r4[q + 2]);
            *(f32x2*)(F.out + (unsigned)(t * 1024 + col)) = (f32x2){h1[0] + r2[0], h1[1] + r2[1]};
            e_lo = n_lo; e_hi = n_hi; n_lo = nn_lo; n_hi = nn_hi; c_lo = nc_lo; c_hi = nc_hi;
            __builtin_amdgcn_sched_barrier(0);
        }
    }
}

constexpr int NPHASE = 10;
__global__ void __launch_bounds__(NTHR, 2) mk_fwd(Args args) {
    extern __shared__ __attribute__((aligned(16))) unsigned char lds_raw[];
    Frame F;
    F.lds = (LAS unsigned char*)lds_raw;
    F.tid = threadIdx.x; F.lane = F.tid & 63; F.wave = __builtin_amdgcn_readfirstlane(F.tid >> 6); F.G = gridDim.x; F.bid = blockIdx.x;
    F.x = args.in[0]; F.meta = args.in[1]; F.g1 = args.in[2]; F.w_in = args.in[3]; F.gq = args.in[4]; F.gk = args.in[5]; F.pool_w = args.in[6]; F.pool_scale = args.in[7];
    F.w_out = args.in[8]; F.g2 = args.in[9]; F.wq = args.in[10]; F.sk1 = args.in[11]; F.sk2 = args.in[12]; F.pu = args.in[13]; F.pv = args.in[14];
    F.out = args.out; F.ws = args.ws; unsigned char* ws = args.ws;
    const int lo = args.ph_lo, hi = args.ph_hi;
#ifndef PHASE_MASK
#define PHASE_MASK 0x3ff
#endif
#define IN(k) (((PHASE_MASK >> (k)) & 1) && lo <= (k) && (k) < hi)
    volatile LAS unsigned* bst = (volatile LAS unsigned*)(F.lds + LDS_BYTES - 16);
    if (F.tid == 0) { bst[0] = 0u; bst[1] = 0u; }
    __syncthreads();
    XcdBarrier bar = xcd_barrier_post((unsigned*)(ws + WS_CTL), bst);
#define GSYNC(k) do { if (IN(k) && IN((k) + 1)) xcd_barrier(bar); } while (0)
    if (IN(0)) { p0_prologue(F); }
    GSYNC(0);
    if (IN(1)) { { pg8::Gemm g{F.XN(), F.WIN(), MPAD, NZP, 1024}; pg8::StaticOrder S; S.init(MPAD, NZP, F.G, F.bid); EpiIn E{F.Q(), F.K(), F.VV(), F.QI(), F.KI(), F.UP(), F.WI(), F.gq, F.gk}; pg8::gemm_phase<EpiIn, pg8::StaticOrder>(F.lds, g, S, E);
        if (F.bid >= p1_first_idle(F.G)) p7b_tables(F, (F.bid - p1_first_idle(F.G)) * 8 + F.wave, (F.G - p1_first_idle(F.G)) * 8, 0, tables_rows_p1(F.G)); } }
    GSYNC(1);
    if (IN(3)) { p2_weff(F); p2_pool(F); p3_indexer(F); }
    GSYNC(3);
    if (IN(4)) { p4_attention(F); }
    GSYNC(4);
    if (IN(5)) { { pg8::Gemm g{F.MIX(), F.WOUT(), MREAL, 1024, 1024}; pg8::StaticOrder S; S.init(MREAL, 1024, F.G, F.bid); EpiOut E{F.x, F.out, F.H1B(), F.SUMSQ()}; pg8::gemm_phase<EpiOut, pg8::StaticOrder>(F.lds, g, S, E); } }
    GSYNC(5);
    if (IN(6)) { { pg8::Gemm g{F.H1B(), F.WQ(), MREAL, 2048, 1024}; pg8::StaticOrder S; S.init(MREAL, 2048, F.G, F.bid); EpiQP E{F.QP(), F.SUMSQ()}; pg8::gemm_phase<EpiQP, pg8::StaticOrder>(F.lds, g, S, E); } }
    if (IN(7)) { p7_routing(F); }
    GSYNC(7);
    if (IN(8)) { p8u_sliced<0>(F); xcd_barrier(bar); p8c_combine(F); }
    GSYNC(8);
    if (IN(9)) { p8v_experts<1>(F); }

#undef IN
#undef GSYNC
}
}

extern "C" void kernel_launch(void* const* d_in, const int* in_sizes, int n_in, void* d_out, int out_size, void* d_ws, size_t ws_size, hipStream_t stream) {
    static int grid = 0;
    if (grid == 0) {
        if (n_in != 15 || out_size != mk::MREAL * 1024 || ws_size < mk::WS_END) { fprintf(stderr, "kernel_launch: unexpected problem (n_in %d out %d ws %zu)\n", n_in, out_size, ws_size); grid = -1; return; }
        int dev = 0, cus = 0;
        if (hipGetDevice(&dev) != hipSuccess || hipDeviceGetAttribute(&cus, hipDeviceAttributeMultiprocessorCount, dev) != hipSuccess) { grid = -1; return; }
        if (hipFuncSetAttribute((const void*)mk::mk_fwd, hipFuncAttributeMaxDynamicSharedMemorySize, mk::LDS_BYTES) != hipSuccess) { fprintf(stderr, "kernel_launch: hipFuncSetAttribute failed\n"); grid = -1; return; }
        int per_cu = 0;
        if (hipOccupancyMaxActiveBlocksPerMultiprocessor(&per_cu, (const void*)mk::mk_fwd, mk::NTHR, mk::LDS_BYTES) != hipSuccess || per_cu < 1) { fprintf(stderr, "kernel_launch: occupancy query says %d\n", per_cu); grid = -1; return; }
        grid = cus;
    }
    if (grid < 0) return;
    if (hipMemsetAsync((char*)d_ws + mk::WS_CTL, 0, 32768, stream) != hipSuccess) { fprintf(stderr, "kernel_launch: memset failed\n"); return; }
    mk::Args a{};
    for (int i = 0; i < 15; ++i) a.in[i] = (const float*)d_in[i];
    a.out = (float*)d_out; a.ws = (unsigned char*)d_ws; a.ph_lo = 0; a.ph_hi = mk::NPHASE;
    void* kargs[] = {&a};
    hipError_t e = hipLaunchCooperativeKernel((const void*)mk::mk_fwd, dim3(grid), dim3(mk::NTHR), kargs, mk::LDS_BYTES, stream);
    if (e != hipSuccess) fprintf(stderr, "kernel_launch: cooperative launch failed: %s (grid %d)\n", hipGetErrorString(e), grid);

}
```

```cpp
#include <hip/hip_runtime.h>
#include <cstdio>
#include <cstdint>
namespace pg8 {
#define PG8_LAS __attribute__((address_space(3)))
typedef unsigned short bf16_t;
typedef short bf16x8 __attribute__((ext_vector_type(8)));
typedef float f32x4 __attribute__((ext_vector_type(4)));
typedef unsigned u32x4 __attribute__((ext_vector_type(4)));
constexpr int BM = 256, BK = 64, HALF = 128, HTB = HALF * BK * 2  , STAGE_BYTES = 8 * HTB, NXCD = 8, WGM = 8;

__host__ __device__ __forceinline__ int lds_byte(int r, int c) { const int st = (r >> 4) * 2 + (c >> 5), rr = r & 15, cc = c & 31, ob = rr * 64 + cc * 2; return st * 1024 + (ob ^ (((ob >> 9) & 1) << 5)); }
__host__ __device__ __forceinline__ void stage_rc(int b, int& R, int& C) { const int st = b / 1024, sb = b % 1024, swz = sb ^ (((sb >> 9) & 1) << 5); R = (st >> 1) * 16 + swz / 64; C = (st & 1) * 32 + (swz % 64) / 2; }
__host__ __device__ __forceinline__ int perm32(int rho) { const int n = rho >> 4, i = rho & 15; return 8 * (i >> 2) + 4 * n + (i & 3); }

struct Unit { int pm, pn; };
struct Gemm { const bf16_t* A; const bf16_t* Bt; int M, N, K; };
struct StaticOrder {
    int nM, nN, nwg, G, c;
    __host__ __device__ void init(int M, int N, int G_, int c_) { nM = M / BM; nN = N / BM; nwg = nM * nN; G = G_; c = c_; }
    __host__ __device__ bool next(int i, Unit& u) const {
        const long L = (long)i * G + c; if (L >= nwg) return false;
        int wgid = (int)L; { const int q = nwg / NXCD, r = nwg % NXCD, xcd = wgid % NXCD, off = wgid / NXCD; wgid = (xcd < r ? xcd * (q + 1) : r * (q + 1) + (xcd - r) * q) + off; }
        const int nig = WGM * nN, gid = wgid / nig, fm = gid * WGM, gsz = (nM - fm) < WGM ? (nM - fm) : WGM;
        u.pm = fm + ((wgid % nig) % gsz); u.pn = (wgid % nig) / gsz; return true;
    }
    __device__ __forceinline__ void a_ready(const Unit&) const {}
    __device__ __forceinline__ void done(const Unit&) const {}
};
__device__ __forceinline__ unsigned cvt_pk_bf16(float lo, float hi) { unsigned r; asm volatile("v_cvt_pk_bf16_f32 %0, %1, %2" : "=v"(r) : "v"(lo), "v"(hi)); return r; }
template <class Epi, class Sched>
__device__ __forceinline__ void gemm_phase(PG8_LAS unsigned char* lds, const Gemm g, const Sched& S, const Epi& E) {
    int tid_ = threadIdx.x; asm volatile("" : "+v"(tid_));
    const int tid = tid_, wid = __builtin_amdgcn_readfirstlane(tid >> 6), lane = tid & 63, wr = wid >> 2, wc = wid & 3, fr = lane & 15, fq = lane >> 4;
    const int K = g.K, nt = K / BK;
    unsigned voffA[2], voffB[2];
#pragma unroll
    for (int i = 0; i < 2; ++i) { int R, C; stage_rc(tid * 16 + i * 8192, R, C); const int Rb = Epi::PERM ? ((R & ~31) + perm32(R & 31)) : R;
        voffA[i] = (unsigned)(R * K + C) * 2u; voffB[i] = (unsigned)(Rb * K + C) * 2u; }
    const size_t kstep = (size_t)(BK * 2);
    const size_t hstep = (size_t)HALF * K * 2;
    const size_t tstep = 2 * hstep;
    const unsigned ldsw = (unsigned)wid * 1024u;
    const int aoff = lds_byte(wr * 64 + fr, fq * 8), boff = lds_byte(wc * 32 + fr, fq * 8);
#define PG8_SA(b, h) (((b) * 2 + (h)) * HTB)
#define PG8_SB(b, h) ((4 + (b) * 2 + (h)) * HTB)
#define PG8_STAGE(bufoff, gbase, voff) do { _Pragma("unroll") for (int _i = 0; _i < 2; ++_i) \
        __builtin_amdgcn_global_load_lds((const unsigned*)((const char*)(gbase) + (voff)[_i]), (PG8_LAS unsigned*)(lds + (bufoff) + ldsw + _i * 8192), 16, 0, 0); } while (0)
#define PG8_LDA(dst, b, h) do { _Pragma("unroll") for (int m = 0; m < 4; ++m) _Pragma("unroll") for (int k = 0; k < 2; ++k) dst[m][k] = *(const PG8_LAS bf16x8*)(lds + PG8_SA(b, h) + aoff + m * 2048 + k * 1024); } while (0)
#define PG8_LDB(dst, b, h) do { _Pragma("unroll") for (int n = 0; n < 2; ++n) _Pragma("unroll") for (int k = 0; k < 2; ++k) dst[n][k] = *(const PG8_LAS bf16x8*)(lds + PG8_SB(b, h) + boff + n * 2048 + k * 1024); } while (0)
#define PG8_MMA(ai, bj, At, Bt) do { __builtin_amdgcn_s_setprio(1); _Pragma("unroll") for (int m = 0; m < 4; ++m) _Pragma("unroll") for (int n = 0; n < 2; ++n) _Pragma("unroll") for (int k = 0; k < 2; ++k) \
        acc[ai][bj][m][n] = __builtin_amdgcn_mfma_f32_16x16x32_bf16(Bt[n][k], At[m][k], acc[ai][bj][m][n], 0, 0, 0); __builtin_amdgcn_s_setprio(0); } while (0)
#define PG8_WAIT_V(n) asm volatile("s_waitcnt vmcnt(" #n ")" ::: "memory")
#define PG8_WAIT_L(n) asm volatile("s_waitcnt lgkmcnt(" #n ")" ::: "memory")
#define PG8_BAR __builtin_amdgcn_s_barrier()
#define PG8_SCHED __builtin_amdgcn_sched_barrier(0)
    Unit cur, nxt; int ui = 0;
    if (!S.next(0, cur)) return;
    f32x4 acc[2][2][4][2];
#pragma unroll
    for (int a = 0; a < 2; ++a)
#pragma unroll
        for (int b = 0; b < 2; ++b)
#pragma unroll
            for (int m = 0; m < 4; ++m)
#pragma unroll
                for (int n = 0; n < 2; ++n) acc[a][b][m][n] = (f32x4){0.f, 0.f, 0.f, 0.f};
    bf16x8 At[4][2], B0[2][2], B1[2][2];
    const char* cA = (const char*)g.A + (size_t)cur.pm * tstep; const char* cB = (const char*)g.Bt + (size_t)cur.pn * tstep;
    S.a_ready(cur);
    PG8_STAGE(PG8_SB(0, 0), cB, voffB); PG8_STAGE(PG8_SA(0, 0), cA, voffA); PG8_STAGE(PG8_SB(0, 1), cB + hstep, voffB); PG8_STAGE(PG8_SA(0, 1), cA + hstep, voffA);
    if (wr == 1) PG8_BAR;
    PG8_WAIT_V(4); PG8_BAR;
    PG8_STAGE(PG8_SB(1, 0), cB + kstep, voffB); PG8_STAGE(PG8_SA(1, 0), cA + kstep, voffA); PG8_STAGE(PG8_SB(1, 1), cB + hstep + kstep, voffB);
    PG8_WAIT_V(6); PG8_BAR;
    for (;;) {
        const bool has_next = S.next(ui + 1, nxt);
        const char* nA = has_next ? (const char*)g.A + (size_t)nxt.pm * tstep : cA; const char* nB = has_next ? (const char*)g.Bt + (size_t)nxt.pn * tstep : cB;
        for (int t = 0; t < nt; t += 2) {
            const bool last = (t == nt - 2);
            const char* a1 = cA + (size_t)(t + 1) * kstep;
            const char* a2 = last ? nA : cA + (size_t)(t + 2) * kstep; const char* b2 = last ? nB : cB + (size_t)(t + 2) * kstep;
            const char* a3 = a2 + kstep; const char* b3 = b2 + kstep;
            if (last && has_next) S.a_ready(nxt);
            PG8_LDB(B0, 0, 0); PG8_SCHED; PG8_LDA(At, 0, 0); PG8_STAGE(PG8_SA(1, 1), a1 + hstep, voffA);
            PG8_WAIT_L(8); PG8_BAR; PG8_WAIT_L(0); PG8_MMA(0, 0, At, B0); PG8_BAR; PG8_SCHED;
            PG8_LDB(B1, 0, 1); PG8_STAGE(PG8_SB(0, 0), b2, voffB);
            PG8_BAR; PG8_WAIT_L(0); PG8_MMA(0, 1, At, B1); PG8_BAR;
            PG8_LDA(At, 0, 1); PG8_STAGE(PG8_SA(0, 0), a2, voffA);
            PG8_BAR; PG8_WAIT_L(0); PG8_MMA(1, 0, At, B0); PG8_BAR; PG8_SCHED;
            PG8_STAGE(PG8_SB(0, 1), b2 + hstep, voffB);
            PG8_WAIT_V(6); PG8_BAR; PG8_MMA(1, 1, At, B1); PG8_BAR;
            PG8_LDB(B0, 1, 0); PG8_SCHED; PG8_LDA(At, 1, 0); PG8_STAGE(PG8_SA(0, 1), a2 + hstep, voffA);
            PG8_WAIT_L(8); PG8_BAR; PG8_WAIT_L(0); PG8_MMA(0, 0, At, B0); PG8_BAR; PG8_SCHED;
            PG8_LDB(B1, 1, 1); PG8_STAGE(PG8_SB(1, 0), b3, voffB);
            PG8_BAR; PG8_WAIT_L(0); PG8_MMA(0, 1, At, B1); PG8_BAR;
            PG8_LDA(At, 1, 1); PG8_STAGE(PG8_SA(1, 0), a3, voffA);
            PG8_BAR; PG8_WAIT_L(0); PG8_MMA(1, 0, At, B0); PG8_BAR; PG8_SCHED;
            PG8_STAGE(PG8_SB(1, 1), b3 + hstep, voffB);
            PG8_WAIT_V(6); PG8_BAR; PG8_MMA(1, 1, At, B1); PG8_BAR;
        }
        if constexpr (!Epi::AFTER_DRAIN) { E(acc, cur, wr, wc, fr, fq); S.done(cur); }
        if (!has_next) break;
#pragma unroll
        for (int a = 0; a < 2; ++a)
#pragma unroll
            for (int b = 0; b < 2; ++b)
#pragma unroll
                for (int m = 0; m < 4; ++m)
#pragma unroll
                    for (int n = 0; n < 2; ++n) acc[a][b][m][n] = (f32x4){0.f, 0.f, 0.f, 0.f};
        cur = nxt; cA = nA; cB = nB; ++ui;
    }
    PG8_WAIT_V(0);
    if (wr == 0) PG8_BAR;
    PG8_BAR;
    if constexpr (Epi::AFTER_DRAIN) { E.fused(acc, cur, wr, wc, fr, fq, lds, wid, lane); S.done(cur); }
#undef PG8_SA
#undef PG8_SB
#undef PG8_STAGE
#undef PG8_LDA
#undef PG8_LDB
#undef PG8_MMA
#undef PG8_WAIT_V
#undef PG8_WAIT_L
#undef PG8_BAR
#undef PG8_SCHED
}
}
#define XB_TMO      128
#define XB_XCNT(j)  (256  + 64 * (j))
#define XB_XSUB(j)  (1280 + 64 * (j))
#define XB_XGEN(j)  (2304 + 64 * (j))
#define XB_TOP      3328
#define XB_TOPGEN   3392
#define XCD_BAR_WORDS 3456
#define XB_SPIN_CAP (1u << 18)

__device__ __forceinline__ unsigned xb_ld(unsigned* p)              { return __hip_atomic_load(p, __ATOMIC_RELAXED, __HIP_MEMORY_SCOPE_AGENT); }
__device__ __forceinline__ unsigned xb_add(unsigned* p, unsigned v) { return __hip_atomic_fetch_add(p, v, __ATOMIC_RELAXED, __HIP_MEMORY_SCOPE_AGENT); }
__device__ __forceinline__ unsigned xb_xcc_id() { return (unsigned)__builtin_amdgcn_s_getreg((3 << 11) | 20) & 0xFu; }
#define XB_SPIN(cond, bar) do { unsigned _sp = 0; while (cond) { __builtin_amdgcn_s_sleep(1); \
    if ((++_sp & 255u) == 0u) { if (xb_ld(&(bar)[XB_TMO])) break; if (_sp > XB_SPIN_CAP) { atomicAdd(&(bar)[XB_TMO], 1u); break; } } } } while (0)

struct XcdBarrier {
    unsigned* bar; unsigned x;
    volatile __attribute__((address_space(3))) unsigned* st;
};

__device__ __forceinline__ XcdBarrier xcd_barrier_post(unsigned* bar, volatile __attribute__((address_space(3))) unsigned* st) {
    XcdBarrier b; b.bar = bar; b.x = xb_xcc_id(); b.st = st;
    if (threadIdx.x == 0) (void)xb_add(&bar[XB_XCNT(b.x)], 1u);
    return b;
}
__device__ __forceinline__ void xcd_barrier_complete(unsigned* bar, unsigned x, unsigned& nloc, unsigned& nx) {
    const unsigned G = gridDim.x * gridDim.y * gridDim.z;
    unsigned sum, cnt, mine, sp = 0u;
    for (;;) {
        sum = 0u; cnt = 0u; mine = 0u;
#pragma unroll
        for (unsigned j = 0; j < 16; ++j) { const unsigned c = xb_ld(&bar[XB_XCNT(j)]); sum += c; cnt += (c > 0u) ? 1u : 0u; mine = (j == x) ? c : mine; }
        if (sum == G) break;
        __builtin_amdgcn_s_sleep(1);
        if ((++sp & 255u) == 0u) { if (xb_ld(&bar[XB_TMO])) break; if (sp > XB_SPIN_CAP) { atomicAdd(&bar[XB_TMO], 1u); break; } }
    }
    nloc = mine > 0u ? mine : 1u; nx = cnt > 0u ? cnt : 1u;
}

__device__ __forceinline__ void xcd_barrier(const XcdBarrier& b) {
    asm volatile("s_waitcnt vmcnt(0)" ::: "memory");
    __syncthreads();
    if (threadIdx.x == 0) {
        unsigned* bar = b.bar;
        __builtin_amdgcn_s_waitcnt(0);
        unsigned nloc = b.st[0], nx = b.st[1];
        if (nloc == 0u) { xcd_barrier_complete(bar, b.x, nloc, nx); b.st[0] = nloc; b.st[1] = nx; }
        const unsigned old = xb_add(&bar[XB_XSUB(b.x)], 1u);
        const unsigned gen = old / nloc;
        if (old + 1u == (gen + 1u) * nloc) {
            __builtin_amdgcn_fence(__ATOMIC_RELEASE, "agent");
            asm volatile("s_waitcnt vmcnt(0)" ::: "memory");
            const unsigned og = xb_add(&bar[XB_TOP], 1u);
            const unsigned tg = og / nx;
            if (og + 1u == (tg + 1u) * nx) xb_add(&bar[XB_TOPGEN], 1u);
            else XB_SPIN(xb_ld(&bar[XB_TOPGEN]) == tg, bar);
            __builtin_amdgcn_fence(__ATOMIC_ACQUIRE, "agent");
            xb_add(&bar[XB_XGEN(b.x)], 1u);
            asm volatile("s_waitcnt vmcnt(0)" ::: "memory");
        } else {
            XB_SPIN(xb_ld(&bar[XB_XGEN(b.x)]) == gen, bar);
            __builtin_amdgcn_fence(__ATOMIC_ACQUIRE, "agent");
            asm volatile("s_waitcnt vmcnt(0)" ::: "memory");
        }
    }
    __syncthreads();
}

namespace mk {
using pg8::bf16_t; using pg8::bf16x8; using pg8::f32x4; using pg8::u32x4; using pg8::cvt_pk_bf16;
typedef float f32x16 __attribute__((ext_vector_type(16)));
typedef unsigned u32x2 __attribute__((ext_vector_type(2)));
typedef short s16x4 __attribute__((ext_vector_type(4)));
#define LAS __attribute__((address_space(3)))
#define MFMA32(a, b, c) __builtin_amdgcn_mfma_f32_32x32x16_bf16((a), (b), (c), 0, 0, 0)

constexpr int DM = 1024, NB = 8, SEQ = 2048, TT = 2064, NMETA = 16;
constexpr int MREAL = NB * SEQ, MROWS = MREAL + NMETA, MPAD = 16640;
constexpr int NZ = 2632, NZP = 2816;
constexpr int OFF_Q = 0, OFF_K = 512, OFF_V = 1024, OFF_POOL = 1536, OFF_IQ = 2048, OFF_IK = 2560, OFF_IW = 2624;
constexpr int NEXP = 16384;
constexpr float RMS_EPS = 1e-6f, LOG2E = 1.4426950408889634f;
constexpr int NTHR = 512, LDS_BYTES = 163840;
constexpr int MASKW = 68;
constexpr int SCW = 2112;

constexpr size_t WS_CTL = 0;
constexpr size_t WS_SUMSQ = 65536;
constexpr size_t WS_WIN = WS_SUMSQ + 65536;
constexpr size_t WS_WOUT = WS_WIN + (size_t)NZP * 1024 * 2;
constexpr size_t WS_WQ = WS_WOUT + (size_t)1024 * 1024 * 2;
constexpr size_t WS_SK = WS_WQ + (size_t)2048 * 1024 * 2;
constexpr size_t WS_KI = WS_SK + 65536;
constexpr size_t WS_WI = WS_KI + (size_t)NB * TT * 64 * 2;
constexpr size_t WS_MASK = WS_WI + (size_t)MREAL * 8 * 4;
constexpr size_t WS_XN = WS_MASK + (size_t)MREAL * MASKW * 4;
constexpr size_t WS_MIX = WS_XN + (size_t)MPAD * 1024 * 2;
constexpr size_t WS_Q = WS_MIX + (size_t)MREAL * 1024 * 2;
constexpr size_t WS_K = WS_Q + (size_t)MREAL * 512 * 2;
constexpr size_t WS_VV = WS_K + (size_t)NB * TT * 512 * 2;
constexpr size_t WS_QI = WS_VV + (size_t)NB * TT * 512 * 2;
constexpr size_t WS_UP = WS_QI + (size_t)MREAL * 512 * 2;
constexpr size_t WS_U8 = WS_UP + (size_t)MROWS * 512 * 2;
constexpr size_t WS_SCL = WS_U8 + (size_t)NEXP * 1024;
constexpr size_t WS_C = WS_SCL + 131072;
constexpr size_t WS_V8 = WS_C + (size_t)MREAL * 128 * 4;
constexpr size_t WS_H1B = WS_V8 + (size_t)NEXP * 1024;
constexpr size_t WS_EID = WS_H1B + (size_t)MREAL * 1024 * 2;
constexpr size_t WS_TW = WS_EID + (size_t)MREAL * 128 * 8;
constexpr size_t WS_END = WS_TW + (size_t)1024 * 512 * 2;
constexpr size_t WS_QP = WS_Q;
static_assert(WS_END <= 268435456ull, "workspace");
static_assert((WS_MASK % 16) == 0 && (WS_XN % 256) == 0 && (WS_UP % 256) == 0 && (WS_K % 256) == 0 && (WS_U8 % 256) == 0, "align");
static_assert(WS_QP + (size_t)MREAL * 2048 * 2 <= WS_UP, "QP fits over Q..QI");
static_assert(WS_MIX == WS_XN + (size_t)MPAD * 1024 * 2 && WS_XN + (size_t)8 * MREAL * 128 * 4 <= WS_Q, "PART (f32 [8][16384][128]) fits over XN | MIX (dead after the input / output projections)");

struct Args { const float* in[15]; float* out; unsigned char* ws; int ph_lo, ph_hi; };

struct Frame {
    const float *x, *meta, *g1, *w_in, *gq, *gk, *pool_w, *pool_scale, *w_out, *g2, *wq, *sk1, *sk2, *pu, *pv;
    float* out; unsigned char* ws; LAS unsigned char* lds;
    int tid, lane, wave, G, bid;
#define WSPTR(name, type, off) __device__ __forceinline__ type* name() const { return (type*)(ws + (off)); }
    WSPTR(SUMSQ, float, WS_SUMSQ) WSPTR(WIN, bf16_t, WS_WIN) WSPTR(WOUT, bf16_t, WS_WOUT) WSPTR(WQ, bf16_t, WS_WQ) WSPTR(SK, bf16_t, WS_SK)
    WSPTR(KI, bf16_t, WS_KI) WSPTR(WI, float, WS_WI) WSPTR(MASK, unsigned, WS_MASK) WSPTR(XN, bf16_t, WS_XN) WSPTR(H1B, bf16_t, WS_H1B) WSPTR(MIX, bf16_t, WS_MIX)
    WSPTR(Q, bf16_t, WS_Q) WSPTR(K, bf16_t, WS_K) WSPTR(VV, bf16_t, WS_VV) WSPTR(QI, bf16_t, WS_QI) WSPTR(UP, bf16_t, WS_UP) WSPTR(QP, bf16_t, WS_QP)
    WSPTR(U8, unsigned char, WS_U8) WSPTR(V8, unsigned char, WS_V8) WSPTR(SU, float, WS_SCL) WSPTR(SV, float, WS_SCL + NEXP * 4)
    WSPTR(TW, bf16_t, WS_TW) WSPTR(PART, bf16_t  , WS_XN) WSPTR(EID, bf16_t  , WS_EID) WSPTR(GATE, float, WS_EID + (size_t)MREAL * 128 * 4) WSPTR(CB, bf16_t  , WS_C)
#undef WSPTR
};


__device__ __forceinline__ int fresh(int v) { asm volatile("" : "+v"(v)); return v; }
__device__ __forceinline__ bf16_t f2bf(float f) { return (bf16_t)(cvt_pk_bf16(f, 0.f) & 0xffffu); }
__device__ __forceinline__ float bf2f(bf16_t b) { return __uint_as_float(((unsigned)b) << 16); }
__device__ __forceinline__ float bflo(unsigned w) { return __uint_as_float(w << 16); }
__device__ __forceinline__ float bfhi(unsigned w) { return __uint_as_float(w & 0xffff0000u); }
__device__ __forceinline__ float wave_sum(float v) {
#pragma unroll
    for (int o = 32; o > 0; o >>= 1) v += __shfl_xor(v, o);
    return v; }
__device__ __forceinline__ float half_sum32(float v) {
#pragma unroll
    for (int o = 16; o > 0; o >>= 1) v += __shfl_xor(v, o);
    return v; }

__host__ __device__ __forceinline__ int win_src_col(int np) {
    const int pn = np >> 8, cl = np & 255, bj = cl >> 7, wc = (cl >> 5) & 3, w = cl & 31;
    if (pn < 2) return OFF_Q + (4 * pn + wc) * 64 + 32 * bj + w;
    if (pn < 4) return OFF_K + (4 * (pn - 2) + wc) * 64 + 32 * bj + w;
    if (pn < 8) return np;
    if (pn < 10) return OFF_IQ + (4 * (pn - 8) + wc) * 64 + 32 * bj + w;
    if (wc == 0) return OFF_IK + 32 * bj + w;
    if (wc == 1 && bj == 0 && w < 8) return OFF_IW + w;
    return -1;
}
template <bool WINPERM>
__device__ __forceinline__ void transpose_tile(const Frame& F, LAS float* tile, const float* W, int ldw, int N, bf16_t* Wt, int ldt, const float* kscale, int k0, int n0) {
    const int lane = F.lane, kk = lane >> 4, n4 = (lane & 15) * 4;
    int src = n0 + n4; bool ok = src < N;
    if (WINPERM) { src = win_src_col(n0 + n4); ok = src >= 0; }
    f32x4 v[16];
#pragma unroll
    for (int p = 0; p < 16; ++p) { v[p] = (f32x4){0.f, 0.f, 0.f, 0.f}; if (ok) v[p] = *(const f32x4*)(W + (size_t)(k0 + 4 * p + kk) * ldw + src); }
#pragma unroll
    for (int p = 0; p < 16; ++p) { const float s = kscale ? kscale[k0 + 4 * p + kk] : 1.f;
#pragma unroll
        for (int i = 0; i < 4; ++i) tile[(4 * p + kk) * 65 + n4 + i] = v[p][i] * s; }
#pragma unroll
    for (int k8 = 0; k8 < 8; ++k8) { float x[8];
#pragma unroll
        for (int i = 0; i < 8; ++i) x[i] = tile[(8 * k8 + i) * 65 + lane];
        u32x4 w; w.x = cvt_pk_bf16(x[0], x[1]); w.y = cvt_pk_bf16(x[2], x[3]); w.z = cvt_pk_bf16(x[4], x[5]); w.w = cvt_pk_bf16(x[6], x[7]);
        *(u32x4*)(Wt + (size_t)(n0 + lane) * ldt + k0 + 8 * k8) = w; }
}

__device__ __forceinline__ void p0_prologue(const Frame& F) {
    const int gtid = F.bid * NTHR + F.tid, gsz = F.G * NTHR, lane = F.lane;
    const int gw = F.bid * 8 + F.wave, nw = F.G * 8;
    for (int u = gw; u < MPAD / 4; u += nw) {
        f32x4 v[4][4]; float ss[4];
#pragma unroll
        for (int r = 0; r < 4; ++r) { const int row = 4 * u + r;
            const float* src = row < MREAL ? F.x + (size_t)row * 1024 : F.meta + (size_t)(row < MROWS ? row - MREAL : 0) * 1024;
#pragma unroll
            for (int i = 0; i < 4; ++i) v[r][i] = *(const f32x4*)(src + 256 * i + 4 * lane); }
        f32x4 g[4];
#pragma unroll
        for (int i = 0; i < 4; ++i) g[i] = *(const f32x4*)(F.g1 + 256 * i + 4 * lane);
#pragma unroll
        for (int r = 0; r < 4; ++r) { float s = 0.f;
#pragma unroll
            for (int i = 0; i < 4; ++i) s += v[r][i][0] * v[r][i][0] + v[r][i][1] * v[r][i][1] + v[r][i][2] * v[r][i][2] + v[r][i][3] * v[r][i][3];
            ss[r] = s; }
#pragma unroll
        for (int o = 32; o > 0; o >>= 1) {
#pragma unroll
            for (int r = 0; r < 4; ++r) ss[r] += __shfl_xor(ss[r], o); }
#pragma unroll
        for (int r = 0; r < 4; ++r) { const int row = 4 * u + r; const float rs = row < MROWS ? rsqrtf(ss[r] * (1.f / 1024.f) + RMS_EPS) : 0.f;
            bf16_t* dst = F.XN() + (size_t)row * 1024;
#pragma unroll
            for (int i = 0; i < 4; ++i) { u32x2 w; w.x = cvt_pk_bf16(v[r][i][0] * rs * g[i][0], v[r][i][1] * rs * g[i][1]); w.y = cvt_pk_bf16(v[r][i][2] * rs * g[i][2], v[r][i][3] * rs * g[i][3]);
                *(u32x2*)(dst + 256 * i + 4 * lane) = w; } }
    }
    { LAS float* tile = (LAS float*)F.lds + F.wave * (64 * 65);
      for (int t = gw; t < 704 + 256 + 512; t += nw) {
          if (t < 704) transpose_tile<true>(F, tile, F.w_in, NZ, NZ, F.WIN(), 1024, nullptr, (t & 15) * 64, (t >> 4) * 64);
          else if (t < 960) { const int q = t - 704, kt = q & 15;
              if (kt < 8) transpose_tile<false>(F, tile, F.w_out, 1024, 1024, F.WOUT(), 1024, nullptr, kt * 64, (q >> 4) * 64);
              else transpose_tile<false>(F, tile, F.w_out + (size_t)512 * 1024, 1024, 1024, F.TW(), 512, nullptr, (kt - 8) * 64, (q >> 4) * 64); }
          else { const int q = t - 960; transpose_tile<false>(F, tile, F.wq, 2048, 2048, F.WQ(), 1024, F.g2, (q & 15) * 64, (q >> 4) * 64); } } }
    for (int idx = gtid; idx < 2 * 128 * 128; idx += gsz) F.SK()[idx] = f2bf(idx < 16384 ? F.sk1[idx] : F.sk2[idx - 16384]);
    for (int idx = gtid; idx < MREAL; idx += gsz) F.SUMSQ()[idx] = 0.f;
}

__device__ __forceinline__ float sum_rows4(float s) {
    auto a = __builtin_amdgcn_permlane16_swap(__float_as_uint(s), __float_as_uint(s), false, false); s = __uint_as_float(a[0]) + __uint_as_float(a[1]);
    auto c = __builtin_amdgcn_permlane32_swap(__float_as_uint(s), __float_as_uint(s), false, false); return __uint_as_float(c[0]) + __uint_as_float(c[1]); }
struct EpiIn {
    static constexpr bool PERM = true, AFTER_DRAIN = false;
    bf16_t *Q, *K, *VV, *QI, *KI, *UP; float* WI; const float *gq, *gk;
    __device__ __forceinline__ static u32x4 pk8(const f32x4 a, const f32x4 b) { u32x4 w; w.x = cvt_pk_bf16(a[0], a[1]); w.y = cvt_pk_bf16(a[2], a[3]); w.z = cvt_pk_bf16(b[0], b[1]); w.w = cvt_pk_bf16(b[2], b[3]); return w; }
    __device__ __forceinline__ void operator()(const f32x4 (&acc)[2][2][4][2], const pg8::Unit& u, int wr, int wc, int fr, int fq) const {
        const int pn = u.pn;
        const int kind = pn < 2 ? 0 : pn < 4 ? 1 : pn < 6 ? 2 : pn < 8 ? 3 : pn < 10 ? 4 : 5;
        const bool headk = (kind <= 1) || kind == 4 || (kind == 5 && wc == 0);
        const float* gp = (kind == 1 ? gk : gq) + 8 * fq;
        const int head = 4 * (pn & 1) + wc;
        float frq[2][4];
#pragma unroll
        for (int n = 0; n < 2; ++n)
#pragma unroll
            for (int i = 0; i < 4; ++i) frq[n][i] = __builtin_amdgcn_exp2f(-(float)(8 * fq + 4 * n + i) * 0.41524101186092029f) * 0.15915494309189535f;
#pragma unroll
        for (int ai = 0; ai < 2; ++ai)
#pragma unroll
            for (int m = 0; m < 4; ++m) {
                int row_ = u.pm * 256 + ai * 128 + wr * 64 + m * 16 + fr; asm volatile("" : "+v"(row_));
                const int row = row_;
                const bool real = row < MREAL, valid = row < MROWS;
                const int b = real ? row >> 11 : 0, pos = real ? (row & 2047) + NMETA : (valid ? row - MREAL : 0);
                f32x4 v[2][2];
#pragma unroll
                for (int bj = 0; bj < 2; ++bj)
#pragma unroll
                    for (int n = 0; n < 2; ++n) v[bj][n] = acc[ai][bj][m][n];
                if (kind <= 1) {
                    float ss = 0.f;
#pragma unroll
                    for (int bj = 0; bj < 2; ++bj)
#pragma unroll
                        for (int n = 0; n < 2; ++n) ss += v[bj][n][0] * v[bj][n][0] + v[bj][n][1] * v[bj][n][1] + v[bj][n][2] * v[bj][n][2] + v[bj][n][3] * v[bj][n][3];
                    ss = sum_rows4(ss);
                    const float rs = rsqrtf(ss * (1.f / 64.f) + RMS_EPS);
#pragma unroll
                    for (int bj = 0; bj < 2; ++bj)
#pragma unroll
                        for (int n = 0; n < 2; ++n) v[bj][n] = v[bj][n] * (kind == 0 ? rs * (0.125f * LOG2E) : rs) * *(const f32x4*)(gp + 32 * bj + 4 * n);
                }
                if (headk) {
                    const float fpos = (float)pos;
#pragma unroll
                    for (int n = 0; n < 2; ++n) { f32x4 cs, sn;
#pragma unroll
                        for (int i = 0; i < 4; ++i) { const float rev = __builtin_amdgcn_fractf(fpos * frq[n][i]); cs[i] = __builtin_amdgcn_cosf(rev); sn[i] = __builtin_amdgcn_sinf(rev); }
                        const f32x4 x1 = v[0][n], x2 = v[1][n];
                        v[0][n] = x1 * cs - x2 * sn; v[1][n] = x2 * cs + x1 * sn; }
                }
                if (kind == 0 || kind == 4) { if (real) { bf16_t* d = (kind ? QI : Q) + (size_t)row * 512 + head * 64 + 8 * fq;
#pragma unroll
                        for (int bj = 0; bj < 2; ++bj) *(u32x4*)(d + 32 * bj) = pk8(v[bj][0], v[bj][1]); } }
                else if (kind == 1 || kind == 2) { if (valid) { const int col = (kind == 1 ? head * 64 : (pn - 4) * 256 + 32 * wc) + 8 * fq; const int cstep = kind == 1 ? 32 : 128; bf16_t* base = kind == 1 ? K : VV;
                        const int nrep = real ? 1 : NB;
                        for (int rb = 0; rb < nrep; ++rb) { bf16_t* d = base + (size_t)((real ? b : rb) * TT + pos) * 512 + col;
#pragma unroll
                            for (int bj = 0; bj < 2; ++bj) *(u32x4*)(d + cstep * bj) = pk8(v[bj][0], v[bj][1]); } } }
                else if (kind == 3) { if (valid) { bf16_t* d = UP + (size_t)row * 512 + (pn - 6) * 256 + 32 * wc + 8 * fq;
#pragma unroll
                        for (int bj = 0; bj < 2; ++bj) *(u32x4*)(d + 128 * bj) = pk8(v[bj][0], v[bj][1]); } }
                else {
                    if (wc == 0) { if (valid) { const int nrep = real ? 1 : NB;
                            for (int rb = 0; rb < nrep; ++rb) { bf16_t* d = KI + (size_t)((real ? b : rb) * TT + pos) * 64 + 8 * fq;
#pragma unroll
                                for (int bj = 0; bj < 2; ++bj) *(u32x4*)(d + 32 * bj) = pk8(v[bj][0], v[bj][1]); } } }
                    else if (wc == 1 && fq == 0 && real) { *(f32x4*)(WI + (size_t)row * 8) = v[0][0] * 0.044194173824159216f; *(f32x4*)(WI + (size_t)row * 8 + 4) = v[0][1] * 0.044194173824159216f; }
                }
                asm volatile("" ::: "memory");
            }
    }
};
struct EpiOut {
    static constexpr bool PERM = false, AFTER_DRAIN = false;
    const float* X; float* out; bf16_t* H1B; float* sumsq;
    __device__ __forceinline__ void operator()(const f32x4 (&acc)[2][2][4][2], const pg8::Unit& u, int wr, int wc, int fr, int fq) const {
        const int row0 = u.pm * 256 + wr * 64 + fr, col0 = u.pn * 256 + wc * 32 + 4 * fq;
#pragma unroll
        for (int ai = 0; ai < 2; ++ai)
#pragma unroll
            for (int m = 0; m < 4; ++m) { const int row = row0 + ai * 128 + m * 16; const size_t off = (size_t)row * 1024 + col0; float ss = 0.f;
#pragma unroll
                for (int bj = 0; bj < 2; ++bj)
#pragma unroll
                    for (int n = 0; n < 2; ++n) { const f32x4 xv = *(const f32x4*)(X + off + bj * 128 + n * 16); const f32x4 h = xv + acc[ai][bj][m][n];
                        u32x2 w; w.x = cvt_pk_bf16(h[0], h[1]); w.y = cvt_pk_bf16(h[2], h[3]); *(u32x2*)(H1B + off + bj * 128 + n * 16) = w;
                        ss += h[0] * h[0] + h[1] * h[1] + h[2] * h[2] + h[3] * h[3]; }
                ss = sum_rows4(ss);
                if (fq == 0) atomicAdd(sumsq + row, ss); }
    }
};
struct EpiQP {
    static constexpr bool PERM = true, AFTER_DRAIN = false;
    bf16_t* O; const float* sumsq;
    __device__ __forceinline__ void operator()(const f32x4 (&acc)[2][2][4][2], const pg8::Unit& u, int wr, int wc, int fr, int fq) const {
        const int row0 = u.pm * 256 + wr * 64 + fr, col0 = u.pn * 256 + wc * 32 + 8 * fq;
#pragma unroll
        for (int ai = 0; ai < 2; ++ai)
#pragma unroll
            for (int m = 0; m < 4; ++m) { const int row = row0 + ai * 128 + m * 16; bf16_t* rowp = O + (size_t)row * 2048 + col0;
                const float rs = rsqrtf(sumsq[row] * (1.f / 1024.f) + RMS_EPS);
#pragma unroll
                for (int bj = 0; bj < 2; ++bj) { const f32x4 v0 = acc[ai][bj][m][0] * rs, v1 = acc[ai][bj][m][1] * rs;
                    u32x4 w; w.x = cvt_pk_bf16(v0[0], v0[1]); w.y = cvt_pk_bf16(v0[2], v0[3]); w.z = cvt_pk_bf16(v1[0], v1[1]); w.w = cvt_pk_bf16(v1[2], v1[3]);
                    *(u32x4*)(rowp + bj * 128) = w; } }
    }
};

__device__ __forceinline__ int zrow_of(int b, int pos) { return pos < NMETA ? MREAL + pos : b * SEQ + pos - NMETA; }

__device__ __forceinline__ bf16_t f2bf_c(float f) { unsigned u = __float_as_uint(f); u += 0x7FFFu + ((u >> 16) & 1u); return (bf16_t)(u >> 16); }
__device__ __forceinline__ void p2_weff(const Frame& F) {
    const int lane = fresh((int)threadIdx.x) & 63, hk = lane >> 5, l31 = lane & 31;
    for (int t = F.bid * 8 + F.wave; t < 512; t += F.G * 8) {
        const int n0 = (t & 31) * 32, gc0 = (t >> 5) * 32, g = gc0 >> 7;
        f32x16 acc = {};
        const bf16_t* ap = F.TW() + (size_t)(n0 + l31) * 512 + g * 128 + 8 * hk;
        const float* bp = F.pool_w + (size_t)(gc0 + l31) * 128 + 8 * hk; const float* sp = F.pool_scale + g * 128 + 8 * hk;
#pragma unroll
        for (int ks = 0; ks < 8; ++ks) {
            const bf16x8 a = *(const bf16x8*)(ap + 16 * ks);
            const f32x4 w0 = *(const f32x4*)(bp + 16 * ks) * *(const f32x4*)(sp + 16 * ks), w1 = *(const f32x4*)(bp + 16 * ks + 4) * *(const f32x4*)(sp + 16 * ks + 4);
            u32x4 bw; bw.x = cvt_pk_bf16(w0[0], w0[1]); bw.y = cvt_pk_bf16(w0[2], w0[3]); bw.z = cvt_pk_bf16(w1[0], w1[1]); bw.w = cvt_pk_bf16(w1[2], w1[3]);
            acc = MFMA32(a, __builtin_bit_cast(bf16x8, bw), acc); }
#pragma unroll
        for (int r = 0; r < 16; ++r) F.WOUT()[(size_t)(n0 + (r & 3) + 8 * (r >> 2) + 4 * hk) * 1024 + 512 + gc0 + l31] = f2bf_c(acc[r]);
    }
}
__device__ __forceinline__ void p2_pool(const Frame& F) {
    const int lane = fresh((int)threadIdx.x) & 63, g = lane >> 4, w = 2 << g;
    const float iw = 1.f / (float)w;
    for (int row0 = (F.bid * 8 + F.wave) * 2; row0 < MREAL; row0 += F.G * 8 * 2) {
        u32x4 x[2][16];
#pragma unroll
        for (int r = 0; r < 2; ++r) { const int row = row0 + r, b = row >> 11, pos = (row & 2047) + NMETA;
#pragma unroll
            for (int ii = 0; ii < 16; ++ii) { x[r][ii] = (u32x4){0u, 0u, 0u, 0u};
                if (ii < w) x[r][ii] = *(const u32x4*)(F.UP() + (size_t)zrow_of(b, pos - ii) * 512 + 8 * lane); } }
#pragma unroll
        for (int r = 0; r < 2; ++r) { float sum[8];
#pragma unroll
            for (int i = 0; i < 8; ++i) sum[i] = 0.f;
#pragma unroll
            for (int ii = 0; ii < 16; ++ii) { const u32x4 v = x[r][ii];
                sum[0] += bflo(v.x); sum[1] += bfhi(v.x); sum[2] += bflo(v.y); sum[3] += bfhi(v.y); sum[4] += bflo(v.z); sum[5] += bfhi(v.z); sum[6] += bflo(v.w); sum[7] += bfhi(v.w); }
            const u32x4 v0 = x[r][0];
            u32x4 o; o.x = cvt_pk_bf16(sum[0] * iw - bflo(v0.x), sum[1] * iw - bfhi(v0.x)); o.y = cvt_pk_bf16(sum[2] * iw - bflo(v0.y), sum[3] * iw - bfhi(v0.y));
            o.z = cvt_pk_bf16(sum[4] * iw - bflo(v0.z), sum[5] * iw - bfhi(v0.z)); o.w = cvt_pk_bf16(sum[6] * iw - bflo(v0.w), sum[7] * iw - bfhi(v0.w));
            *(u32x4*)(F.MIX() + (size_t)(row0 + r) * 1024 + 512 + 8 * lane) = o; }
    }
}

__device__ __forceinline__ void indexer_item(const Frame& F, const int b, const int qt32) {
    constexpr int NTB = 65;
    const int lane = fresh((int)threadIdx.x) & 63, tid = (int)threadIdx.x, wv = F.wave, hk = lane >> 5, l31 = lane & 31;
    const int c = qt32 >> 1, nvis = 80 + 64 * c, ntile = 3 + 2 * c, nsteps = (ntile + 3) >> 2;
    const int qrow0 = b * SEQ + qt32 * 32 + 4 * wv;
    constexpr int NST = (NTB + 3) / 4;
    const int blk = l31 >> 3, hf = (l31 >> 2) & 1, e = l31 & 3;
    const int ql = 2 * hf + (blk >> 1), head = 4 * (blk & 1) + e;
    bf16x8 af[4];
    { const bf16_t* qip = F.QI() + (size_t)(qrow0 + ql) * 512 + head * 64 + 8 * hk;
#pragma unroll
      for (int ks = 0; ks < 4; ++ks) af[ks] = *(const bf16x8*)(qip + 16 * ks); }
    float wreg[16];
#pragma unroll
    for (int r = 0; r < 16; ++r) wreg[r] = F.WI()[(size_t)(qrow0 + 2 * hk + (r >> 3)) * 8 + (r & 7)];
    const int st_key = tid >> 3, st_c8 = tid & 7;
    const unsigned st_off = st_key * 128 + ((st_c8 ^ (st_key & 7)) * 16);
    const bf16_t* kisrc = F.KI() + (size_t)(b * TT) * 64 + st_c8 * 8;
    u32x4 sa, sb;
    { int k0 = st_key, k1 = 64 + st_key; sa = *(const u32x4*)(kisrc + (size_t)k0 * 64); sb = *(const u32x4*)(kisrc + (size_t)k1 * 64); }
    *(LAS u32x4*)(F.lds + st_off) = sa; *(LAS u32x4*)(F.lds + 8192 + st_off) = sb;
    if (nsteps > 1) { int k0 = 128 + st_key, k1 = 192 + st_key; k0 = k0 < TT ? k0 : TT - 1; k1 = k1 < TT ? k1 : TT - 1; sa = *(const u32x4*)(kisrc + (size_t)k0 * 64); sb = *(const u32x4*)(kisrc + (size_t)k1 * 64); }
    __syncthreads();
    unsigned comp[2][NTB];
#pragma unroll
    for (int st = 0; st < NST; ++st) {
        if (st < nsteps) {
            const int buf = st & 1;
            u32x4 na = sa, nb = sb;
            if (st + 2 < nsteps) { int k0 = 128 * (st + 2) + st_key, k1 = k0 + 64; k0 = k0 < TT ? k0 : TT - 1; k1 = k1 < TT ? k1 : TT - 1; na = *(const u32x4*)(kisrc + (size_t)k0 * 64); nb = *(const u32x4*)(kisrc + (size_t)k1 * 64); }
#pragma unroll
            for (int tl = 0; tl < 4; ++tl) { constexpr int dummy = 0; (void)dummy; const int j = 4 * st + tl;
                if (j < NTB) {
                    unsigned c0 = 0u, c1 = 0u;
                    if (j < ntile) {
                        LAS const unsigned char* kb = F.lds + buf * 16384 + (32 * tl + l31) * 128;
                        f32x16 acc = {};
#pragma unroll
                        for (int ks = 0; ks < 4; ++ks) { const bf16x8 bfr = *(LAS const bf16x8*)(kb + (((2 * ks + hk) ^ (l31 & 7)) * 16)); acc = MFMA32(af[ks], bfr, acc); }
                        float s0 = 0.f, s1 = 0.f;
#pragma unroll
                        for (int r = 0; r < 8; ++r) { s0 += wreg[r] * fmaxf(acc[r], 0.f); s1 += wreg[r + 8] * fmaxf(acc[r + 8], 0.f); }
                        const int key = 32 * j + l31;
                        if (key < nvis) { unsigned u0 = __float_as_uint(s0), u1 = __float_as_uint(s1); if (u0 == 0x80000000u) u0 = 0u; if (u1 == 0x80000000u) u1 = 0u;
                            c0 = ((u0 ^ ((u0 >> 31) ? 0xFFFFFFFFu : 0x80000000u)) & ~0xFFFu) | (unsigned)(4095 - key);
                            c1 = ((u1 ^ ((u1 >> 31) ? 0xFFFFFFFFu : 0x80000000u)) & ~0xFFFu) | (unsigned)(4095 - key); }
                    }
                    comp[0][j] = c0; comp[1][j] = c1;
                    __builtin_amdgcn_sched_barrier(0);
                } }
            if (st + 1 < nsteps) { *(LAS u32x4*)(F.lds + (buf ^ 1) * 16384 + st_off) = sa; *(LAS u32x4*)(F.lds + (buf ^ 1) * 16384 + 8192 + st_off) = sb; }
            sa = na; sb = nb;
            __syncthreads();
        } else {
#pragma unroll
            for (int tl = 0; tl < 4; ++tl) { const int j = 4 * st + tl; if (j < NTB) { comp[0][j] = 0u; comp[1][j] = 0u; } }
        }
    }
    unsigned tA0 = 1u, tA1 = 1u, tB0 = 1u, tB1 = 1u;
    if (nvis > 256) { tA0 = tA1 = tB0 = tB1 = 0u; bool dA0 = false, dA1 = false, dB0 = false, dB1 = false;
#pragma unroll 1
        for (int bit = 31; bit >= 0; --bit) {
            const unsigned m = 1u << bit;
            const unsigned cand0 = (hk ? tB0 : tA0) | m, cand1 = (hk ? tB1 : tA1) | m;
            int p0 = 0, p1 = 0;
#define IDX_CNT(LO, HI) _Pragma("unroll") for (int j = (LO); j < (HI); ++j) { p0 += (comp[0][j] >= cand0) ? 1 : 0; p1 += (comp[1][j] >= cand1) ? 1 : 0; }
            IDX_CNT(0, 17)
            if (ntile > 17) { IDX_CNT(17, 33) if (ntile > 33) { IDX_CNT(33, 49) if (ntile > 49) { IDX_CNT(49, 65) } } }
#undef IDX_CNT
            p0 += __builtin_amdgcn_update_dpp(0, p0, 0xB1, 0xF, 0xF, false); p1 += __builtin_amdgcn_update_dpp(0, p1, 0xB1, 0xF, 0xF, false);
            p0 += __builtin_amdgcn_update_dpp(0, p0, 0x4E, 0xF, 0xF, false); p1 += __builtin_amdgcn_update_dpp(0, p1, 0x4E, 0xF, 0xF, false);
            p0 += __builtin_amdgcn_update_dpp(0, p0, 0x141, 0xF, 0xF, false); p1 += __builtin_amdgcn_update_dpp(0, p1, 0x141, 0xF, 0xF, false);
            p0 += __builtin_amdgcn_update_dpp(0, p0, 0x140, 0xF, 0xF, false); p1 += __builtin_amdgcn_update_dpp(0, p1, 0x140, 0xF, 0xF, false);
            const int cA0 = __builtin_amdgcn_readlane(p0, 0) + __builtin_amdgcn_readlane(p0, 16), cB0 = __builtin_amdgcn_readlane(p0, 32) + __builtin_amdgcn_readlane(p0, 48);
            const int cA1 = __builtin_amdgcn_readlane(p1, 0) + __builtin_amdgcn_readlane(p1, 16), cB1 = __builtin_amdgcn_readlane(p1, 32) + __builtin_amdgcn_readlane(p1, 48);
            if (!dA0 && cA0 >= 256) { tA0 |= m; dA0 = (cA0 == 256); }
            if (!dA1 && cA1 >= 256) { tA1 |= m; dA1 = (cA1 == 256); }
            if (!dB0 && cB0 >= 256) { tB0 |= m; dB0 = (cB0 == 256); }
            if (!dB1 && cB1 >= 256) { tB1 |= m; dB1 = (cB1 == 256); }
            if (dA0 && dA1 && dB0 && dB1) break; } }
    const unsigned t0 = hk ? tB0 : tA0, t1 = hk ? tB1 : tA1;
    int mq[4] = {0, 0, 0, 0};
    unsigned w64[4] = {0u, 0u, 0u, 0u};
#pragma unroll
    for (int j = 0; j < NTB; ++j) { const unsigned long long m0 = __ballot(comp[0][j] >= t0), m1 = __ballot(comp[1][j] >= t1);
        if (j < 64) {
            asm volatile("v_writelane_b32 %0, %2, %4\n\tv_writelane_b32 %1, %3, %4" : "+v"(mq[0]), "+v"(mq[2]) : "s"((int)(unsigned)m0), "s"((int)(unsigned)(m0 >> 32)), "i"(j < 64 ? j : 0));
            asm volatile("v_writelane_b32 %0, %2, %4\n\tv_writelane_b32 %1, %3, %4" : "+v"(mq[1]), "+v"(mq[3]) : "s"((int)(unsigned)m1), "s"((int)(unsigned)(m1 >> 32)), "i"(j < 64 ? j : 0));
        } else { w64[0] = (unsigned)m0; w64[2] = (unsigned)(m0 >> 32); w64[1] = (unsigned)m1; w64[3] = (unsigned)(m1 >> 32); } }
#pragma unroll
    for (int q = 0; q < 4; ++q) { unsigned* mrow = F.MASK() + (size_t)(qrow0 + q) * MASKW;
        if (lane <= ntile + 2 && lane < 64) mrow[lane] = lane < ntile ? (unsigned)mq[q] : 0u;
        if (lane < 4 && 64 + lane <= ntile + 2) mrow[64 + lane] = (64 + lane < ntile) ? w64[q] : 0u; }
    __syncthreads();
}

__device__ __forceinline__ void p3_indexer(const Frame& F) {
    for (int it = F.bid; it < 512; it += F.G) {
        const int half = it >> 8, ii = half ? 511 - (it & 255) : it;
        indexer_item(F, ii & 7, 63 - (ii >> 3));
    }
}

typedef short v4i16_t __attribute__((ext_vector_type(4)));
__device__ __forceinline__ s16x4 vtr(LAS const unsigned char* p) { return __builtin_bit_cast(s16x4, __builtin_amdgcn_ds_read_tr16_b64_v4i16((LAS v4i16_t*)p)); }

__device__ __forceinline__ void p4_attention(const Frame& F) {
    const int lane = fresh((int)threadIdx.x) & 63, wv = F.wave, tid = (int)threadIdx.x, hk = lane >> 5, l31 = lane & 31;
    float gb; { float a = fabsf(F.gq[lane]), bq = fabsf(F.gk[lane]);
#pragma unroll
        for (int o = 32; o > 0; o >>= 1) { a = fmaxf(a, __shfl_xor(a, o)); bq = fmaxf(bq, __shfl_xor(bq, o)); }
        gb = a * bq; }
    const float NMB = -8.f * gb * 1.02f * LOG2E;
    const int st_which = tid >> 8, st_r = (tid & 255) >> 3, st_c8 = tid & 7;
    const unsigned st_off = st_which ? (32768u + st_r * 128 + st_c8 * 16) : (st_r * 128 + ((st_c8 ^ (st_r & 7)) * 16));
    for (int it = F.bid; it < 512; it += F.G) {
        const int pr = it & 255, half = it >> 8, cp = pr & 3, bh = pr >> 2, b = bh >> 3, h = bh & 7, c4 = half ? 7 - cp : cp;
        const int qrow = b * SEQ + 256 * c4 + 32 * wv + l31;
        const int cch = 4 * c4 + (wv >> 1), nt = (80 + 64 * cch + 127) >> 7, ntmax = (80 + 64 * (4 * c4 + 3) + 127) >> 7;
        bf16x8 qf[4];
#pragma unroll
        for (int ks = 0; ks < 4; ++ks) qf[ks] = *(const bf16x8*)(F.Q() + (size_t)qrow * 512 + h * 64 + 16 * ks + 8 * hk);
        const bf16_t* stsrc = (st_which ? F.VV() : F.K()) + (size_t)(b * TT) * 512 + h * 64 + st_c8 * 8;
        f32x16 o0 = {}, o1 = {}; float lsum = 0.f;
        u32x4 sa[4];
#pragma unroll
        for (int q = 0; q < 4; ++q) sa[q] = *(const u32x4*)(stsrc + (size_t)(32 * q + st_r) * 512);
        u32x4 mw = *(const u32x4*)(F.MASK() + (size_t)qrow * MASKW);
#pragma unroll
        for (int q = 0; q < 4; ++q) *(LAS u32x4*)(F.lds + 4096 * q + st_off) = sa[q];
        if (ntmax > 1) {
#pragma unroll
            for (int q = 0; q < 4; ++q) { int k = 128 + 32 * q + st_r; k = k < TT ? k : TT - 1; sa[q] = *(const u32x4*)(stsrc + (size_t)k * 512); } }
        __syncthreads();
        for (int j = 0; j < ntmax; ++j) {
            const int buf = j & 1;
            u32x4 mw_next = {0u, 0u, 0u, 0u}; u32x4 na[4];
#pragma unroll
            for (int q = 0; q < 4; ++q) na[q] = sa[q];
            if (j + 2 < ntmax) {
#pragma unroll
                for (int q = 0; q < 4; ++q) { int k = 128 * (j + 2) + 32 * q + st_r; k = k < TT ? k : TT - 1; na[q] = *(const u32x4*)(stsrc + (size_t)k * 512); } }
            if (j + 1 < nt) mw_next = *(const u32x4*)(F.MASK() + (size_t)qrow * MASKW + 4 * (j + 1));
            if (j < nt) {
                LAS const unsigned char* kb = F.lds + buf * 16384; LAS const unsigned char* vb = F.lds + 32768 + buf * 16384;
#pragma unroll
                for (int hp = 0; hp < 2; ++hp) {
                    f32x16 s[2];
#pragma unroll
                    for (int hh = 0; hh < 2; ++hh)
#pragma unroll
                        for (int r = 0; r < 16; ++r) s[hh][r] = NMB;
#pragma unroll
                    for (int ks = 0; ks < 4; ++ks)
#pragma unroll
                        for (int hh = 0; hh < 2; ++hh) { const bf16x8 kf = *(LAS const bf16x8*)(kb + (64 * hp + 32 * hh + l31) * 128 + (((2 * ks + hk) ^ (l31 & 7)) * 16)); s[hh] = MFMA32(kf, qf[ks], s[hh]); }
                    bf16x8 pf[2][2];
#pragma unroll
                    for (int hh = 0; hh < 2; ++hh) {
                        const unsigned w2 = mw[2 * hp + hh] >> (4 * hk);
                        float p[16];
#pragma unroll
                        for (int r = 0; r < 16; ++r) { p[r] = __uint_as_float(__float_as_uint(__builtin_amdgcn_exp2f(s[hh][r])) & (unsigned)__builtin_amdgcn_sbfe((int)w2, (r & 3) + 8 * (r >> 2), 1)); lsum += p[r]; }
#pragma unroll
                        for (int s2 = 0; s2 < 2; ++s2) { u32x4 w; w.x = cvt_pk_bf16(p[8 * s2 + 0], p[8 * s2 + 1]); w.y = cvt_pk_bf16(p[8 * s2 + 2], p[8 * s2 + 3]);
                            w.z = cvt_pk_bf16(p[8 * s2 + 4], p[8 * s2 + 5]); w.w = cvt_pk_bf16(p[8 * s2 + 6], p[8 * s2 + 7]); pf[hh][s2] = __builtin_bit_cast(bf16x8, w); }
                    }
                    const int i16 = lane & 15, g1 = (lane >> 4) & 1;
#pragma unroll
                    for (int hh = 0; hh < 2; ++hh) {
                        LAS const unsigned char* vp = vb + (64 * hp + 32 * hh + 4 * hk + (i16 >> 2)) * 128 + (16 * g1 + 4 * (i16 & 3)) * 2;
#pragma unroll
                        for (int s2 = 0; s2 < 2; ++s2) {
                            { const s16x4 lo = vtr(vp + (16 * s2) * 128), hi = vtr(vp + (16 * s2 + 8) * 128);
                              const bf16x8 vf = {lo[0], lo[1], lo[2], lo[3], hi[0], hi[1], hi[2], hi[3]}; o0 = MFMA32(vf, pf[hh][s2], o0); }
                            { const s16x4 lo = vtr(vp + (16 * s2) * 128 + 64), hi = vtr(vp + (16 * s2 + 8) * 128 + 64);
                              const bf16x8 vf = {lo[0], lo[1], lo[2], lo[3], hi[0], hi[1], hi[2], hi[3]}; o1 = MFMA32(vf, pf[hh][s2], o1); }
                        }
                    }
                }
            }
            if (j + 1 < ntmax) {
#pragma unroll
                for (int q = 0; q < 4; ++q) *(LAS u32x4*)(F.lds + (buf ^ 1) * 16384 + 4096 * q + st_off) = sa[q]; }
            mw = mw_next;
#pragma unroll
            for (int q = 0; q < 4; ++q) sa[q] = na[q];
            __syncthreads();
        }
        lsum += __shfl_xor(lsum, 32);
        const float inv = 1.f / lsum;
        bf16_t* dst = F.MIX() + (size_t)qrow * 1024 + h * 64 + 4 * hk;
#pragma unroll
        for (int g = 0; g < 4; ++g) {
            u32x2 w; w.x = cvt_pk_bf16(o0[4 * g] * inv, o0[4 * g + 1] * inv); w.y = cvt_pk_bf16(o0[4 * g + 2] * inv, o0[4 * g + 3] * inv); *(u32x2*)(dst + 8 * g) = w;
            u32x2 w1; w1.x = cvt_pk_bf16(o1[4 * g] * inv, o1[4 * g + 1] * inv); w1.y = cvt_pk_bf16(o1[4 * g + 2] * inv, o1[4 * g + 3] * inv); *(u32x2*)(dst + 32 + 8 * g) = w1; }
    }
}

template <int N> __device__ __forceinline__ void bitonic_sort_desc(float (&a)[N]) {
#pragma unroll
    for (int k = 2; k <= N; k <<= 1)
#pragma unroll
        for (int j = k >> 1; j > 0; j >>= 1)
#pragma unroll
            for (int i = 0; i < N; ++i) { const int l = i ^ j; if (l > i) { const bool desc = ((i & k) == 0) || (k == N); const float x = a[i], y = a[l];
                const float mx = fmaxf(x, y), mn = fminf(x, y); a[i] = desc ? mx : mn; a[l] = desc ? mn : mx; } }
}
__device__ __forceinline__ void merge_top16(float (&a)[16], const float (&b)[16]) {
#pragma unroll
    for (int i = 0; i < 16; ++i) a[i] = fmaxf(a[i], b[15 - i]);
#pragma unroll
    for (int j = 8; j > 0; j >>= 1)
#pragma unroll
        for (int i = 0; i < 16; ++i) { const int l = i ^ j; if (l > i) { const float x = a[i], y = a[l]; a[i] = fmaxf(x, y); a[l] = fminf(x, y); } }
}
__device__ __forceinline__ void cex(float& x, int& px, float& y, int& py) { const bool sw = y > x; const float tx = sw ? y : x, ty = sw ? x : y; const int tp = sw ? py : px, tq = sw ? px : py; x = tx; y = ty; px = tp; py = tq; }

__host__ __device__ constexpr int cand_cnt(int i) { return 16 / (i + 1); }
__host__ __device__ constexpr int cand_off(int i) { int s = 0; for (int k = 0; k < i; ++k) s += cand_cnt(k); return s; }
static_assert(cand_off(16) == 50, "candidates");
template <int N> __device__ __forceinline__ void bitonic_sort_desc_kv(float (&a)[N], int (&p)[N]) {
#pragma unroll
    for (int k = 2; k <= N; k <<= 1)
#pragma unroll
        for (int j = k >> 1; j > 0; j >>= 1)
#pragma unroll
            for (int i = 0; i < N; ++i) { const int l = i ^ j; if (l > i) { const bool desc = ((i & k) == 0) || (k == N);
                if (desc) cex(a[i], p[i], a[l], p[l]); else cex(a[l], p[l], a[i], p[i]); } }
}
__device__ __forceinline__ void merge_top16_kv(float (&a)[16], int (&pa)[16], const float (&b)[16], const int (&pb)[16]) {
#pragma unroll
    for (int i = 0; i < 16; ++i) { const bool sw = b[15 - i] > a[i]; a[i] = sw ? b[15 - i] : a[i]; pa[i] = sw ? pb[15 - i] : pa[i]; }
#pragma unroll
    for (int j = 8; j > 0; j >>= 1)
#pragma unroll
        for (int i = 0; i < 16; ++i) { const int l = i ^ j; if (l > i) cex(a[i], pa[i], a[l], pa[l]); }
}
__device__ __forceinline__ void sub_top16(const Frame& F, LAS const unsigned char* skl, const bf16_t* qrow, float (&top)[16]) {
    const int lane = F.lane, hk = lane >> 5, l31 = lane & 31;
    bf16x8 bq[8];
#pragma unroll
    for (int ks = 0; ks < 8; ++ks) bq[ks] = *(const bf16x8*)(qrow + 16 * ks + 8 * hk);
#pragma unroll
    for (int mt = 0; mt < 4; ++mt) {
        f32x16 acc = {};
        const int key = 32 * mt + l31;
#pragma unroll
        for (int ks = 0; ks < 8; ++ks) { const bf16x8 a = *(LAS const bf16x8*)(skl + key * 256 + (((2 * ks + hk) ^ (key & 15)) * 16)); acc = MFMA32(a, bq[ks], acc); }
        float cur[16];
#pragma unroll
        for (int r = 0; r < 16; ++r) { const unsigned kidx = (unsigned)(32 * mt + (r & 3) + 8 * (r >> 2) + 4 * hk); cur[r] = __uint_as_float((__float_as_uint(acc[r]) & ~127u) | kidx); }
        bitonic_sort_desc<16>(cur);
        if (mt == 0) {
#pragma unroll
            for (int i = 0; i < 16; ++i) top[i] = cur[i]; }
        else merge_top16(top, cur);
        __builtin_amdgcn_sched_barrier(0);
    }
    float oth[16];
#pragma unroll
    for (int i = 0; i < 16; ++i) oth[i] = __shfl_xor(top[i], 32);
    merge_top16(top, oth);
}

__host__ __device__ constexpr int p1_units() { return (MPAD / 256) * (NZP / 256); }
__host__ __device__ __forceinline__ int p1_first_idle(int G) { const int maxu = (p1_units() + G - 1) / G; return p1_units() - (maxu - 1) * G; }
__host__ __device__ __forceinline__ int tables_rows_p1(int G) { const int r = (G - p1_first_idle(G)) * 8 * 24; return r < 2 * NEXP ? r : 2 * NEXP; }
__device__ __forceinline__ unsigned pack_i8(float a, float b, float c, float d) {
    const unsigned ua = __float_as_uint(a + 12582912.f), ub = __float_as_uint(b + 12582912.f), uc = __float_as_uint(c + 12582912.f), ud = __float_as_uint(d + 12582912.f);
    return __builtin_amdgcn_perm(ub, ua, 0x0c0c0400u) | __builtin_amdgcn_perm(ud, uc, 0x04000c0cu);
}
__device__ __forceinline__ void p7b_tables(const Frame& F, const int widx, const int nworkers, const int rbeg, const int rend) {
    const int lane = fresh((int)threadIdx.x) & 63;
    f32x4 g[4];
#pragma unroll
    for (int i = 0; i < 4; ++i) g[i] = *(const f32x4*)(F.g2 + 16 * lane + 4 * i);
#pragma unroll 1
    for (int r0 = rbeg + widx * 8; r0 < rend; r0 += nworkers * 8) {
        const bool isv = r0 >= NEXP; const int e0 = isv ? r0 - NEXP : r0;
        const float* src = (isv ? F.pv : F.pu) + (size_t)e0 * 1024 + 16 * lane;
        f32x4 v[8][4]; float mx[8];
#pragma unroll
        for (int r = 0; r < 8; ++r)
#pragma unroll
            for (int i = 0; i < 4; ++i) v[r][i] = *(const f32x4*)(src + (size_t)r * 1024 + 4 * i);
#pragma unroll
        for (int r = 0; r < 8; ++r) { float m = 0.f;
#pragma unroll
            for (int i = 0; i < 4; ++i) { if (!isv) v[r][i] = v[r][i] * g[i];
                m = fmaxf(m, fmaxf(fmaxf(fabsf(v[r][i][0]), fabsf(v[r][i][1])), fmaxf(fabsf(v[r][i][2]), fabsf(v[r][i][3])))); }
            mx[r] = m; }
#pragma unroll
        for (int o = 32; o > 0; o >>= 1) {
#pragma unroll
            for (int r = 0; r < 8; ++r) mx[r] = fmaxf(mx[r], __shfl_xor(mx[r], o)); }
        unsigned char* dst = (isv ? F.V8() : F.U8()) + (size_t)(lane >> 3) * (NEXP * 128) + 16 * (lane & 7);
#pragma unroll
        for (int r = 0; r < 8; ++r) { const float qmax = isv ? 440.f : 127.f; const float sc = mx[r] > 0.f ? mx[r] / qmax : 1.f, inv = 1.f / sc;
            u32x4 w;
            if (isv) {
#pragma unroll
                for (int i = 0; i < 4; ++i) { int p = __builtin_amdgcn_cvt_pk_fp8_f32(v[r][i][0] * inv, v[r][i][1] * inv, 0, false); p = __builtin_amdgcn_cvt_pk_fp8_f32(v[r][i][2] * inv, v[r][i][3] * inv, p, true); w[i] = (unsigned)p; }
            } else {
#pragma unroll
                for (int i = 0; i < 4; ++i) w[i] = pack_i8(v[r][i][0] * inv, v[r][i][1] * inv, v[r][i][2] * inv, v[r][i][3] * inv);
            }
            *(u32x4*)(dst + (size_t)(e0 + r) * 128) = w;
            if (lane == 0) (isv ? F.SV() : F.SU())[e0 + r] = sc; }
    }
}

__device__ __forceinline__ void p7_routing(const Frame& F) {
    const int lane = F.lane, hk = lane >> 5, l31 = lane & 31;
    for (int idx = F.tid; idx < 2 * 128 * 16; idx += NTHR) { const int tb = idx >> 11, key = (idx >> 4) & 127, c16 = idx & 15;
        const u32x4 v = *(const u32x4*)(F.SK() + (size_t)tb * 16384 + key * 128 + c16 * 8);
        *(LAS u32x4*)(F.lds + tb * 32768 + key * 256 + ((c16 ^ (key & 15)) * 16)) = v; }
    LAS unsigned* ctab = (LAS unsigned*)(F.lds + 131072);
    if (F.tid < 50) { int n = F.tid, i = 0; while (n >= cand_cnt(i)) { n -= cand_cnt(i); ++i; } ctab[F.tid] = (unsigned)((i << 4) | n); }
    LAS float* lt = (LAS float*)(F.lds + 65536) + F.wave * 2048;
    __syncthreads();
    constexpr int RW = 6;
    if (F.wave >= RW) { p7b_tables(F, F.bid * (8 - RW) + (F.wave - RW), F.G * (8 - RW), tables_rows_p1(F.G), 2 * NEXP); return; }
    pg8::StaticOrder S; S.init(MREAL, 2048, F.G, F.bid);
    for (int li = F.wave; ; li += RW) {
        pg8::Unit un; if (!S.next(li >> 3, un)) break;
        const int tt = un.pm * 8 + (li & 7), head = un.pn, tok = tt * 32 + l31;
        const bf16_t* qrow = F.QP() + (size_t)tok * 2048 + head * 256;
        float t1[16], t2[16];
        sub_top16(F, F.lds, qrow, t1);
        sub_top16(F, F.lds + 32768, qrow + 128, t2);
#pragma unroll
        for (int i = 0; i < 16; ++i) { lt[i * 64 + lane] = t1[i]; lt[(16 + i) * 64 + lane] = t2[i]; }
        float cv[4][16];
#pragma unroll
        for (int k = 50; k < 64; ++k) cv[k >> 4][k & 15] = -3.0e38f;
#pragma unroll
        for (int i = 0; i < 16; ++i)
#pragma unroll
            for (int j = 0; j < 16; ++j) if ((i + 1) * (j + 1) <= 16) {
                const int n = cand_off(i) + j;
                const float sum = __uint_as_float(__float_as_uint(t1[i]) & ~127u) + __uint_as_float(__float_as_uint(t2[j]) & ~127u);
                cv[n >> 4][n & 15] = __uint_as_float((__float_as_uint(sum) & ~63u) | (unsigned)n); }
#pragma unroll
        for (int g = 0; g < 4; ++g) bitonic_sort_desc<16>(cv[g]);
        merge_top16(cv[0], cv[1]); merge_top16(cv[2], cv[3]); merge_top16(cv[0], cv[2]);
        float sv[16]; int ev[16];
#pragma unroll
        for (int k = 0; k < 16; ++k) { const unsigned ij = ctab[__float_as_uint(cv[0][k]) & 63u];
            const unsigned a = __float_as_uint(lt[(ij >> 4) * 64 + lane]), bb = __float_as_uint(lt[(16 + (ij & 15)) * 64 + lane]);
            sv[k] = __uint_as_float(a & ~127u) + __uint_as_float(bb & ~127u); ev[k] = (int)(((a & 127u) << 7) | (bb & 127u)); }
        float mx = sv[0];
#pragma unroll
        for (int k = 1; k < 16; ++k) mx = fmaxf(mx, sv[k]);
        float ge[16], gs = 0.f;
#pragma unroll
        for (int k = 0; k < 16; ++k) { ge[k] = __expf(sv[k] - mx); gs += ge[k]; }
        const float ginv = 1.f / gs;
        if (hk == 0) {
            bf16_t* ed = F.EID() + (size_t)tok * 128 + head * 16; float* gd = F.GATE() + (size_t)tok * 128 + head * 16;
#pragma unroll
            for (int k = 0; k < 16; k += 8) *(u32x4*)(ed + k) = (u32x4){(unsigned)ev[k] | ((unsigned)ev[k + 1] << 16), (unsigned)ev[k + 2] | ((unsigned)ev[k + 3] << 16), (unsigned)ev[k + 4] | ((unsigned)ev[k + 5] << 16), (unsigned)ev[k + 6] | ((unsigned)ev[k + 7] << 16)};
#pragma unroll
            for (int k = 0; k < 16; k += 4) *(f32x4*)(gd + k) = (f32x4){ge[k] * ginv, ge[k + 1] * ginv, ge[k + 2] * ginv, ge[k + 3] * ginv};
        }
    }
}

typedef float f32x2 __attribute__((ext_vector_type(2)));
#define XQ_WORD(pass, s) (4096 + 64 * (8 * (pass) + (s)))
#define XQ_TOK 32
#define XQ_CHUNKS (MREAL / (8 * XQ_TOK))
__device__ __forceinline__ int next_item(const Frame& F, unsigned* ctl, int qpass, int cur) {
    volatile LAS int* slot = (volatile LAS int*)(F.lds + LDS_BYTES - 32);
    __syncthreads();
    if (F.tid == 0) { int res = -1;
        for (int d = 0; d < 8; ++d) { const int s = (cur + d) & 7; unsigned* c = ctl + XQ_WORD(qpass, s);
            if (__hip_atomic_load(c, __ATOMIC_RELAXED, __HIP_MEMORY_SCOPE_AGENT) >= (unsigned)XQ_CHUNKS) continue;
            const unsigned idx = __hip_atomic_fetch_add(c, 1u, __ATOMIC_RELAXED, __HIP_MEMORY_SCOPE_AGENT);
            if (idx < (unsigned)XQ_CHUNKS) { res = (s << 16) | (int)idx; break; } }
        *slot = res; }
    __syncthreads();
    return *slot;
}
__device__ __forceinline__ float swap32_sum(float a, float b) { auto r = __builtin_amdgcn_permlane32_swap(__float_as_uint(a), __float_as_uint(b), false, false); return __uint_as_float(r[0]) + __uint_as_float(r[1]); }
__device__ __forceinline__ float swap16_sum(float a, float b) { auto r = __builtin_amdgcn_permlane16_swap(__float_as_uint(a), __float_as_uint(b), false, false); return __uint_as_float(r[0]) + __uint_as_float(r[1]); }
__device__ __forceinline__ float ror8_sum(float mine, float theirs) { return mine + __uint_as_float((unsigned)__builtin_amdgcn_update_dpp(0, (int)__float_as_uint(theirs), 0x128, 0xF, 0xF, false)); }
template <int CTRL> __device__ __forceinline__ float dpp_sum(float mine, float theirs) { return mine + __uint_as_float((unsigned)__builtin_amdgcn_update_dpp(0, (int)__float_as_uint(theirs), CTRL, 0xF, 0xF, false)); }
#define P8_LOAD8(R, EV, BASE, OFF) _Pragma("unroll") for (int ii = 0; ii < 8; ++ii) { const int e_ = __shfl((EV), 8 * ii + xg); R[ii] = *(const u32x4*)((BASE) + ((unsigned)e_ * 128u + (OFF))); }
#define P8U_DOT8(R, P0) _Pragma("unroll") for (int ii = 0; ii < 8; ++ii) { int a_ = __builtin_amdgcn_sdot4((int)R[ii][0], (int)xq[0], 0, false); a_ = __builtin_amdgcn_sdot4((int)R[ii][1], (int)xq[1], a_, false); \
        a_ = __builtin_amdgcn_sdot4((int)R[ii][2], (int)xq[2], a_, false); p[(P0) + ii] = __builtin_amdgcn_sdot4((int)R[ii][3], (int)xq[3], a_, false); }
template <int CTRL> __device__ __forceinline__ int dpp_isum(int mine, int theirs) { return mine + __builtin_amdgcn_update_dpp(0, theirs, CTRL, 0xF, 0xF, false); }
template <int CTRL> __device__ __forceinline__ float dpp_fmax(float v) { return fmaxf(v, __uint_as_float((unsigned)__builtin_amdgcn_update_dpp(0, (int)__float_as_uint(v), CTRL, 0xF, 0xF, false))); }
template <int QPASS>
__device__ __forceinline__ void p8u_sliced(const Frame& F) {
    unsigned* ctl = (unsigned*)(F.ws + WS_CTL);
    int cur = (int)(xb_xcc_id() & 7u);
    for (;;) { const int itm = next_item(F, ctl, QPASS, cur); if (itm < 0) break;
        const int s = itm >> 16, chunk = itm & 0xffff; cur = s;
        const int lane = fresh((int)threadIdx.x) & 63, xg = lane >> 3, ch = lane & 7;
        const int t0 = chunk * (8 * XQ_TOK) + F.wave * XQ_TOK;
        const unsigned char* ubase = F.U8() + (size_t)s * (NEXP * 128);
        const unsigned uoff = 16u * ch;
        const bool b2 = lane & 4, b1 = lane & 2, b0 = lane & 1;
        const int kout = 64 * (b2 ? 1 : 0) + 32 * (b0 ? 1 : 0) + 16 * (b1 ? 1 : 0) + xg;
        bf16_t* part = F.PART() + (size_t)s * ((size_t)MREAL * 128);
        LAS unsigned char* xl = F.lds + F.wave * 4096; LAS float* xsl = (LAS float*)(F.lds + 32768) + F.wave * 32;
        { u32x4 hx[4][2];
#pragma unroll
          for (int r = 0; r < 4; ++r) { const bf16_t* hp = F.H1B() + (unsigned)((t0 + 8 * r + xg) * 1024 + 128 * s + 16 * ch); hx[r][0] = *(const u32x4*)hp; hx[r][1] = *(const u32x4*)(hp + 8); }
#pragma unroll
          for (int r = 0; r < 4; ++r) { float v[16];
#pragma unroll
              for (int q = 0; q < 4; ++q) { v[2 * q] = bflo(hx[r][0][q]); v[2 * q + 1] = bfhi(hx[r][0][q]); v[8 + 2 * q] = bflo(hx[r][1][q]); v[8 + 2 * q + 1] = bfhi(hx[r][1][q]); }
              float m = fabsf(v[0]);
#pragma unroll
              for (int q = 1; q < 16; ++q) m = fmaxf(m, fabsf(v[q]));
              m = dpp_fmax<0xB1>(m); m = dpp_fmax<0x4E>(m); m = dpp_fmax<0x141>(m);
              const float sc = m > 0.f ? m * (1.f / 127.f) : 1.f, inv = m > 0.f ? 127.f / m : 0.f;
              u32x4 w;
#pragma unroll
              for (int q = 0; q < 4; ++q) w[q] = pack_i8(v[4 * q] * inv, v[4 * q + 1] * inv, v[4 * q + 2] * inv, v[4 * q + 3] * inv);
              *(LAS u32x4*)(xl + (8 * r + xg) * 128 + 16 * ch) = w;
              if (ch == 0) xsl[8 * r + xg] = sc; } }
        int e_lo = (int)F.EID()[(unsigned)(t0 * 128 + lane)], e_hi = (int)F.EID()[(unsigned)(t0 * 128 + 64 + lane)];
        int n_lo = (int)F.EID()[(unsigned)((t0 + 1) * 128 + lane)], n_hi = (int)F.EID()[(unsigned)((t0 + 1) * 128 + 64 + lane)];
        u32x4 rA[8], rB[8];
        P8_LOAD8(rA, e_lo, ubase, uoff)
#pragma unroll 1
        for (int i = 0; i < XQ_TOK; ++i) {
            const int t = t0 + i, tnn = t0 + (i < XQ_TOK - 2 ? i + 2 : XQ_TOK - 1);
            const int nn_lo = (int)F.EID()[(unsigned)(tnn * 128 + lane)], nn_hi = (int)F.EID()[(unsigned)(tnn * 128 + 64 + lane)];
            const u32x4 xq = *(const LAS u32x4*)(xl + i * 128 + 16 * ch); const float xs = xsl[i];
            int p[16];
            P8_LOAD8(rB, e_hi, ubase, uoff)
            __builtin_amdgcn_sched_barrier(0);
            P8U_DOT8(rA, 0)
            __builtin_amdgcn_sched_barrier(0);
            P8_LOAD8(rA, n_lo, ubase, uoff)
            __builtin_amdgcn_sched_barrier(0);
            P8U_DOT8(rB, 8)
            int r8[8], r4[4], r2[2];
#pragma unroll
            for (int q = 0; q < 8; ++q) r8[q] = dpp_isum<0x141>(b2 ? p[q + 8] : p[q], b2 ? p[q] : p[q + 8]);
#pragma unroll
            for (int q = 0; q < 4; ++q) r4[q] = dpp_isum<0xB1>(b0 ? r8[q + 4] : r8[q], b0 ? r8[q] : r8[q + 4]);
#pragma unroll
            for (int q = 0; q < 2; ++q) r2[q] = dpp_isum<0x4E>(b1 ? r4[q + 2] : r4[q], b1 ? r4[q] : r4[q + 2]);
            part[(unsigned)(t * 128 + kout)] = f2bf((float)r2[0] * xs); part[(unsigned)(t * 128 + kout + 8)] = f2bf((float)r2[1] * xs);
            e_lo = n_lo; e_hi = n_hi; n_lo = nn_lo; n_hi = nn_hi;
            __builtin_amdgcn_sched_barrier(0);
        }
    }
}
__device__ __forceinline__ void p8c_combine(const Frame& F) {
    for (int idx = F.bid * NTHR + fresh((int)threadIdx.x); idx < MREAL * 128; idx += F.G * NTHR) {
        const int t = idx >> 7; const int e = (int)F.EID()[idx];
        float sum = 0.f;
#pragma unroll
        for (int s = 0; s < 8; ++s) sum += bf2f(F.PART()[(size_t)s * ((size_t)MREAL * 128) + idx]);
        const float a = sum * F.SU()[e] * rsqrtf(F.SUMSQ()[t] * (1.f / 1024.f) + RMS_EPS);
        F.CB()[idx] = f2bf(0.5f * a * (1.f + erff(a * 0.70710678118654752f)) * F.GATE()[idx] * F.SV()[e]);
    }
}
#define P8V_FMA8(R, C) _Pragma("unroll") for (int ii = 0; ii < 8; ++ii) { const f32x2 c2 = {C[ii], C[ii]};                            \
        _Pragma("unroll") for (int q = 0; q < 4; ++q) { acc2[2 * q] += c2 * __builtin_amdgcn_cvt_pk_f32_fp8((int)R[ii][q], false); acc2[2 * q + 1] += c2 * __builtin_amdgcn_cvt_pk_f32_fp8((int)R[ii][q], true); } }
#define P8V_COEF8(C, CV) _Pragma("unroll") for (int ii = 0; ii < 8; ++ii) C[ii] = __shfl((CV), 8 * ii + xg);
template <int QPASS>
__device__ __forceinline__ void p8v_experts(const Frame& F) {
    unsigned* ctl = (unsigned*)(F.ws + WS_CTL);
    int cur = (int)(xb_xcc_id() & 7u);
    for (;;) { const int itm = next_item(F, ctl, QPASS, cur); if (itm < 0) break;
        const int s = itm >> 16, chunk = itm & 0xffff; cur = s;
        const int lane = fresh((int)threadIdx.x) & 63, xg = lane >> 3, ch = lane & 7;
        const int t0 = chunk * (8 * XQ_TOK) + F.wave * XQ_TOK;
        const unsigned char* vbase = F.V8() + (size_t)s * (NEXP * 128);
        const unsigned voff = 16u * ch;
        const bool b5 = lane & 32, b4 = lane & 16, b3 = lane & 8;
        const int col = 128 * s + 16 * ch + (b5 ? 8 : 0) + (b4 ? 4 : 0) + (b3 ? 2 : 0);
        int e_lo = (int)F.EID()[(unsigned)(t0 * 128 + lane)], e_hi = (int)F.EID()[(unsigned)(t0 * 128 + 64 + lane)];
        int n_lo = (int)F.EID()[(unsigned)((t0 + 1) * 128 + lane)], n_hi = (int)F.EID()[(unsigned)((t0 + 1) * 128 + 64 + lane)];
        float c_lo = bf2f(F.CB()[(unsigned)(t0 * 128 + lane)]), c_hi = bf2f(F.CB()[(unsigned)(t0 * 128 + 64 + lane)]);
        u32x4 rA[8], rB[8];
        P8_LOAD8(rA, e_lo, vbase, voff)
#pragma unroll 1
        for (int i = 0; i < XQ_TOK; ++i) {
            const int t = t0 + i, tn = t0 + (i < XQ_TOK - 1 ? i + 1 : XQ_TOK - 1), tnn = t0 + (i < XQ_TOK - 2 ? i + 2 : XQ_TOK - 1);
            const int nn_lo = (int)F.EID()[(unsigned)(tnn * 128 + lane)], nn_hi = (int)F.EID()[(unsigned)(tnn * 128 + 64 + lane)];
            const float nc_lo = bf2f(F.CB()[(unsigned)(tn * 128 + lane)]), nc_hi = bf2f(F.CB()[(unsigned)(tn * 128 + 64 + lane)]);
            const unsigned h1w = *(const unsigned*)(F.H1B() + (unsigned)(t * 1024 + col)); const f32x2 h1 = {bflo(h1w), bfhi(h1w)};
            f32x2 acc2[8]; float cc[8];
#pragma unroll
            for (int q = 0; q < 8; ++q) acc2[q] = (f32x2){0.f, 0.f};
            P8_LOAD8(rB, e_hi, vbase, voff)
            P8V_COEF8(cc, c_lo)
            __builtin_amdgcn_sched_barrier(0);
            P8V_FMA8(rA, cc)
            __builtin_amdgcn_sched_barrier(0);
            P8_LOAD8(rA, n_lo, vbase, voff)
            P8V_COEF8(cc, c_hi)
            __builtin_amdgcn_sched_barrier(0);
            P8V_FMA8(rB, cc)
            __builtin_amdgcn_sched_barrier(0);
            float acc[16];
#pragma unroll
            for (int q = 0; q < 8; ++q) { acc[2 * q] = acc2[q][0]; acc[2 * q + 1] = acc2[q][1]; }
            float r8[8], r4[4], r2[2];
#pragma unroll
            for (int q = 0; q < 8; ++q) r8[q] = swap32_sum(acc[q], acc[q + 8]);
#pragma unroll
            for (int q = 0; q < 4; ++q) r4[q] = swap16_sum(r8[q], r8[q + 4]);
#pragma unroll
            for (int q = 0; q < 2; ++q) r2[q] = ror8_sum(b3 ? r4[q + 2] : r4[q], b3 ? r4[q] : r4[q + 2]);
            *(f32x2*)(F.out + (unsigned)(t * 1024 + col)) = (f32x2){h1[0] + r2[0], h1[1] + r2[1]};
            e_lo = n_lo; e_hi = n_hi; n_lo = nn_lo; n_hi = nn_hi; c_lo = nc_lo; c_hi = nc_hi;
            __builtin_amdgcn_sched_barrier(0);
        }
    }
}

constexpr int NPHASE = 10;
__global__ void __launch_bounds__(NTHR, 2) mk_fwd(Args args) {
    extern __shared__ __attribute__((aligned(16))) unsigned char lds_raw[];
    Frame F;
    F.lds = (LAS unsigned char*)lds_raw;
    F.tid = threadIdx.x; F.lane = F.tid & 63; F.wave = __builtin_amdgcn_readfirstlane(F.tid >> 6); F.G = gridDim.x; F.bid = blockIdx.x;
    F.x = args.in[0]; F.meta = args.in[1]; F.g1 = args.in[2]; F.w_in = args.in[3]; F.gq = args.in[4]; F.gk = args.in[5]; F.pool_w = args.in[6]; F.pool_scale = args.in[7];
    F.w_out = args.in[8]; F.g2 = args.in[9]; F.wq = args.in[10]; F.sk1 = args.in[11]; F.sk2 = args.in[12]; F.pu = args.in[13]; F.pv = args.in[14];
    F.out = args.out; F.ws = args.ws; unsigned char* ws = args.ws;
    const int lo = args.ph_lo, hi = args.ph_hi;
#ifndef PHASE_MASK
#define PHASE_MASK 0x3ff
#endif
#define IN(k) (((PHASE_MASK >> (k)) & 1) && lo <= (k) && (k) < hi)
    volatile LAS unsigned* bst = (volatile LAS unsigned*)(F.lds + LDS_BYTES - 16);
    if (F.tid == 0) { bst[0] = 0u; bst[1] = 0u; }
    __syncthreads();
    XcdBarrier bar = xcd_barrier_post((unsigned*)(ws + WS_CTL), bst);
#define GSYNC(k) do { if (IN(k) && IN((k) + 1)) xcd_barrier(bar); } while (0)
    if (IN(0)) { p0_prologue(F); }
    GSYNC(0);
    if (IN(1)) { { pg8::Gemm g{F.XN(), F.WIN(), MPAD, NZP, 1024}; pg8::StaticOrder S; S.init(MPAD, NZP, F.G, F.bid); EpiIn E{F.Q(), F.K(), F.VV(), F.QI(), F.KI(), F.UP(), F.WI(), F.gq, F.gk}; pg8::gemm_phase<EpiIn, pg8::StaticOrder>(F.lds, g, S, E);
        if (F.bid >= p1_first_idle(F.G)) p7b_tables(F, (F.bid - p1_first_idle(F.G)) * 8 + F.wave, (F.G - p1_first_idle(F.G)) * 8, 0, tables_rows_p1(F.G)); } }
    GSYNC(1);
    if (IN(3)) { p2_weff(F); p2_pool(F); p3_indexer(F); }
    GSYNC(3);
    if (IN(4)) { p4_attention(F); }
    GSYNC(4);
    if (IN(5)) { { pg8::Gemm g{F.MIX(), F.WOUT(), MREAL, 1024, 1024}; pg8::StaticOrder S; S.init(MREAL, 1024, F.G, F.bid); EpiOut E{F.x, F.out, F.H1B(), F.SUMSQ()}; pg8::gemm_phase<EpiOut, pg8::StaticOrder>(F.lds, g, S, E); } }
    GSYNC(5);
    if (IN(6)) { { pg8::Gemm g{F.H1B(), F.WQ(), MREAL, 2048, 1024}; pg8::StaticOrder S; S.init(MREAL, 2048, F.G, F.bid); EpiQP E{F.QP(), F.SUMSQ()}; pg8::gemm_phase<EpiQP, pg8::StaticOrder>(F.lds, g, S, E); } }
    if (IN(7)) { p7_routing(F); }
    GSYNC(7);
    if (IN(8)) { p8u_sliced<0>(F); xcd_barrier(bar); p8c_combine(F); }
    GSYNC(8);
    if (IN(9)) { p8v_experts<1>(F); }

#undef IN
#undef GSYNC
}
}

extern "C" void kernel_launch(void* const* d_in, const int* in_sizes, int n_in, void* d_out, int out_size, void* d_ws, size_t ws_size, hipStream_t stream) {
    static int grid = 0;
    if (grid == 0) {
        if (n_in != 15 || out_size != mk::MREAL * 1024 || ws_size < mk::WS_END) { fprintf(stderr, "kernel_launch: unexpected problem (n_in %d out %d ws %zu)\n", n_in, out_size, ws_size); grid = -1; return; }
        int dev = 0, cus = 0;
        if (hipGetDevice(&dev) != hipSuccess || hipDeviceGetAttribute(&cus, hipDeviceAttributeMultiprocessorCount, dev) != hipSuccess) { grid = -1; return; }
        if (hipFuncSetAttribute((const void*)mk::mk_fwd, hipFuncAttributeMaxDynamicSharedMemorySize, mk::LDS_BYTES) != hipSuccess) { fprintf(stderr, "kernel_launch: hipFuncSetAttribute failed\n"); grid = -1; return; }
        int per_cu = 0;
        if (hipOccupancyMaxActiveBlocksPerMultiprocessor(&per_cu, (const void*)mk::mk_fwd, mk::NTHR, mk::LDS_BYTES) != hipSuccess || per_cu < 1) { fprintf(stderr, "kernel_launch: occupancy query says %d\n", per_cu); grid = -1; return; }
        grid = cus;
    }
    if (grid < 0) return;
    if (hipMemsetAsync((char*)d_ws + mk::WS_CTL, 0, 32768, stream) != hipSuccess) { fprintf(stderr, "kernel_launch: memset failed\n"); return; }
    mk::Args a{};
    for (int i = 0; i < 15; ++i) a.in[i] = (const float*)d_in[i];
    a.out = (float*)d_out; a.ws = (unsigned char*)d_ws; a.ph_lo = 0; a.ph_hi = mk::NPHASE;
    void* kargs[] = {&a};
    hipError_t e = hipLaunchCooperativeKernel((const void*)mk::mk_fwd, dim3(grid), dim3(mk::NTHR), kargs, mk::LDS_BYTES, stream);
    if (e != hipSuccess) fprintf(stderr, "kernel_launch: cooperative launch failed: %s (grid %d)\n", hipGetErrorString(e), grid);

}
```

```cpp
#include <hip/hip_runtime.h>
#include <cstdio>
#include <cstdint>
namespace pg8 {
#define PG8_LAS __attribute__((address_space(3)))
typedef unsigned short bf16_t;
typedef short bf16x8 __attribute__((ext_vector_type(8)));
typedef float f32x4 __attribute__((ext_vector_type(4)));
typedef unsigned u32x4 __attribute__((ext_vector_type(4)));
constexpr int BM = 256, BK = 64, HALF = 128, HTB = HALF * BK * 2  , STAGE_BYTES = 8 * HTB, NXCD = 8, WGM = 8;

__host__ __device__ __forceinline__ int lds_byte(int r, int c) { const int st = (r >> 4) * 2 + (c >> 5), rr = r & 15, cc = c & 31, ob = rr * 64 + cc * 2; return st * 1024 + (ob ^ (((ob >> 9) & 1) << 5)); }
__host__ __device__ __forceinline__ void stage_rc(int b, int& R, int& C) { const int st = b / 1024, sb = b % 1024, swz = sb ^ (((sb >> 9) & 1) << 5); R = (st >> 1) * 16 + swz / 64; C = (st & 1) * 32 + (swz % 64) / 2; }
__host__ __device__ __forceinline__ int perm32(int rho) { const int n = rho >> 4, i = rho & 15; return 8 * (i >> 2) + 4 * n + (i & 3); }

struct Unit { int pm, pn; };
struct Gemm { const bf16_t* A; const bf16_t* Bt; int M, N, K; };
struct StaticOrder {
    int nM, nN, nwg, G, c;
    __host__ __device__ void init(int M, int N, int G_, int c_) { nM = M / BM; nN = N / BM; nwg = nM * nN; G = G_; c = c_; }
    __host__ __device__ bool next(int i, Unit& u) const {
        const long L = (long)i * G + c; if (L >= nwg) return false;
        int wgid = (int)L; { const int q = nwg / NXCD, r = nwg % NXCD, xcd = wgid % NXCD, off = wgid / NXCD; wgid = (xcd < r ? xcd * (q + 1) : r * (q + 1) + (xcd - r) * q) + off; }
        const int nig = WGM * nN, gid = wgid / nig, fm = gid * WGM, gsz = (nM - fm) < WGM ? (nM - fm) : WGM;
        u.pm = fm + ((wgid % nig) % gsz); u.pn = (wgid % nig) / gsz; return true;
    }
    __device__ __forceinline__ void a_ready(const Unit&) const {}
    __device__ __forceinline__ void done(const Unit&) const {}
};
__device__ __forceinline__ unsigned cvt_pk_bf16(float lo, float hi) { unsigned r; asm volatile("v_cvt_pk_bf16_f32 %0, %1, %2" : "=v"(r) : "v"(lo), "v"(hi)); return r; }
template <class Epi, class Sched>
__device__ __forceinline__ void gemm_phase(PG8_LAS unsigned char* lds, const Gemm g, const Sched& S, const Epi& E) {
    int tid_ = threadIdx.x; asm volatile("" : "+v"(tid_));
    const int tid = tid_, wid = __builtin_amdgcn_readfirstlane(tid >> 6), lane = tid & 63, wr = wid >> 2, wc = wid & 3, fr = lane & 15, fq = lane >> 4;
    const int K = g.K, nt = K / BK;
    unsigned voffA[2], voffB[2];
#pragma unroll
    for (int i = 0; i < 2; ++i) { int R, C; stage_rc(tid * 16 + i * 8192, R, C); const int Rb = Epi::PERM ? ((R & ~31) + perm32(R & 31)) : R;
        voffA[i] = (unsigned)(R * K + C) * 2u; voffB[i] = (unsigned)(Rb * K + C) * 2u; }
    const size_t kstep = (size_t)(BK * 2);
    const size_t hstep = (size_t)HALF * K * 2;
    const size_t tstep = 2 * hstep;
    const unsigned ldsw = (unsigned)wid * 1024u;
    const int aoff = lds_byte(wr * 64 + fr, fq * 8), boff = lds_byte(wc * 32 + fr, fq * 8);
#define PG8_SA(b, h) (((b) * 2 + (h)) * HTB)
#define PG8_SB(b, h) ((4 + (b) * 2 + (h)) * HTB)
#define PG8_STAGE(bufoff, gbase, voff) do { _Pragma("unroll") for (int _i = 0; _i < 2; ++_i) \
        __builtin_amdgcn_global_load_lds((const unsigned*)((const char*)(gbase) + (voff)[_i]), (PG8_LAS unsigned*)(lds + (bufoff) + ldsw + _i * 8192), 16, 0, 0); } while (0)
#define PG8_LDA(dst, b, h) do { _Pragma("unroll") for (int m = 0; m < 4; ++m) _Pragma("unroll") for (int k = 0; k < 2; ++k) dst[m][k] = *(const PG8_LAS bf16x8*)(lds + PG8_SA(b, h) + aoff + m * 2048 + k * 1024); } while (0)
#define PG8_LDB(dst, b, h) do { _Pragma("unroll") for (int n = 0; n < 2; ++n) _Pragma("unroll") for (int k = 0; k < 2; ++k) dst[n][k] = *(const PG8_LAS bf16x8*)(lds + PG8_SB(b, h) + boff + n * 2048 + k * 1024); } while (0)
#define PG8_MMA(ai, bj, At, Bt) do { __builtin_amdgcn_s_setprio(1); _Pragma("unroll") for (int m = 0; m < 4; ++m) _Pragma("unroll") for (int n = 0; n < 2; ++n) _Pragma("unroll") for (int k = 0; k < 2; ++k) \
        acc[ai][bj][m][n] = __builtin_amdgcn_mfma_f32_16x16x32_bf16(Bt[n][k], At[m][k], acc[ai][bj][m][n], 0, 0, 0); __builtin_amdgcn_s_setprio(0); } while (0)
#define PG8_WAIT_V(n) asm volatile("s_waitcnt vmcnt(" #n ")" ::: "memory")
#define PG8_WAIT_L(n) asm volatile("s_waitcnt lgkmcnt(" #n ")" ::: "memory")
#define PG8_BAR __builtin_amdgcn_s_barrier()
#define PG8_SCHED __builtin_amdgcn_sched_barrier(0)
    Unit cur, nxt; int ui = 0;
    if (!S.next(0, cur)) return;
    f32x4 acc[2][2][4][2];
#pragma unroll
    for (int a = 0; a < 2; ++a)
#pragma unroll
        for (int b = 0; b < 2; ++b)
#pragma unroll
            for (int m = 0; m < 4; ++m)
#pragma unroll
                for (int n = 0; n < 2; ++n) acc[a][b][m][n] = (f32x4){0.f, 0.f, 0.f, 0.f};
    bf16x8 At[4][2], B0[2][2], B1[2][2];
    const char* cA = (const char*)g.A + (size_t)cur.pm * tstep; const char* cB = (const char*)g.Bt + (size_t)cur.pn * tstep;
    S.a_ready(cur);
    PG8_STAGE(PG8_SB(0, 0), cB, voffB); PG8_STAGE(PG8_SA(0, 0), cA, voffA); PG8_STAGE(PG8_SB(0, 1), cB + hstep, voffB); PG8_STAGE(PG8_SA(0, 1), cA + hstep, voffA);
    if (wr == 1) PG8_BAR;
    PG8_WAIT_V(4); PG8_BAR;
    PG8_STAGE(PG8_SB(1, 0), cB + kstep, voffB); PG8_STAGE(PG8_SA(1, 0), cA + kstep, voffA); PG8_STAGE(PG8_SB(1, 1), cB + hstep + kstep, voffB);
    PG8_WAIT_V(6); PG8_BAR;
    for (;;) {
        const bool has_next = S.next(ui + 1, nxt);
        const char* nA = has_next ? (const char*)g.A + (size_t)nxt.pm * tstep : cA; const char* nB = has_next ? (const char*)g.Bt + (size_t)nxt.pn * tstep : cB;
        for (int t = 0; t < nt; t += 2) {
            const bool last = (t == nt - 2);
            const char* a1 = cA + (size_t)(t + 1) * kstep;
            const char* a2 = last ? nA : cA + (size_t)(t + 2) * kstep; const char* b2 = last ? nB : cB + (size_t)(t + 2) * kstep;
            const char* a3 = a2 + kstep; const char* b3 = b2 + kstep;
            if (last && has_next) S.a_ready(nxt);
            PG8_LDB(B0, 0, 0); PG8_SCHED; PG8_LDA(At, 0, 0); PG8_STAGE(PG8_SA(1, 1), a1 + hstep, voffA);
            PG8_WAIT_L(8); PG8_BAR; PG8_WAIT_L(0); PG8_MMA(0, 0, At, B0); PG8_BAR; PG8_SCHED;
            PG8_LDB(B1, 0, 1); PG8_STAGE(PG8_SB(0, 0), b2, voffB);
            PG8_BAR; PG8_WAIT_L(0); PG8_MMA(0, 1, At, B1); PG8_BAR;
            PG8_LDA(At, 0, 1); PG8_STAGE(PG8_SA(0, 0), a2, voffA);
            PG8_BAR; PG8_WAIT_L(0); PG8_MMA(1, 0, At, B0); PG8_BAR; PG8_SCHED;
            PG8_STAGE(PG8_SB(0, 1), b2 + hstep, voffB);
            PG8_WAIT_V(6); PG8_BAR; PG8_MMA(1, 1, At, B1); PG8_BAR;
            PG8_LDB(B0, 1, 0); PG8_SCHED; PG8_LDA(At, 1, 0); PG8_STAGE(PG8_SA(0, 1), a2 + hstep, voffA);
            PG8_WAIT_L(8); PG8_BAR; PG8_WAIT_L(0); PG8_MMA(0, 0, At, B0); PG8_BAR; PG8_SCHED;
            PG8_LDB(B1, 1, 1); PG8_STAGE(PG8_SB(1, 0), b3, voffB);
            PG8_BAR; PG8_WAIT_L(0); PG8_MMA(0, 1, At, B1); PG8_BAR;
            PG8_LDA(At, 1, 1); PG8_STAGE(PG8_SA(1, 0), a3, voffA);
            PG8_BAR; PG8_WAIT_L(0); PG8_MMA(1, 0, At, B0); PG8_BAR; PG8_SCHED;
            PG8_STAGE(PG8_SB(1, 1), b3 + hstep, voffB);
            PG8_WAIT_V(6); PG8_BAR; PG8_MMA(1, 1, At, B1); PG8_BAR;
        }
        if constexpr (!Epi::AFTER_DRAIN) { E(acc, cur, wr, wc, fr, fq); S.done(cur); }
        if (!has_next) break;
#pragma unroll
        for (int a = 0; a < 2; ++a)
#pragma unroll
            for (int b = 0; b < 2; ++b)
#pragma unroll
                for (int m = 0; m < 4; ++m)
#pragma unroll
                    for (int n = 0; n < 2; ++n) acc[a][b][m][n] = (f32x4){0.f, 0.f, 0.f, 0.f};
        cur = nxt; cA = nA; cB = nB; ++ui;
    }
    PG8_WAIT_V(0);
    if (wr == 0) PG8_BAR;
    PG8_BAR;
    if constexpr (Epi::AFTER_DRAIN) { E.fused(acc, cur, wr, wc, fr, fq, lds, wid, lane); S.done(cur); }
#undef PG8_SA
#undef PG8_SB
#undef PG8_STAGE
#undef PG8_LDA
#undef PG8_LDB
#undef PG8_MMA
#undef PG8_WAIT_V
#undef PG8_WAIT_L
#undef PG8_BAR
#undef PG8_SCHED
}
}
#define XB_TMO      128
#define XB_XCNT(j)  (256  + 64 * (j))
#define XB_XSUB(j)  (1280 + 64 * (j))
#define XB_XGEN(j)  (2304 + 64 * (j))
#define XB_TOP      3328
#define XB_TOPGEN   3392
#define XCD_BAR_WORDS 3456
#define XB_SPIN_CAP (1u << 18)

__device__ __forceinline__ unsigned xb_ld(unsigned* p)              { return __hip_atomic_load(p, __ATOMIC_RELAXED, __HIP_MEMORY_SCOPE_AGENT); }
__device__ __forceinline__ unsigned xb_add(unsigned* p, unsigned v) { return __hip_atomic_fetch_add(p, v, __ATOMIC_RELAXED, __HIP_MEMORY_SCOPE_AGENT); }
__device__ __forceinline__ unsigned xb_xcc_id() { return (unsigned)__builtin_amdgcn_s_getreg((3 << 11) | 20) & 0xFu; }
#define XB_SPIN(cond, bar) do { unsigned _sp = 0; while (cond) { __builtin_amdgcn_s_sleep(1); \
    if ((++_sp & 255u) == 0u) { if (xb_ld(&(bar)[XB_TMO])) break; if (_sp > XB_SPIN_CAP) { atomicAdd(&(bar)[XB_TMO], 1u); break; } } } } while (0)

struct XcdBarrier {
    unsigned* bar; unsigned x;
    volatile __attribute__((address_space(3))) unsigned* st;
};

__device__ __forceinline__ XcdBarrier xcd_barrier_post(unsigned* bar, volatile __attribute__((address_space(3))) unsigned* st) {
    XcdBarrier b; b.bar = bar; b.x = xb_xcc_id(); b.st = st;
    if (threadIdx.x == 0) (void)xb_add(&bar[XB_XCNT(b.x)], 1u);
    return b;
}
__device__ __forceinline__ void xcd_barrier_complete(unsigned* bar, unsigned x, unsigned& nloc, unsigned& nx) {
    const unsigned G = gridDim.x * gridDim.y * gridDim.z;
    unsigned sum, cnt, mine, sp = 0u;
    for (;;) {
        sum = 0u; cnt = 0u; mine = 0u;
#pragma unroll
        for (unsigned j = 0; j < 16; ++j) { const unsigned c = xb_ld(&bar[XB_XCNT(j)]); sum += c; cnt += (c > 0u) ? 1u : 0u; mine = (j == x) ? c : mine; }
        if (sum == G) break;
        __builtin_amdgcn_s_sleep(1);
        if ((++sp & 255u) == 0u) { if (xb_ld(&bar[XB_TMO])) break; if (sp > XB_SPIN_CAP) { atomicAdd(&bar[XB_TMO], 1u); break; } }
    }
    nloc = mine > 0u ? mine : 1u; nx = cnt > 0u ? cnt : 1u;
}

__device__ __forceinline__ void xcd_barrier(const XcdBarrier& b) {
    asm volatile("s_waitcnt vmcnt(0)" ::: "memory");
    __syncthreads();
    if (threadIdx.x == 0) {
        unsigned* bar = b.bar;
        __builtin_amdgcn_s_waitcnt(0);
        unsigned nloc = b.st[0], nx = b.st[1];
        if (nloc == 0u) { xcd_barrier_complete(bar, b.x, nloc, nx); b.st[0] = nloc; b.st[1] = nx; }
        const unsigned old = xb_add(&bar[XB_XSUB(b.x)], 1u);
        const unsigned gen = old / nloc;
        if (old + 1u == (gen + 1u) * nloc) {
            __builtin_amdgcn_fence(__ATOMIC_RELEASE, "agent");
            asm volatile("s_waitcnt vmcnt(0)" ::: "memory");
            const unsigned og = xb_add(&bar[XB_TOP], 1u);
            const unsigned tg = og / nx;
            if (og + 1u == (tg + 1u) * nx) xb_add(&bar[XB_TOPGEN], 1u);
            else XB_SPIN(xb_ld(&bar[XB_TOPGEN]) == tg, bar);
            __builtin_amdgcn_fence(__ATOMIC_ACQUIRE, "agent");
            xb_add(&bar[XB_XGEN(b.x)], 1u);
            asm volatile("s_waitcnt vmcnt(0)" ::: "memory");
        } else {
            XB_SPIN(xb_ld(&bar[XB_XGEN(b.x)]) == gen, bar);
            __builtin_amdgcn_fence(__ATOMIC_ACQUIRE, "agent");
            asm volatile("s_waitcnt vmcnt(0)" ::: "memory");
        }
    }
    __syncthreads();
}

namespace mk {
using pg8::bf16_t; using pg8::bf16x8; using pg8::f32x4; using pg8::u32x4; using pg8::cvt_pk_bf16;
typedef float f32x16 __attribute__((ext_vector_type(16)));
typedef unsigned u32x2 __attribute__((ext_vector_type(2)));
typedef short s16x4 __attribute__((ext_vector_type(4)));
#define LAS __attribute__((address_space(3)))
#define MFMA32(a, b, c) __builtin_amdgcn_mfma_f32_32x32x16_bf16((a), (b), (c), 0, 0, 0)

constexpr int DM = 1024, NB = 8, SEQ = 2048, TT = 2064, NMETA = 16;
constexpr int MREAL = NB * SEQ, MROWS = MREAL + NMETA, MPAD = 16640;
constexpr int NZ = 2632, NZP = 2816;
constexpr int OFF_Q = 0, OFF_K = 512, OFF_V = 1024, OFF_POOL = 1536, OFF_IQ = 2048, OFF_IK = 2560, OFF_IW = 2624;
constexpr int NEXP = 16384;
constexpr float RMS_EPS = 1e-6f, LOG2E = 1.4426950408889634f;
constexpr int NTHR = 512, LDS_BYTES = 163840;
constexpr int MASKW = 68;
constexpr int SCW = 2112;

constexpr size_t WS_CTL = 0;
constexpr size_t WS_SUMSQ = 65536;
constexpr size_t WS_WIN = WS_SUMSQ + 65536;
constexpr size_t WS_WOUT = WS_WIN + (size_t)NZP * 1024 * 2;
constexpr size_t WS_WQ = WS_WOUT + (size_t)1024 * 1024 * 2;
constexpr size_t WS_SK = WS_WQ + (size_t)2048 * 1024 * 2;
constexpr size_t WS_KI = WS_SK + 65536;
constexpr size_t WS_WI = WS_KI + (size_t)NB * TT * 64 * 2;
constexpr size_t WS_MASK = WS_WI + (size_t)MREAL * 8 * 4;
constexpr size_t WS_XN = WS_MASK + (size_t)MREAL * MASKW * 4;
constexpr size_t WS_MIX = WS_XN + (size_t)MPAD * 1024 * 2;
constexpr size_t WS_Q = WS_MIX + (size_t)MREAL * 1024 * 2;
constexpr size_t WS_K = WS_Q + (size_t)MREAL * 512 * 2;
constexpr size_t WS_VV = WS_K + (size_t)NB * TT * 512 * 2;
constexpr size_t WS_QI = WS_VV + (size_t)NB * TT * 512 * 2;
constexpr size_t WS_UP = WS_QI + (size_t)MREAL * 512 * 2;
constexpr size_t WS_U8 = WS_UP + (size_t)MROWS * 512 * 2;
constexpr size_t WS_SCL = WS_U8 + (size_t)NEXP * 1024;
constexpr size_t WS_C = WS_SCL + 131072;
constexpr size_t WS_V8 = WS_C + (size_t)MREAL * 128 * 4;
constexpr size_t WS_H1B = WS_V8 + (size_t)NEXP * 1024;
constexpr size_t WS_EID = WS_H1B + (size_t)MREAL * 1024 * 2;
constexpr size_t WS_TW = WS_EID + (size_t)MREAL * 128 * 8;
constexpr size_t WS_END = WS_TW + (size_t)1024 * 512 * 2;
constexpr size_t WS_QP = WS_Q;
static_assert(WS_END <= 268435456ull, "workspace");
static_assert((WS_MASK % 16) == 0 && (WS_XN % 256) == 0 && (WS_UP % 256) == 0 && (WS_K % 256) == 0 && (WS_U8 % 256) == 0, "align");
static_assert(WS_QP + (size_t)MREAL * 2048 * 2 <= WS_UP, "QP fits over Q..QI");
static_assert(WS_MIX == WS_XN + (size_t)MPAD * 1024 * 2 && WS_XN + (size_t)8 * MREAL * 128 * 4 <= WS_Q, "PART (f32 [8][16384][128]) fits over XN | MIX (dead after the input / output projections)");

struct Args { const float* in[15]; float* out; unsigned char* ws; int ph_lo, ph_hi; };

struct Frame {
    const float *x, *meta, *g1, *w_in, *gq, *gk, *pool_w, *pool_scale, *w_out, *g2, *wq, *sk1, *sk2, *pu, *pv;
    float* out; unsigned char* ws; LAS unsigned char* lds;
    int tid, lane, wave, G, bid;
#define WSPTR(name, type, off) __device__ __forceinline__ type* name() const { return (type*)(ws + (off)); }
    WSPTR(SUMSQ, float, WS_SUMSQ) WSPTR(WIN, bf16_t, WS_WIN) WSPTR(WOUT, bf16_t, WS_WOUT) WSPTR(WQ, bf16_t, WS_WQ) WSPTR(SK, bf16_t, WS_SK)
    WSPTR(KI, bf16_t, WS_KI) WSPTR(WI, float, WS_WI) WSPTR(MASK, unsigned, WS_MASK) WSPTR(XN, bf16_t, WS_XN) WSPTR(H1B, bf16_t, WS_H1B) WSPTR(MIX, bf16_t, WS_MIX)
    WSPTR(Q, bf16_t, WS_Q) WSPTR(K, bf16_t, WS_K) WSPTR(VV, bf16_t, WS_VV) WSPTR(QI, bf16_t, WS_QI) WSPTR(UP, bf16_t, WS_UP) WSPTR(QP, bf16_t, WS_QP)
    WSPTR(U8, unsigned char, WS_U8) WSPTR(V8, unsigned char, WS_V8) WSPTR(SU, float, WS_SCL) WSPTR(SV, float, WS_SCL + NEXP * 4)
    WSPTR(TW, bf16_t, WS_TW) WSPTR(PART, bf16_t  , WS_XN) WSPTR(EID, bf16_t  , WS_EID) WSPTR(GATE, float, WS_EID + (size_t)MREAL * 128 * 4) WSPTR(CB, bf16_t  , WS_C)
#undef WSPTR
};


__device__ __forceinline__ int fresh(int v) { asm volatile("" : "+v"(v)); return v; }
__device__ __forceinline__ bf16_t f2bf(float f) { return (bf16_t)(cvt_pk_bf16(f, 0.f) & 0xffffu); }
__device__ __forceinline__ float bf2f(bf16_t b) { return __uint_as_float(((unsigned)b) << 16); }
__device__ __forceinline__ float bflo(unsigned w) { return __uint_as_float(w << 16); }
__device__ __forceinline__ float bfhi(unsigned w) { return __uint_as_float(w & 0xffff0000u); }
__device__ __forceinline__ float wave_sum(float v) {
#pragma unroll
    for (int o = 32; o > 0; o >>= 1) v += __shfl_xor(v, o);
    return v; }
__device__ __forceinline__ float half_sum32(float v) {
#pragma unroll
    for (int o = 16; o > 0; o >>= 1) v += __shfl_xor(v, o);
    return v; }

__host__ __device__ __forceinline__ int win_src_col(int np) {
    const int pn = np >> 8, cl = np & 255, bj = cl >> 7, wc = (cl >> 5) & 3, w = cl & 31;
    if (pn < 2) return OFF_Q + (4 * pn + wc) * 64 + 32 * bj + w;
    if (pn < 4) return OFF_K + (4 * (pn - 2) + wc) * 64 + 32 * bj + w;
    if (pn < 8) return np;
    if (pn < 10) return OFF_IQ + (4 * (pn - 8) + wc) * 64 + 32 * bj + w;
    if (wc == 0) return OFF_IK + 32 * bj + w;
    if (wc == 1 && bj == 0 && w < 8) return OFF_IW + w;
    return -1;
}
template <bool WINPERM>
__device__ __forceinline__ void transpose_tile(const Frame& F, LAS float* tile, const float* W, int ldw, int N, bf16_t* Wt, int ldt, const float* kscale, int k0, int n0) {
    const int lane = F.lane, kk = lane >> 4, n4 = (lane & 15) * 4;
    int src = n0 + n4; bool ok = src < N;
    if (WINPERM) { src = win_src_col(n0 + n4); ok = src >= 0; }
    f32x4 v[16];
#pragma unroll
    for (int p = 0; p < 16; ++p) { v[p] = (f32x4){0.f, 0.f, 0.f, 0.f}; if (ok) v[p] = *(const f32x4*)(W + (size_t)(k0 + 4 * p + kk) * ldw + src); }
#pragma unroll
    for (int p = 0; p < 16; ++p) { const float s = kscale ? kscale[k0 + 4 * p + kk] : 1.f;
#pragma unroll
        for (int i = 0; i < 4; ++i) tile[(4 * p + kk) * 65 + n4 + i] = v[p][i] * s; }
#pragma unroll
    for (int k8 = 0; k8 < 8; ++k8) { float x[8];
#pragma unroll
        for (int i = 0; i < 8; ++i) x[i] = tile[(8 * k8 + i) * 65 + lane];
        u32x4 w; w.x = cvt_pk_bf16(x[0], x[1]); w.y = cvt_pk_bf16(x[2], x[3]); w.z = cvt_pk_bf16(x[4], x[5]); w.w = cvt_pk_bf16(x[6], x[7]);
        *(u32x4*)(Wt + (size_t)(n0 + lane) * ldt + k0 + 8 * k8) = w; }
}

__device__ __forceinline__ void p0_prologue(const Frame& F) {
    const int gtid = F.bid * NTHR + F.tid, gsz = F.G * NTHR, lane = F.lane;
    const int gw = F.bid * 8 + F.wave, nw = F.G * 8;
    for (int u = gw; u < MPAD / 4; u += nw) {
        f32x4 v[4][4]; float ss[4];
#pragma unroll
        for (int r = 0; r < 4; ++r) { const int row = 4 * u + r;
            const float* src = row < MREAL ? F.x + (size_t)row * 1024 : F.meta + (size_t)(row < MROWS ? row - MREAL : 0) * 1024;
#pragma unroll
            for (int i = 0; i < 4; ++i) v[r][i] = *(const f32x4*)(src + 256 * i + 4 * lane); }
        f32x4 g[4];
#pragma unroll
        for (int i = 0; i < 4; ++i) g[i] = *(const f32x4*)(F.g1 + 256 * i + 4 * lane);
#pragma unroll
        for (int r = 0; r < 4; ++r) { float s = 0.f;
#pragma unroll
            for (int i = 0; i < 4; ++i) s += v[r][i][0] * v[r][i][0] + v[r][i][1] * v[r][i][1] + v[r][i][2] * v[r][i][2] + v[r][i][3] * v[r][i][3];
            ss[r] = s; }
#pragma unroll
        for (int o = 32; o > 0; o >>= 1) {
#pragma unroll
            for (int r = 0; r < 4; ++r) ss[r] += __shfl_xor(ss[r], o); }
#pragma unroll
        for (int r = 0; r < 4; ++r) { const int row = 4 * u + r; const float rs = row < MROWS ? rsqrtf(ss[r] * (1.f / 1024.f) + RMS_EPS) : 0.f;
            bf16_t* dst = F.XN() + (size_t)row * 1024;
#pragma unroll
            for (int i = 0; i < 4; ++i) { u32x2 w; w.x = cvt_pk_bf16(v[r][i][0] * rs * g[i][0], v[r][i][1] * rs * g[i][1]); w.y = cvt_pk_bf16(v[r][i][2] * rs * g[i][2], v[r][i][3] * rs * g[i][3]);
                *(u32x2*)(dst + 256 * i + 4 * lane) = w; } }
    }
    { LAS float* tile = (LAS float*)F.lds + F.wave * (64 * 65);
      for (int t = gw; t < 704 + 256 + 512; t += nw) {
          if (t < 704) transpose_tile<true>(F, tile, F.w_in, NZ, NZ, F.WIN(), 1024, nullptr, (t & 15) * 64, (t >> 4) * 64);
          else if (t < 960) { const int q = t - 704, kt = q & 15;
              if (kt < 8) transpose_tile<false>(F, tile, F.w_out, 1024, 1024, F.WOUT(), 1024, nullptr, kt * 64, (q >> 4) * 64);
              else transpose_tile<false>(F, tile, F.w_out + (size_t)512 * 1024, 1024, 1024, F.TW(), 512, nullptr, (kt - 8) * 64, (q >> 4) * 64); }
          else { const int q = t - 960; transpose_tile<false>(F, tile, F.wq, 2048, 2048, F.WQ(), 1024, F.g2, (q & 15) * 64, (q >> 4) * 64); } } }
    for (int idx = gtid; idx < 2 * 128 * 128; idx += gsz) F.SK()[idx] = f2bf(idx < 16384 ? F.sk1[idx] : F.sk2[idx - 16384]);
    for (int idx = gtid; idx < MREAL; idx += gsz) F.SUMSQ()[idx] = 0.f;
}

__device__ __forceinline__ float sum_rows4(float s) {
    auto a = __builtin_amdgcn_permlane16_swap(__float_as_uint(s), __float_as_uint(s), false, false); s = __uint_as_float(a[0]) + __uint_as_float(a[1]);
    auto c = __builtin_amdgcn_permlane32_swap(__float_as_uint(s), __float_as_uint(s), false, false); return __uint_as_float(c[0]) + __uint_as_float(c[1]); }
struct EpiIn {
    static constexpr bool PERM = true, AFTER_DRAIN = false;
    bf16_t *Q, *K, *VV, *QI, *KI, *UP; float* WI; const float *gq, *gk;
    __device__ __forceinline__ static u32x4 pk8(const f32x4 a, const f32x4 b) { u32x4 w; w.x = cvt_pk_bf16(a[0], a[1]); w.y = cvt_pk_bf16(a[2], a[3]); w.z = cvt_pk_bf16(b[0], b[1]); w.w = cvt_pk_bf16(b[2], b[3]); return w; }
    __device__ __forceinline__ void operator()(const f32x4 (&acc)[2][2][4][2], const pg8::Unit& u, int wr, int wc, int fr, int fq) const {
        const int pn = u.pn;
        const int kind = pn < 2 ? 0 : pn < 4 ? 1 : pn < 6 ? 2 : pn < 8 ? 3 : pn < 10 ? 4 : 5;
        const bool headk = (kind <= 1) || kind == 4 || (kind == 5 && wc == 0);
        const float* gp = (kind == 1 ? gk : gq) + 8 * fq;
        const int head = 4 * (pn & 1) + wc;
        float frq[2][4];
#pragma unroll
        for (int n = 0; n < 2; ++n)
#pragma unroll
            for (int i = 0; i < 4; ++i) frq[n][i] = __builtin_amdgcn_exp2f(-(float)(8 * fq + 4 * n + i) * 0.41524101186092029f) * 0.15915494309189535f;
#pragma unroll
        for (int ai = 0; ai < 2; ++ai)
#pragma unroll
            for (int m = 0; m < 4; ++m) {
                int row_ = u.pm * 256 + ai * 128 + wr * 64 + m * 16 + fr; asm volatile("" : "+v"(row_));
                const int row = row_;
                const bool real = row < MREAL, valid = row < MROWS;
                const int b = real ? row >> 11 : 0, pos = real ? (row & 2047) + NMETA : (valid ? row - MREAL : 0);
                f32x4 v[2][2];
#pragma unroll
                for (int bj = 0; bj < 2; ++bj)
#pragma unroll
                    for (int n = 0; n < 2; ++n) v[bj][n] = acc[ai][bj][m][n];
                if (kind <= 1) {
                    float ss = 0.f;
#pragma unroll
                    for (int bj = 0; bj < 2; ++bj)
#pragma unroll
                        for (int n = 0; n < 2; ++n) ss += v[bj][n][0] * v[bj][n][0] + v[bj][n][1] * v[bj][n][1] + v[bj][n][2] * v[bj][n][2] + v[bj][n][3] * v[bj][n][3];
                    ss = sum_rows4(ss);
                    const float rs = rsqrtf(ss * (1.f / 64.f) + RMS_EPS);
#pragma unroll
                    for (int bj = 0; bj < 2; ++bj)
#pragma unroll
                        for (int n = 0; n < 2; ++n) v[bj][n] = v[bj][n] * (kind == 0 ? rs * (0.125f * LOG2E) : rs) * *(const f32x4*)(gp + 32 * bj + 4 * n);
                }
                if (headk) {
                    const float fpos = (float)pos;
#pragma unroll
                    for (int n = 0; n < 2; ++n) { f32x4 cs, sn;
#pragma unroll
                        for (int i = 0; i < 4; ++i) { const float rev = __builtin_amdgcn_fractf(fpos * frq[n][i]); cs[i] = __builtin_amdgcn_cosf(rev); sn[i] = __builtin_amdgcn_sinf(rev); }
                        const f32x4 x1 = v[0][n], x2 = v[1][n];
                        v[0][n] = x1 * cs - x2 * sn; v[1][n] = x2 * cs + x1 * sn; }
                }
                if (kind == 0 || kind == 4) { if (real) { bf16_t* d = (kind ? QI : Q) + (size_t)row * 512 + head * 64 + 8 * fq;
#pragma unroll
                        for (int bj = 0; bj < 2; ++bj) *(u32x4*)(d + 32 * bj) = pk8(v[bj][0], v[bj][1]); } }
                else if (kind == 1 || kind == 2) { if (valid) { const int col = (kind == 1 ? head * 64 : (pn - 4) * 256 + 32 * wc) + 8 * fq; const int cstep = kind == 1 ? 32 : 128; bf16_t* base = kind == 1 ? K : VV;
                        const int nrep = real ? 1 : NB;
                        for (int rb = 0; rb < nrep; ++rb) { bf16_t* d = base + (size_t)((real ? b : rb) * TT + pos) * 512 + col;
#pragma unroll
                            for (int bj = 0; bj < 2; ++bj) *(u32x4*)(d + cstep * bj) = pk8(v[bj][0], v[bj][1]); } } }
                else if (kind == 3) { if (valid) { bf16_t* d = UP + (size_t)row * 512 + (pn - 6) * 256 + 32 * wc + 8 * fq;
#pragma unroll
                        for (int bj = 0; bj < 2; ++bj) *(u32x4*)(d + 128 * bj) = pk8(v[bj][0], v[bj][1]); } }
                else {
                    if (wc == 0) { if (valid) { const int nrep = real ? 1 : NB;
                            for (int rb = 0; rb < nrep; ++rb) { bf16_t* d = KI + (size_t)((real ? b : rb) * TT + pos) * 64 + 8 * fq;
#pragma unroll
                                for (int bj = 0; bj < 2; ++bj) *(u32x4*)(d + 32 * bj) = pk8(v[bj][0], v[bj][1]); } } }
                    else if (wc == 1 && fq == 0 && real) { *(f32x4*)(WI + (size_t)row * 8) = v[0][0] * 0.044194173824159216f; *(f32x4*)(WI + (size_t)row * 8 + 4) = v[0][1] * 0.044194173824159216f; }
                }
                asm volatile("" ::: "memory");
            }
    }
};
struct EpiOut {
    static constexpr bool PERM = false, AFTER_DRAIN = false;
    const float* X; float* out; bf16_t* H1B; float* sumsq;
    __device__ __forceinline__ void operator()(const f32x4 (&acc)[2][2][4][2], const pg8::Unit& u, int wr, int wc, int fr, int fq) const {
        const int row0 = u.pm * 256 + wr * 64 + fr, col0 = u.pn * 256 + wc * 32 + 4 * fq;
#pragma unroll
        for (int ai = 0; ai < 2; ++ai)
#pragma unroll
            for (int m = 0; m < 4; ++m) { const int row = row0 + ai * 128 + m * 16; const size_t off = (size_t)row * 1024 + col0; float ss = 0.f;
#pragma unroll
                for (int bj = 0; bj < 2; ++bj)
#pragma unroll
                    for (int n = 0; n < 2; ++n) { const f32x4 xv = *(const f32x4*)(X + off + bj * 128 + n * 16); const f32x4 h = xv + acc[ai][bj][m][n];
                        u32x2 w; w.x = cvt_pk_bf16(h[0], h[1]); w.y = cvt_pk_bf16(h[2], h[3]); *(u32x2*)(H1B + off + bj * 128 + n * 16) = w;
                        ss += h[0] * h[0] + h[1] * h[1] + h[2] * h[2] + h[3] * h[3]; }
                ss = sum_rows4(ss);
                if (fq == 0) atomicAdd(sumsq + row, ss); }
    }
};
struct EpiQP {
    static constexpr bool PERM = true, AFTER_DRAIN = false;
    bf16_t* O; const float* sumsq;
    __device__ __forceinline__ void operator()(const f32x4 (&acc)[2][2][4][2], const pg8::Unit& u, int wr, int wc, int fr, int fq) const {
        const int row0 = u.pm * 256 + wr * 64 + fr, col0 = u.pn * 256 + wc * 32 + 8 * fq;
#pragma unroll
        for (int ai = 0; ai < 2; ++ai)
#pragma unroll
            for (int m = 0; m < 4; ++m) { const int row = row0 + ai * 128 + m * 16; bf16_t* rowp = O + (size_t)row * 2048 + col0;
                const float rs = rsqrtf(sumsq[row] * (1.f / 1024.f) + RMS_EPS);
#pragma unroll
                for (int bj = 0; bj < 2; ++bj) { const f32x4 v0 = acc[ai][bj][m][0] * rs, v1 = acc[ai][bj][m][1] * rs;
                    u32x4 w; w.x = cvt_pk_bf16(v0[0], v0[1]); w.y = cvt_pk_bf16(v0[2], v0[3]); w.z = cvt_pk_bf16(v1[0], v1[1]); w.w = cvt_pk_bf16(v1[2], v1[3]);
                    *(u32x4*)(rowp + bj * 128) = w; } }
    }
};

__device__ __forceinline__ int zrow_of(int b, int pos) { return pos < NMETA ? MREAL + pos : b * SEQ + pos - NMETA; }

__device__ __forceinline__ bf16_t f2bf_c(float f) { unsigned u = __float_as_uint(f); u += 0x7FFFu + ((u >> 16) & 1u); return (bf16_t)(u >> 16); }
__device__ __forceinline__ void p2_weff(const Frame& F) {
    const int lane = fresh((int)threadIdx.x) & 63, hk = lane >> 5, l31 = lane & 31;
    for (int t = F.bid * 8 + F.wave; t < 512; t += F.G * 8) {
        const int n0 = (t & 31) * 32, gc0 = (t >> 5) * 32, g = gc0 >> 7;
        f32x16 acc = {};
        const bf16_t* ap = F.TW() + (size_t)(n0 + l31) * 512 + g * 128 + 8 * hk;
        const float* bp = F.pool_w + (size_t)(gc0 + l31) * 128 + 8 * hk; const float* sp = F.pool_scale + g * 128 + 8 * hk;
#pragma unroll
        for (int ks = 0; ks < 8; ++ks) {
            const bf16x8 a = *(const bf16x8*)(ap + 16 * ks);
            const f32x4 w0 = *(const f32x4*)(bp + 16 * ks) * *(const f32x4*)(sp + 16 * ks), w1 = *(const f32x4*)(bp + 16 * ks + 4) * *(const f32x4*)(sp + 16 * ks + 4);
            u32x4 bw; bw.x = cvt_pk_bf16(w0[0], w0[1]); bw.y = cvt_pk_bf16(w0[2], w0[3]); bw.z = cvt_pk_bf16(w1[0], w1[1]); bw.w = cvt_pk_bf16(w1[2], w1[3]);
            acc = MFMA32(a, __builtin_bit_cast(bf16x8, bw), acc); }
#pragma unroll
        for (int r = 0; r < 16; ++r) F.WOUT()[(size_t)(n0 + (r & 3) + 8 * (r >> 2) + 4 * hk) * 1024 + 512 + gc0 + l31] = f2bf_c(acc[r]);
    }
}
__device__ __forceinline__ void p2_pool(const Frame& F) {
    const int lane = fresh((int)threadIdx.x) & 63, g = lane >> 4, w = 2 << g;
    const float iw = 1.f / (float)w;
    for (int row0 = (F.bid * 8 + F.wave) * 2; row0 < MREAL; row0 += F.G * 8 * 2) {
        u32x4 x[2][16];
#pragma unroll
        for (int r = 0; r < 2; ++r) { const int row = row0 + r, b = row >> 11, pos = (row & 2047) + NMETA;
#pragma unroll
            for (int ii = 0; ii < 16; ++ii) { x[r][ii] = (u32x4){0u, 0u, 0u, 0u};
                if (ii < w) x[r][ii] = *(const u32x4*)(F.UP() + (size_t)zrow_of(b, pos - ii) * 512 + 8 * lane); } }
#pragma unroll
        for (int r = 0; r < 2; ++r) { float sum[8];
#pragma unroll
            for (int i = 0; i < 8; ++i) sum[i] = 0.f;
#pragma unroll
            for (int ii = 0; ii < 16; ++ii) { const u32x4 v = x[r][ii];
                sum[0] += bflo(v.x); sum[1] += bfhi(v.x); sum[2] += bflo(v.y); sum[3] += bfhi(v.y); sum[4] += bflo(v.z); sum[5] += bfhi(v.z); sum[6] += bflo(v.w); sum[7] += bfhi(v.w); }
            const u32x4 v0 = x[r][0];
            u32x4 o; o.x = cvt_pk_bf16(sum[0] * iw - bflo(v0.x), sum[1] * iw - bfhi(v0.x)); o.y = cvt_pk_bf16(sum[2] * iw - bflo(v0.y), sum[3] * iw - bfhi(v0.y));
            o.z = cvt_pk_bf16(sum[4] * iw - bflo(v0.z), sum[5] * iw - bfhi(v0.z)); o.w = cvt_pk_bf16(sum[6] * iw - bflo(v0.w), sum[7] * iw - bfhi(v0.w));
            *(u32x4*)(F.MIX() + (size_t)(row0 + r) * 1024 + 512 + 8 * lane) = o; }
    }
}

__device__ __forceinline__ void indexer_item(const Frame& F, const int b, const int qt32) {
    constexpr int NTB = 65;
    const int lane = fresh((int)threadIdx.x) & 63, tid = (int)threadIdx.x, wv = F.wave, hk = lane >> 5, l31 = lane & 31;
    const int c = qt32 >> 1, nvis = 80 + 64 * c, ntile = 3 + 2 * c, nsteps = (ntile + 3) >> 2;
    const int qrow0 = b * SEQ + qt32 * 32 + 4 * wv;
    constexpr int NST = (NTB + 3) / 4;
    const int blk = l31 >> 3, hf = (l31 >> 2) & 1, e = l31 & 3;
    const int ql = 2 * hf + (blk >> 1), head = 4 * (blk & 1) + e;
    bf16x8 af[4];
    { const bf16_t* qip = F.QI() + (size_t)(qrow0 + ql) * 512 + head * 64 + 8 * hk;
#pragma unroll
      for (int ks = 0; ks < 4; ++ks) af[ks] = *(const bf16x8*)(qip + 16 * ks); }
    float wreg[16];
#pragma unroll
    for (int r = 0; r < 16; ++r) wreg[r] = F.WI()[(size_t)(qrow0 + 2 * hk + (r >> 3)) * 8 + (r & 7)];
    const int st_key = tid >> 3, st_c8 = tid & 7;
    const unsigned st_off = st_key * 128 + ((st_c8 ^ (st_key & 7)) * 16);
    const bf16_t* kisrc = F.KI() + (size_t)(b * TT) * 64 + st_c8 * 8;
    u32x4 sa, sb;
    { int k0 = st_key, k1 = 64 + st_key; sa = *(const u32x4*)(kisrc + (size_t)k0 * 64); sb = *(const u32x4*)(kisrc + (size_t)k1 * 64); }
    *(LAS u32x4*)(F.lds + st_off) = sa; *(LAS u32x4*)(F.lds + 8192 + st_off) = sb;
    if (nsteps > 1) { int k0 = 128 + st_key, k1 = 192 + st_key; k0 = k0 < TT ? k0 : TT - 1; k1 = k1 < TT ? k1 : TT - 1; sa = *(const u32x4*)(kisrc + (size_t)k0 * 64); sb = *(const u32x4*)(kisrc + (size_t)k1 * 64); }
    __syncthreads();
    unsigned comp[2][NTB];
#pragma unroll
    for (int st = 0; st < NST; ++st) {
        if (st < nsteps) {
            const int buf = st & 1;
            u32x4 na = sa, nb = sb;
            if (st + 2 < nsteps) { int k0 = 128 * (st + 2) + st_key, k1 = k0 + 64; k0 = k0 < TT ? k0 : TT - 1; k1 = k1 < TT ? k1 : TT - 1; na = *(const u32x4*)(kisrc + (size_t)k0 * 64); nb = *(const u32x4*)(kisrc + (size_t)k1 * 64); }
#pragma unroll
            for (int tl = 0; tl < 4; ++tl) { constexpr int dummy = 0; (void)dummy; const int j = 4 * st + tl;
                if (j < NTB) {
                    unsigned c0 = 0u, c1 = 0u;
                    if (j < ntile) {
                        LAS const unsigned char* kb = F.lds + buf * 16384 + (32 * tl + l31) * 128;
                        f32x16 acc = {};
#pragma unroll
                        for (int ks = 0; ks < 4; ++ks) { const bf16x8 bfr = *(LAS const bf16x8*)(kb + (((2 * ks + hk) ^ (l31 & 7)) * 16)); acc = MFMA32(af[ks], bfr, acc); }
                        float s0 = 0.f, s1 = 0.f;
#pragma unroll
                        for (int r = 0; r < 8; ++r) { s0 += wreg[r] * fmaxf(acc[r], 0.f); s1 += wreg[r + 8] * fmaxf(acc[r + 8], 0.f); }
                        const int key = 32 * j + l31;
                        if (key < nvis) { unsigned u0 = __float_as_uint(s0), u1 = __float_as_uint(s1); if (u0 == 0x80000000u) u0 = 0u; if (u1 == 0x80000000u) u1 = 0u;
                            c0 = ((u0 ^ ((u0 >> 31) ? 0xFFFFFFFFu : 0x80000000u)) & ~0xFFFu) | (unsigned)(4095 - key);
                            c1 = ((u1 ^ ((u1 >> 31) ? 0xFFFFFFFFu : 0x80000000u)) & ~0xFFFu) | (unsigned)(4095 - key); }
                    }
                    comp[0][j] = c0; comp[1][j] = c1;
                    __builtin_amdgcn_sched_barrier(0);
                } }
            if (st + 1 < nsteps) { *(LAS u32x4*)(F.lds + (buf ^ 1) * 16384 + st_off) = sa; *(LAS u32x4*)(F.lds + (buf ^ 1) * 16384 + 8192 + st_off) = sb; }
            sa = na; sb = nb;
            __syncthreads();
        } else {
#pragma unroll
            for (int tl = 0; tl < 4; ++tl) { const int j = 4 * st + tl; if (j < NTB) { comp[0][j] = 0u; comp[1][j] = 0u; } }
        }
    }
    unsigned tA0 = 1u, tA1 = 1u, tB0 = 1u, tB1 = 1u;
    if (nvis > 256) { tA0 = tA1 = tB0 = tB1 = 0u; bool dA0 = false, dA1 = false, dB0 = false, dB1 = false;
#pragma unroll 1
        for (int bit = 31; bit >= 0; --bit) {
            const unsigned m = 1u << bit;
            const unsigned cand0 = (hk ? tB0 : tA0) | m, cand1 = (hk ? tB1 : tA1) | m;
            int p0 = 0, p1 = 0;
#define IDX_CNT(LO, HI) _Pragma("unroll") for (int j = (LO); j < (HI); ++j) { p0 += (comp[0][j] >= cand0) ? 1 : 0; p1 += (comp[1][j] >= cand1) ? 1 : 0; }
            IDX_CNT(0, 17)
            if (ntile > 17) { IDX_CNT(17, 33) if (ntile > 33) { IDX_CNT(33, 49) if (ntile > 49) { IDX_CNT(49, 65) } } }
#undef IDX_CNT
            p0 += __builtin_amdgcn_update_dpp(0, p0, 0xB1, 0xF, 0xF, false); p1 += __builtin_amdgcn_update_dpp(0, p1, 0xB1, 0xF, 0xF, false);
            p0 += __builtin_amdgcn_update_dpp(0, p0, 0x4E, 0xF, 0xF, false); p1 += __builtin_amdgcn_update_dpp(0, p1, 0x4E, 0xF, 0xF, false);
            p0 += __builtin_amdgcn_update_dpp(0, p0, 0x141, 0xF, 0xF, false); p1 += __builtin_amdgcn_update_dpp(0, p1, 0x141, 0xF, 0xF, false);
            p0 += __builtin_amdgcn_update_dpp(0, p0, 0x140, 0xF, 0xF, false); p1 += __builtin_amdgcn_update_dpp(0, p1, 0x140, 0xF, 0xF, false);
            const int cA0 = __builtin_amdgcn_readlane(p0, 0) + __builtin_amdgcn_readlane(p0, 16), cB0 = __builtin_amdgcn_readlane(p0, 32) + __builtin_amdgcn_readlane(p0, 48);
            const int cA1 = __builtin_amdgcn_readlane(p1, 0) + __builtin_amdgcn_readlane(p1, 16), cB1 = __builtin_amdgcn_readlane(p1, 32) + __builtin_amdgcn_readlane(p1, 48);
            if (!dA0 && cA0 >= 256) { tA0 |= m; dA0 = (cA0 == 256); }
            if (!dA1 && cA1 >= 256) { tA1 |= m; dA1 = (cA1 == 256); }
            if (!dB0 && cB0 >= 256) { tB0 |= m; dB0 = (cB0 == 256); }
            if (!dB1 && cB1 >= 256) { tB1 |= m; dB1 = (cB1 == 256); }
            if (dA0 && dA1 && dB0 && dB1) break; } }
    const unsigned t0 = hk ? tB0 : tA0, t1 = hk ? tB1 : tA1;
    int mq[4] = {0, 0, 0, 0};
    unsigned w64[4] = {0u, 0u, 0u, 0u};
#pragma unroll
    for (int j = 0; j < NTB; ++j) { const unsigned long long m0 = __ballot(comp[0][j] >= t0), m1 = __ballot(comp[1][j] >= t1);
        if (j < 64) {
            asm volatile("v_writelane_b32 %0, %2, %4\n\tv_writelane_b32 %1, %3, %4" : "+v"(mq[0]), "+v"(mq[2]) : "s"((int)(unsigned)m0), "s"((int)(unsigned)(m0 >> 32)), "i"(j < 64 ? j : 0));
            asm volatile("v_writelane_b32 %0, %2, %4\n\tv_writelane_b32 %1, %3, %4" : "+v"(mq[1]), "+v"(mq[3]) : "s"((int)(unsigned)m1), "s"((int)(unsigned)(m1 >> 32)), "i"(j < 64 ? j : 0));
        } else { w64[0] = (unsigned)m0; w64[2] = (unsigned)(m0 >> 32); w64[1] = (unsigned)m1; w64[3] = (unsigned)(m1 >> 32); } }
#pragma unroll
    for (int q = 0; q < 4; ++q) { unsigned* mrow = F.MASK() + (size_t)(qrow0 + q) * MASKW;
        if (lane <= ntile + 2 && lane < 64) mrow[lane] = lane < ntile ? (unsigned)mq[q] : 0u;
        if (lane < 4 && 64 + lane <= ntile + 2) mrow[64 + lane] = (64 + lane < ntile) ? w64[q] : 0u; }
    __syncthreads();
}

__device__ __forceinline__ void p3_indexer(const Frame& F) {
    for (int it = F.bid; it < 512; it += F.G) {
        const int half = it >> 8, ii = half ? 511 - (it & 255) : it;
        indexer_item(F, ii & 7, 63 - (ii >> 3));
    }
}

typedef short v4i16_t __attribute__((ext_vector_type(4)));
__device__ __forceinline__ s16x4 vtr(LAS const unsigned char* p) { return __builtin_bit_cast(s16x4, __builtin_amdgcn_ds_read_tr16_b64_v4i16((LAS v4i16_t*)p)); }

__device__ __forceinline__ void p4_attention(const Frame& F) {
    const int lane = fresh((int)threadIdx.x) & 63, wv = F.wave, tid = (int)threadIdx.x, hk = lane >> 5, l31 = lane & 31;
    float gb; { float a = fabsf(F.gq[lane]), bq = fabsf(F.gk[lane]);
#pragma unroll
        for (int o = 32; o > 0; o >>= 1) { a = fmaxf(a, __shfl_xor(a, o)); bq = fmaxf(bq, __shfl_xor(bq, o)); }
        gb = a * bq; }
    const float NMB = -8.f * gb * 1.02f * LOG2E;
    const int st_which = tid >> 8, st_r = (tid & 255) >> 3, st_c8 = tid & 7;
    const unsigned st_off = st_which ? (32768u + st_r * 128 + st_c8 * 16) : (st_r * 128 + ((st_c8 ^ (st_r & 7)) * 16));
    for (int it = F.bid; it < 512; it += F.G) {
        const int pr = it & 255, half = it >> 8, cp = pr & 3, bh = pr >> 2, b = bh >> 3, h = bh & 7, c4 = half ? 7 - cp : cp;
        const int qrow = b * SEQ + 256 * c4 + 32 * wv + l31;
        const int cch = 4 * c4 + (wv >> 1), nt = (80 + 64 * cch + 127) >> 7, ntmax = (80 + 64 * (4 * c4 + 3) + 127) >> 7;
        bf16x8 qf[4];
#pragma unroll
        for (int ks = 0; ks < 4; ++ks) qf[ks] = *(const bf16x8*)(F.Q() + (size_t)qrow * 512 + h * 64 + 16 * ks + 8 * hk);
        const bf16_t* stsrc = (st_which ? F.VV() : F.K()) + (size_t)(b * TT) * 512 + h * 64 + st_c8 * 8;
        f32x16 o0 = {}, o1 = {}; float lsum = 0.f;
        u32x4 sa[4];
#pragma unroll
        for (int q = 0; q < 4; ++q) sa[q] = *(const u32x4*)(stsrc + (size_t)(32 * q + st_r) * 512);
        u32x4 mw = *(const u32x4*)(F.MASK() + (size_t)qrow * MASKW);
#pragma unroll
        for (int q = 0; q < 4; ++q) *(LAS u32x4*)(F.lds + 4096 * q + st_off) = sa[q];
        if (ntmax > 1) {
#pragma unroll
            for (int q = 0; q < 4; ++q) { int k = 128 + 32 * q + st_r; k = k < TT ? k : TT - 1; sa[q] = *(const u32x4*)(stsrc + (size_t)k * 512); } }
        __syncthreads();
        for (int j = 0; j < ntmax; ++j) {
            const int buf = j & 1;
            u32x4 mw_next = {0u, 0u, 0u, 0u}; u32x4 na[4];
#pragma unroll
            for (int q = 0; q < 4; ++q) na[q] = sa[q];
            if (j + 2 < ntmax) {
#pragma unroll
                for (int q = 0; q < 4; ++q) { int k = 128 * (j + 2) + 32 * q + st_r; k = k < TT ? k : TT - 1; na[q] = *(const u32x4*)(stsrc + (size_t)k * 512); } }
            if (j + 1 < nt) mw_next = *(const u32x4*)(F.MASK() + (size_t)qrow * MASKW + 4 * (j + 1));
            if (j < nt) {
                LAS const unsigned char* kb = F.lds + buf * 16384; LAS const unsigned char* vb = F.lds + 32768 + buf * 16384;
#pragma unroll
                for (int hp = 0; hp < 2; ++hp) {
                    f32x16 s[2];
#pragma unroll
                    for (int hh = 0; hh < 2; ++hh)
#pragma unroll
                        for (int r = 0; r < 16; ++r) s[hh][r] = NMB;
#pragma unroll
                    for (int ks = 0; ks < 4; ++ks)
#pragma unroll
                        for (int hh = 0; hh < 2; ++hh) { const bf16x8 kf = *(LAS const bf16x8*)(kb + (64 * hp + 32 * hh + l31) * 128 + (((2 * ks + hk) ^ (l31 & 7)) * 16)); s[hh] = MFMA32(kf, qf[ks], s[hh]); }
                    bf16x8 pf[2][2];
#pragma unroll
                    for (int hh = 0; hh < 2; ++hh) {
                        const unsigned w2 = mw[2 * hp + hh] >> (4 * hk);
                        float p[16];
#pragma unroll
                        for (int r = 0; r < 16; ++r) { p[r] = __uint_as_float(__float_as_uint(__builtin_amdgcn_exp2f(s[hh][r])) & (unsigned)__builtin_amdgcn_sbfe((int)w2, (r & 3) + 8 * (r >> 2), 1)); lsum += p[r]; }
#pragma unroll
                        for (int s2 = 0; s2 < 2; ++s2) { u32x4 w; w.x = cvt_pk_bf16(p[8 * s2 + 0], p[8 * s2 + 1]); w.y = cvt_pk_bf16(p[8 * s2 + 2], p[8 * s2 + 3]);
                            w.z = cvt_pk_bf16(p[8 * s2 + 4], p[8 * s2 + 5]); w.w = cvt_pk_bf16(p[8 * s2 + 6], p[8 * s2 + 7]); pf[hh][s2] = __builtin_bit_cast(bf16x8, w); }
                    }
                    const int i16 = lane & 15, g1 = (lane >> 4) & 1;
#pragma unroll
                    for (int hh = 0; hh < 2; ++hh) {
                        LAS const unsigned char* vp = vb + (64 * hp + 32 * hh + 4 * hk + (i16 >> 2)) * 128 + (16 * g1 + 4 * (i16 & 3)) * 2;
#pragma unroll
                        for (int s2 = 0; s2 < 2; ++s2) {
                            { const s16x4 lo = vtr(vp + (16 * s2) * 128), hi = vtr(vp + (16 * s2 + 8) * 128);
                              const bf16x8 vf = {lo[0], lo[1], lo[2], lo[3], hi[0], hi[1], hi[2], hi[3]}; o0 = MFMA32(vf, pf[hh][s2], o0); }
                            { const s16x4 lo = vtr(vp + (16 * s2) * 128 + 64), hi = vtr(vp + (16 * s2 + 8) * 128 + 64);
                              const bf16x8 vf = {lo[0], lo[1], lo[2], lo[3], hi[0], hi[1], hi[2], hi[3]}; o1 = MFMA32(vf, pf[hh][s2], o1); }
                        }
                    }
                }
            }
            if (j + 1 < ntmax) {
#pragma unroll
                for (int q = 0; q < 4; ++q) *(LAS u32x4*)(F.lds + (buf ^ 1) * 16384 + 4096 * q + st_off) = sa[q]; }
            mw = mw_next;
#pragma unroll
            for (int q = 0; q < 4; ++q) sa[q] = na[q];
            __syncthreads();
        }
        lsum += __shfl_xor(lsum, 32);
        const float inv = 1.f / lsum;
        bf16_t* dst = F.MIX() + (size_t)qrow * 1024 + h * 64 + 4 * hk;
#pragma unroll
        for (int g = 0; g < 4; ++g) {
            u32x2 w; w.x = cvt_pk_bf16(o0[4 * g] * inv, o0[4 * g + 1] * inv); w.y = cvt_pk_bf16(o0[4 * g + 2] * inv, o0[4 * g + 3] * inv); *(u32x2*)(dst + 8 * g) = w;
            u32x2 w1; w1.x = cvt_pk_bf16(o1[4 * g] * inv, o1[4 * g + 1] * inv); w1.y = cvt_pk_bf16(o1[4 * g + 2] * inv, o1[4 * g + 3] * inv); *(u32x2*)(dst + 32 + 8 * g) = w1; }
    }
}

template <int N> __device__ __forceinline__ void bitonic_sort_desc(float (&a)[N]) {
#pragma unroll
    for (int k = 2; k <= N; k <<= 1)
#pragma unroll
        for (int j = k >> 1; j > 0; j >>= 1)
#pragma unroll
            for (int i = 0; i < N; ++i) { const int l = i ^ j; if (l > i) { const bool desc = ((i & k) == 0) || (k == N); const float x = a[i], y = a[l];
                const float mx = fmaxf(x, y), mn = fminf(x, y); a[i] = desc ? mx : mn; a[l] = desc ? mn : mx; } }
}
__device__ __forceinline__ void merge_top16(float (&a)[16], const float (&b)[16]) {
#pragma unroll
    for (int i = 0; i < 16; ++i) a[i] = fmaxf(a[i], b[15 - i]);
#pragma unroll
    for (int j = 8; j > 0; j >>= 1)
#pragma unroll
        for (int i = 0; i < 16; ++i) { const int l = i ^ j; if (l > i) { const float x = a[i], y = a[l]; a[i] = fmaxf(x, y); a[l] = fminf(x, y); } }
}
__device__ __forceinline__ void cex(float& x, int& px, float& y, int& py) { const bool sw = y > x; const float tx = sw ? y : x, ty = sw ? x : y; const int tp = sw ? py : px, tq = sw ? px : py; x = tx; y = ty; px = tp; py = tq; }

__host__ __device__ constexpr int cand_cnt(int i) { return 16 / (i + 1); }
__host__ __device__ constexpr int cand_off(int i) { int s = 0; for (int k = 0; k < i; ++k) s += cand_cnt(k); return s; }
static_assert(cand_off(16) == 50, "candidates");
template <int N> __device__ __forceinline__ void bitonic_sort_desc_kv(float (&a)[N], int (&p)[N]) {
#pragma unroll
    for (int k = 2; k <= N; k <<= 1)
#pragma unroll
        for (int j = k >> 1; j > 0; j >>= 1)
#pragma unroll
            for (int i = 0; i < N; ++i) { const int l = i ^ j; if (l > i) { const bool desc = ((i & k) == 0) || (k == N);
                if (desc) cex(a[i], p[i], a[l], p[l]); else cex(a[l], p[l], a[i], p[i]); } }
}
__device__ __forceinline__ void merge_top16_kv(float (&a)[16], int (&pa)[16], const float (&b)[16], const int (&pb)[16]) {
#pragma unroll
    for (int i = 0; i < 16; ++i) { const bool sw = b[15 - i] > a[i]; a[i] = sw ? b[15 - i] : a[i]; pa[i] = sw ? pb[15 - i] : pa[i]; }
#pragma unroll
    for (int j = 8; j > 0; j >>= 1)
#pragma unroll
        for (int i = 0; i < 16; ++i) { const int l = i ^ j; if (l > i) cex(a[i], pa[i], a[l], pa[l]); }
}
__device__ __forceinline__ void sub_top16(const Frame& F, LAS const unsigned char* skl, const bf16_t* qrow, float (&top)[16]) {
    const int lane = F.lane, hk = lane >> 5, l31 = lane & 31;
    bf16x8 bq[8];
#pragma unroll
    for (int ks = 0; ks < 8; ++ks) bq[ks] = *(const bf16x8*)(qrow + 16 * ks + 8 * hk);
#pragma unroll
    for (int mt = 0; mt < 4; ++mt) {
        f32x16 acc = {};
        const int key = 32 * mt + l31;
#pragma unroll
        for (int ks = 0; ks < 8; ++ks) { const bf16x8 a = *(LAS const bf16x8*)(skl + key * 256 + (((2 * ks + hk) ^ (key & 15)) * 16)); acc = MFMA32(a, bq[ks], acc); }
        float cur[16];
#pragma unroll
        for (int r = 0; r < 16; ++r) { const unsigned kidx = (unsigned)(32 * mt + (r & 3) + 8 * (r >> 2) + 4 * hk); cur[r] = __uint_as_float((__float_as_uint(acc[r]) & ~127u) | kidx); }
        bitonic_sort_desc<16>(cur);
        if (mt == 0) {
#pragma unroll
            for (int i = 0; i < 16; ++i) top[i] = cur[i]; }
        else merge_top16(top, cur);
        __builtin_amdgcn_sched_barrier(0);
    }
    float oth[16];
#pragma unroll
    for (int i = 0; i < 16; ++i) oth[i] = __shfl_xor(top[i], 32);
    merge_top16(top, oth);
}

__host__ __device__ constexpr int p1_units() { return (MPAD / 256) * (NZP / 256); }
__host__ __device__ __forceinline__ int p1_first_idle(int G) { const int maxu = (p1_units() + G - 1) / G; return p1_units() - (maxu - 1) * G; }
__host__ __device__ __forceinline__ int tables_rows_p1(int G) { const int r = (G - p1_first_idle(G)) * 8 * 24; return r < 2 * NEXP ? r : 2 * NEXP; }
__device__ __forceinline__ unsigned pack_i8(float a, float b, float c, float d) {
    const unsigned ua = __float_as_uint(a + 12582912.f), ub = __float_as_uint(b + 12582912.f), uc = __float_as_uint(c + 12582912.f), ud = __float_as_uint(d + 12582912.f);
    return __builtin_amdgcn_perm(ub, ua, 0x0c0c0400u) | __builtin_amdgcn_perm(ud, uc, 0x04000c0cu);
}
__device__ __forceinline__ void p7b_tables(const Frame& F, const int widx, const int nworkers, const int rbeg, const int rend) {
    const int lane = fresh((int)threadIdx.x) & 63;
    f32x4 g[4];
#pragma unroll
    for (int i = 0; i < 4; ++i) g[i] = *(const f32x4*)(F.g2 + 16 * lane + 4 * i);
#pragma unroll 1
    for (int r0 = rbeg + widx * 8; r0 < rend; r0 += nworkers * 8) {
        const bool isv = r0 >= NEXP; const int e0 = isv ? r0 - NEXP : r0;
        const float* src = (isv ? F.pv : F.pu) + (size_t)e0 * 1024 + 16 * lane;
        f32x4 v[8][4]; float mx[8];
#pragma unroll
        for (int r = 0; r < 8; ++r)
#pragma unroll
            for (int i = 0; i < 4; ++i) v[r][i] = *(const f32x4*)(src + (size_t)r * 1024 + 4 * i);
#pragma unroll
        for (int r = 0; r < 8; ++r) { float m = 0.f;
#pragma unroll
            for (int i = 0; i < 4; ++i) { if (!isv) v[r][i] = v[r][i] * g[i];
                m = fmaxf(m, fmaxf(fmaxf(fabsf(v[r][i][0]), fabsf(v[r][i][1])), fmaxf(fabsf(v[r][i][2]), fabsf(v[r][i][3])))); }
            mx[r] = m; }
#pragma unroll
        for (int o = 32; o > 0; o >>= 1) {
#pragma unroll
            for (int r = 0; r < 8; ++r) mx[r] = fmaxf(mx[r], __shfl_xor(mx[r], o)); }
        unsigned char* dst = (isv ? F.V8() : F.U8()) + (size_t)(lane >> 3) * (NEXP * 128) + 16 * (lane & 7);
#pragma unroll
        for (int r = 0; r < 8; ++r) { const float qmax = isv ? 440.f : 127.f; const float sc = mx[r] > 0.f ? mx[r] / qmax : 1.f, inv = 1.f / sc;
            u32x4 w;
            if (isv) {
#pragma unroll
                for (int i = 0; i < 4; ++i) { int p = __builtin_amdgcn_cvt_pk_fp8_f32(v[r][i][0] * inv, v[r][i][1] * inv, 0, false); p = __builtin_amdgcn_cvt_pk_fp8_f32(v[r][i][2] * inv, v[r][i][3] * inv, p, true); w[i] = (unsigned)p; }
            } else {
#pragma unroll
                for (int i = 0; i < 4; ++i) w[i] = pack_i8(v[r][i][0] * inv, v[r][i][1] * inv, v[r][i][2] * inv, v[r][i][3] * inv);
            }
            *(u32x4*)(dst + (size_t)(e0 + r) * 128) = w;
            if (lane == 0) (isv ? F.SV() : F.SU())[e0 + r] = sc; }
    }
}

__device__ __forceinline__ void p7_routing(const Frame& F) {
    const int lane = F.lane, hk = lane >> 5, l31 = lane & 31;
    for (int idx = F.tid; idx < 2 * 128 * 16; idx += NTHR) { const int tb = idx >> 11, key = (idx >> 4) & 127, c16 = idx & 15;
        const u32x4 v = *(const u32x4*)(F.SK() + (size_t)tb * 16384 + key * 128 + c16 * 8);
        *(LAS u32x4*)(F.lds + tb * 32768 + key * 256 + ((c16 ^ (key & 15)) * 16)) = v; }
    LAS unsigned* ctab = (LAS unsigned*)(F.lds + 131072);
    if (F.tid < 50) { int n = F.tid, i = 0; while (n >= cand_cnt(i)) { n -= cand_cnt(i); ++i; } ctab[F.tid] = (unsigned)((i << 4) | n); }
    LAS float* lt = (LAS float*)(F.lds + 65536) + F.wave * 2048;
    __syncthreads();
    constexpr int RW = 6;
    if (F.wave >= RW) { p7b_tables(F, F.bid * (8 - RW) + (F.wave - RW), F.G * (8 - RW), tables_rows_p1(F.G), 2 * NEXP); return; }
    pg8::StaticOrder S; S.init(MREAL, 2048, F.G, F.bid);
    for (int li = F.wave; ; li += RW) {
        pg8::Unit un; if (!S.next(li >> 3, un)) break;
        const int tt = un.pm * 8 + (li & 7), head = un.pn, tok = tt * 32 + l31;
        const bf16_t* qrow = F.QP() + (size_t)tok * 2048 + head * 256;
        float t1[16], t2[16];
        sub_top16(F, F.lds, qrow, t1);
        sub_top16(F, F.lds + 32768, qrow + 128, t2);
#pragma unroll
        for (int i = 0; i < 16; ++i) { lt[i * 64 + lane] = t1[i]; lt[(16 + i) * 64 + lane] = t2[i]; }
        float cv[4][16];
#pragma unroll
        for (int k = 50; k < 64; ++k) cv[k >> 4][k & 15] = -3.0e38f;
#pragma unroll
        for (int i = 0; i < 16; ++i)
#pragma unroll
            for (int j = 0; j < 16; ++j) if ((i + 1) * (j + 1) <= 16) {
                const int n = cand_off(i) + j;
                const float sum = __uint_as_float(__float_as_uint(t1[i]) & ~127u) + __uint_as_float(__float_as_uint(t2[j]) & ~127u);
                cv[n >> 4][n & 15] = __uint_as_float((__float_as_uint(sum) & ~63u) | (unsigned)n); }
#pragma unroll
        for (int g = 0; g < 4; ++g) bitonic_sort_desc<16>(cv[g]);
        merge_top16(cv[0], cv[1]); merge_top16(cv[2], cv[3]); merge_top16(cv[0], cv[2]);
        float sv[16]; int ev[16];
#pragma unroll
        for (int k = 0; k < 16; ++k) { const unsigned ij = ctab[__float_as_uint(cv[0][k]) & 63u];
            const unsigned a = __float_as_uint(lt[(ij >> 4) * 64 + lane]), bb = __float_as_uint(lt[(16 + (ij & 15)) * 64 + lane]);
            sv[k] = __uint_as_float(a & ~127u) + __uint_as_float(bb & ~127u); ev[k] = (int)(((a & 127u) << 7) | (bb & 127u)); }
        float mx = sv[0];
#pragma unroll
        for (int k = 1; k < 16; ++k) mx = fmaxf(mx, sv[k]);
        float ge[16], gs = 0.f;
#pragma unroll
        for (int k = 0; k < 16; ++k) { ge[k] = __expf(sv[k] - mx); gs += ge[k]; }
        const float ginv = 1.f / gs;
        if (hk == 0) {
            bf16_t* ed = F.EID() + (size_t)tok * 128 + head * 16; float* gd = F.GATE() + (size_t)tok * 128 + head * 16;
#pragma unroll
            for (int k = 0; k < 16; k += 8) *(u32x4*)(ed + k) = (u32x4){(unsigned)ev[k] | ((unsigned)ev[k + 1] << 16), (unsigned)ev[k + 2] | ((unsigned)ev[k + 3] << 16), (unsigned)ev[k + 4] | ((unsigned)ev[k + 5] << 16), (unsigned)ev[k + 6] | ((unsigned)ev[k + 7] << 16)};
#pragma unroll
            for (int k = 0; k < 16; k += 4) *(f32x4*)(gd + k) = (f32x4){ge[k] * ginv, ge[k + 1] * ginv, ge[k + 2] * ginv, ge[k + 3] * ginv};
        }
    }
}

typedef float f32x2 __attribute__((ext_vector_type(2)));
#define XQ_WORD(pass, s) (4096 + 64 * (8 * (pass) + (s)))
#define XQ_TOK 32
#define XQ_CHUNKS (MREAL / (8 * XQ_TOK))
__device__ __forceinline__ int next_item(const Frame& F, unsigned* ctl, int qpass, int cur) {
    volatile LAS int* slot = (volatile LAS int*)(F.lds + LDS_BYTES - 32);
    __syncthreads();
    if (F.tid == 0) { int res = -1;
        for (int d = 0; d < 8; ++d) { const int s = (cur + d) & 7; unsigned* c = ctl + XQ_WORD(qpass, s);
            if (__hip_atomic_load(c, __ATOMIC_RELAXED, __HIP_MEMORY_SCOPE_AGENT) >= (unsigned)XQ_CHUNKS) continue;
            const unsigned idx = __hip_atomic_fetch_add(c, 1u, __ATOMIC_RELAXED, __HIP_MEMORY_SCOPE_AGENT);
            if (idx < (unsigned)XQ_CHUNKS) { res = (s << 16) | (int)idx; break; } }
        *slot = res; }
    __syncthreads();
    return *slot;
}
__device__ __forceinline__ float swap32_sum(float a, float b) { auto r = __builtin_amdgcn_permlane32_swap(__float_as_uint(a), __float_as_uint(b), false, false); return __uint_as_float(r[0]) + __uint_as_float(r[1]); }
__device__ __forceinline__ float swap16_sum(float a, float b) { auto r = __builtin_amdgcn_permlane16_swap(__float_as_uint(a), __float_as_uint(b), false, false); return __uint_as_float(r[0]) + __uint_as_float(r[1]); }
__device__ __forceinline__ float ror8_sum(float mine, float theirs) { return mine + __uint_as_float((unsigned)__builtin_amdgcn_update_dpp(0, (int)__float_as_uint(theirs), 0x128, 0xF, 0xF, false)); }
template <int CTRL> __device__ __forceinline__ float dpp_sum(float mine, float theirs) { return mine + __uint_as_float((unsigned)__builtin_amdgcn_update_dpp(0, (int)__float_as_uint(theirs), CTRL, 0xF, 0xF, false)); }
#define P8_LOAD8(R, EV, BASE, OFF) _Pragma("unroll") for (int ii = 0; ii < 8; ++ii) { const int e_ = __shfl((EV), 8 * ii + xg); R[ii] = *(const u32x4*)((BASE) + ((unsigned)e_ * 128u + (OFF))); }
#define P8U_DOT8(R, P0) _Pragma("unroll") for (int ii = 0; ii < 8; ++ii) { int a_ = __builtin_amdgcn_sdot4((int)R[ii][0], (int)xq[0], 0, false); a_ = __builtin_amdgcn_sdot4((int)R[ii][1], (int)xq[1], a_, false); \
        a_ = __builtin_amdgcn_sdot4((int)R[ii][2], (int)xq[2], a_, false); p[(P0) + ii] = __builtin_amdgcn_sdot4((int)R[ii][3], (int)xq[3], a_, false); }
template <int CTRL> __device__ __forceinline__ int dpp_isum(int mine, int theirs) { return mine + __builtin_amdgcn_update_dpp(0, theirs, CTRL, 0xF, 0xF, false); }
template <int CTRL> __device__ __forceinline__ float dpp_fmax(float v) { return fmaxf(v, __uint_as_float((unsigned)__builtin_amdgcn_update_dpp(0, (int)__float_as_uint(v), CTRL, 0xF, 0xF, false))); }
template <int QPASS>
__device__ __forceinline__ void p8u_sliced(const Frame& F) {
    unsigned* ctl = (unsigned*)(F.ws + WS_CTL);
    int cur = (int)(xb_xcc_id() & 7u);
    for (;;) { const int itm = next_item(F, ctl, QPASS, cur); if (itm < 0) break;
        const int s = itm >> 16, chunk = itm & 0xffff; cur = s;
        const int lane = fresh((int)threadIdx.x) & 63, xg = lane >> 3, ch = lane & 7;
        const int t0 = chunk * (8 * XQ_TOK) + F.wave * XQ_TOK;
        const unsigned char* ubase = F.U8() + (size_t)s * (NEXP * 128);
        const unsigned uoff = 16u * ch;
        const bool b2 = lane & 4, b1 = lane & 2, b0 = lane & 1;
        const int kout = 64 * (b2 ? 1 : 0) + 32 * (b0 ? 1 : 0) + 16 * (b1 ? 1 : 0) + xg;
        bf16_t* part = F.PART() + (size_t)s * ((size_t)MREAL * 128);
        LAS unsigned char* xl = F.lds + F.wave * 4096; LAS float* xsl = (LAS float*)(F.lds + 32768) + F.wave * 32;
        { u32x4 hx[4][2];
#pragma unroll
          for (int r = 0; r < 4; ++r) { const bf16_t* hp = F.H1B() + (unsigned)((t0 + 8 * r + xg) * 1024 + 128 * s + 16 * ch); hx[r][0] = *(const u32x4*)hp; hx[r][1] = *(const u32x4*)(hp + 8); }
#pragma unroll
          for (int r = 0; r < 4; ++r) { float v[16];
#pragma unroll
              for (int q = 0; q < 4; ++q) { v[2 * q] = bflo(hx[r][0][q]); v[2 * q + 1] = bfhi(hx[r][0][q]); v[8 + 2 * q] = bflo(hx[r][1][q]); v[8 + 2 * q + 1] = bfhi(hx[r][1][q]); }
              float m = fabsf(v[0]);
#pragma unroll
              for (int q = 1; q < 16; ++q) m = fmaxf(m, fabsf(v[q]));
              m = dpp_fmax<0xB1>(m); m = dpp_fmax<0x4E>(m); m = dpp_fmax<0x141>(m);
              const float sc = m > 0.f ? m * (1.f / 127.f) : 1.f, inv = m > 0.f ? 127.f / m : 0.f;
              u32x4 w;
#pragma unroll
              for (int q = 0; q < 4; ++q) w[q] = pack_i8(v[4 * q] * inv, v[4 * q + 1] * inv, v[4 * q + 2] * inv, v[4 * q + 3] * inv);
              *(LAS u32x4*)(xl + (8 * r + xg) * 128 + 16 * ch) = w;
              if (ch == 0) xsl[8 * r + xg] = sc; } }
        int e_lo = (int)F.EID()[(unsigned)(t0 * 128 + lane)], e_hi = (int)F.EID()[(unsigned)(t0 * 128 + 64 + lane)];
        int n_lo = (int)F.EID()[(unsigned)((t0 + 1) * 128 + lane)], n_hi = (int)F.EID()[(unsigned)((t0 + 1) * 128 + 64 + lane)];
        u32x4 rA[8], rB[8];
        P8_LOAD8(rA, e_lo, ubase, uoff)
#pragma unroll 1
        for (int i = 0; i < XQ_TOK; ++i) {
            const int t = t0 + i, tnn = t0 + (i < XQ_TOK - 2 ? i + 2 : XQ_TOK - 1);
            const int nn_lo = (int)F.EID()[(unsigned)(tnn * 128 + lane)], nn_hi = (int)F.EID()[(unsigned)(tnn * 128 + 64 + lane)];
            const u32x4 xq = *(const LAS u32x4*)(xl + i * 128 + 16 * ch); const float xs = xsl[i];
            int p[16];
            P8_LOAD8(rB, e_hi, ubase, uoff)
            __builtin_amdgcn_sched_barrier(0);
            P8U_DOT8(rA, 0)
            __builtin_amdgcn_sched_barrier(0);
            P8_LOAD8(rA, n_lo, ubase, uoff)
            __builtin_amdgcn_sched_barrier(0);
            P8U_DOT8(rB, 8)
            int r8[8], r4[4], r2[2];
#pragma unroll
            for (int q = 0; q < 8; ++q) r8[q] = dpp_isum<0x141>(b2 ? p[q + 8] : p[q], b2 ? p[q] : p[q + 8]);
#pragma unroll
            for (int q = 0; q < 4; ++q) r4[q] = dpp_isum<0xB1>(b0 ? r8[q + 4] : r8[q], b0 ? r8[q] : r8[q + 4]);
#pragma unroll
            for (int q = 0; q < 2; ++q) r2[q] = dpp_isum<0x4E>(b1 ? r4[q + 2] : r4[q], b1 ? r4[q] : r4[q + 2]);
            part[(unsigned)(t * 128 + kout)] = f2bf((float)r2[0] * xs); part[(unsigned)(t * 128 + kout + 8)] = f2bf((float)r2[1] * xs);
            e_lo = n_lo; e_hi = n_hi; n_lo = nn_lo; n_hi = nn_hi;
            __builtin_amdgcn_sched_barrier(0);
        }
    }
}
__device__ __forceinline__ float* CSP(const Frame& F) { return (float*)(F.ws + WS_C + (size_t)MREAL * 128 * 2); }
template <int CTRL> __device__ __forceinline__ float dpp_fmax2(float v) { return fmaxf(v, __uint_as_float((unsigned)__builtin_amdgcn_update_dpp(0, (int)__float_as_uint(v), CTRL, 0xF, 0xF, false))); }
__device__ __forceinline__ void p8c_combine(const Frame& F) {
    for (int i8 = F.bid * NTHR + fresh((int)threadIdx.x); i8 < MREAL * 16; i8 += F.G * NTHR) {
        const int idx = i8 * 8, t = i8 >> 4;
        u32x4 pp[8];
#pragma unroll
        for (int s = 0; s < 8; ++s) pp[s] = *(const u32x4*)(F.PART() + (size_t)s * ((size_t)MREAL * 128) + idx);
        const u32x4 ew = *(const u32x4*)(F.EID() + idx);
        const f32x4 g0 = *(const f32x4*)(F.GATE() + idx), g1 = *(const f32x4*)(F.GATE() + idx + 4);
        const float rstd = rsqrtf(F.SUMSQ()[t] * (1.f / 1024.f) + RMS_EPS);
        float su[8], sv[8], c[8];
#pragma unroll
        for (int j = 0; j < 8; ++j) { const int e = (int)((ew[j >> 1] >> (16 * (j & 1))) & 0xffffu); su[j] = F.SU()[e]; sv[j] = F.SV()[e]; }
        float m = 0.f;
#pragma unroll
        for (int q = 0; q < 4; ++q) { float sl = 0.f, sh = 0.f;
#pragma unroll
            for (int s = 0; s < 8; ++s) { sl += bflo(pp[s][q]); sh += bfhi(pp[s][q]); }
            const float al = sl * su[2 * q] * rstd, ah = sh * su[2 * q + 1] * rstd;
            const float gl = q < 2 ? g0[2 * q] : g1[2 * q - 4], gh = q < 2 ? g0[2 * q + 1] : g1[2 * q - 3];
            c[2 * q] = 0.5f * al * (1.f + erff(al * 0.70710678118654752f)) * gl * sv[2 * q]; c[2 * q + 1] = 0.5f * ah * (1.f + erff(ah * 0.70710678118654752f)) * gh * sv[2 * q + 1];
            m = fmaxf(m, fmaxf(fabsf(c[2 * q]), fabsf(c[2 * q + 1]))); }
        m = dpp_fmax2<0xB1>(m); m = dpp_fmax2<0x4E>(m); m = dpp_fmax2<0x141>(m); m = dpp_fmax2<0x140>(m);
        const float sc = m > 0.f ? 256.f / m : 1.f;
        unsigned ow[4];
#pragma unroll
        for (int q = 0; q < 4; ++q) { const float x0 = c[2 * q] * sc, x1 = c[2 * q + 1] * sc;
            const int p1 = __builtin_amdgcn_cvt_pk_fp8_f32(x0, x1, 0, false);
            const float r0 = x0 - __builtin_amdgcn_cvt_f32_fp8(p1, 0), r1 = x1 - __builtin_amdgcn_cvt_f32_fp8(p1, 1);
            int w2 = __builtin_amdgcn_cvt_pk_fp8_f32(x0, r0, 0, false); w2 = __builtin_amdgcn_cvt_pk_fp8_f32(x1, r1, w2, true);
            ow[q] = (unsigned)w2; }
        *(u32x4*)(F.CB() + idx) = (u32x4){ow[0], ow[1], ow[2], ow[3]};
        if ((i8 & 15) == 0) CSP(F)[t] = m > 0.f ? m * (1.f / 256.f) : 1.f;
    }
}
#define P8V_FMA8(R, C) _Pragma("unroll") for (int ii = 0; ii < 8; ++ii) { const f32x2 c2 = {C[ii], C[ii]};                            \
        _Pragma("unroll") for (int q = 0; q < 4; ++q) { acc2[2 * q] += c2 * __builtin_amdgcn_cvt_pk_f32_fp8((int)R[ii][q], false); acc2[2 * q + 1] += c2 * __builtin_amdgcn_cvt_pk_f32_fp8((int)R[ii][q], true); } }
#define P8V_COEF8(C, CV) _Pragma("unroll") for (int ii = 0; ii < 8; ++ii) C[ii] = __shfl((CV), 8 * ii + xg);
template <int QPASS>
__device__ __forceinline__ void p8v_experts(const Frame& F) {
    unsigned* ctl = (unsigned*)(F.ws + WS_CTL);
    int cur = (int)(xb_xcc_id() & 7u);
    for (;;) { const int itm = next_item(F, ctl, QPASS, cur); if (itm < 0) break;
        const int s = itm >> 16, chunk = itm & 0xffff; cur = s;
        const int lane = fresh((int)threadIdx.x) & 63, xg = lane >> 3, ch = lane & 7;
        const int t0 = chunk * (8 * XQ_TOK) + F.wave * XQ_TOK;
        const unsigned char* vbase = F.V8() + (size_t)s * (NEXP * 128);
        const unsigned voff = 16u * ch;
        const bool b5 = lane & 32, b4 = lane & 16, b3 = lane & 8;
        const int col = 128 * s + 16 * ch + (b5 ? 8 : 0) + (b4 ? 4 : 0) + (b3 ? 2 : 0);
        int e_lo = (int)F.EID()[(unsigned)(t0 * 128 + lane)], e_hi = (int)F.EID()[(unsigned)(t0 * 128 + 64 + lane)];
        int n_lo = (int)F.EID()[(unsigned)((t0 + 1) * 128 + lane)], n_hi = (int)F.EID()[(unsigned)((t0 + 1) * 128 + 64 + lane)];
#define P8V_CDEC(T, H) ((__builtin_amdgcn_cvt_f32_fp8((int)F.CB()[(unsigned)((T) * 128 + 64 * (H) + lane)], 0) + __builtin_amdgcn_cvt_f32_fp8((int)F.CB()[(unsigned)((T) * 128 + 64 * (H) + lane)], 1)) * CSP(F)[(T)])
        float c_lo = P8V_CDEC(t0, 0), c_hi = P8V_CDEC(t0, 1);
        u32x4 rA[8], rB[8];
        P8_LOAD8(rA, e_lo, vbase, voff)
#pragma unroll 1
        for (int i = 0; i < XQ_TOK; ++i) {
            const int t = t0 + i, tn = t0 + (i < XQ_TOK - 1 ? i + 1 : XQ_TOK - 1), tnn = t0 + (i < XQ_TOK - 2 ? i + 2 : XQ_TOK - 1);
            const int nn_lo = (int)F.EID()[(unsigned)(tnn * 128 + lane)], nn_hi = (int)F.EID()[(unsigned)(tnn * 128 + 64 + lane)];
            const float nc_lo = P8V_CDEC(tn, 0), nc_hi = P8V_CDEC(tn, 1);
            const unsigned h1w = *(const unsigned*)(F.H1B() + (unsigned)(t * 1024 + col)); const f32x2 h1 = {bflo(h1w), bfhi(h1w)};
            f32x2 acc2[8]; float cc[8];
#pragma unroll
            for (int q = 0; q < 8; ++q) acc2[q] = (f32x2){0.f, 0.f};
            P8_LOAD8(rB, e_hi, vbase, voff)
            P8V_COEF8(cc, c_lo)
            __builtin_amdgcn_sched_barrier(0);
            P8V_FMA8(rA, cc)
            __builtin_amdgcn_sched_barrier(0);
            P8_LOAD8(rA, n_lo, vbase, voff)
            P8V_COEF8(cc, c_hi)
            __builtin_amdgcn_sched_barrier(0);
            P8V_FMA8(rB, cc)
            __builtin_amdgcn_sched_barrier(0);
            float acc[16];
#pragma unroll
            for (int q = 0; q < 8; ++q) { acc[2 * q] = acc2[q][0]; acc[2 * q + 1] = acc2[q][1]; }
            float r8[8], r4[4], r2[2];
#pragma unroll
            for (int q = 0; q < 8; ++q) r8[q] = swap32_sum(acc[q], acc[q + 8]);
#pragma unroll
            for (int q = 0; q < 4; ++q) r4[q] = swap16_sum(r8[q], r8[q + 4]);
#pragma unroll
            for (int q = 0; q < 2; ++q) r2[q] = ror8_sum(b3 ? r4[q + 2] : r4[q], b3 ? r4[q] : r4[q + 2]);
            *(f32x2*)(F.out + (unsigned)(t * 1024 + col)) = (f32x2){h1[0] + r2[0], h1[1] + r2[1]};
            e_lo = n_lo; e_hi = n_hi; n_lo = nn_lo; n_hi = nn_hi; c_lo = nc_lo; c_hi = nc_hi;
            __builtin_amdgcn_sched_barrier(0);
        }
    }
}

typedef int i32x2 __attribute__((ext_vector_type(2)));
#define P8M_TR(DST, ADDR, OFF) asm volatile("ds_read_b64_tr_b8 %0, %1 offset:" #OFF : "=v"(DST) : "v"(ADDR) : "memory")
#define P8M_STEP(VOFF, AOFF) { long fa, fb0, fb1, fb2, fb3, fb4, fb5, fb6, fb7;                                                                    \
        P8M_TR(fa, aa, AOFF); P8M_TR(fb0, ab[0], VOFF); P8M_TR(fb1, ab[1], VOFF); P8M_TR(fb2, ab[2], VOFF); P8M_TR(fb3, ab[3], VOFF);                \
        P8M_TR(fb4, ab[4], VOFF); P8M_TR(fb5, ab[5], VOFF); P8M_TR(fb6, ab[6], VOFF); P8M_TR(fb7, ab[7], VOFF);                                        \
        asm volatile("s_waitcnt lgkmcnt(0)" : "+v"(fa), "+v"(fb0), "+v"(fb1), "+v"(fb2), "+v"(fb3), "+v"(fb4), "+v"(fb5), "+v"(fb6), "+v"(fb7) :: "memory"); \
        acc[0] = __builtin_amdgcn_mfma_f32_16x16x32_fp8_fp8(fa, fb0, acc[0], 0, 0, 0); acc[1] = __builtin_amdgcn_mfma_f32_16x16x32_fp8_fp8(fa, fb1, acc[1], 0, 0, 0); \
        acc[2] = __builtin_amdgcn_mfma_f32_16x16x32_fp8_fp8(fa, fb2, acc[2], 0, 0, 0); acc[3] = __builtin_amdgcn_mfma_f32_16x16x32_fp8_fp8(fa, fb3, acc[3], 0, 0, 0); \
        acc[4] = __builtin_amdgcn_mfma_f32_16x16x32_fp8_fp8(fa, fb4, acc[4], 0, 0, 0); acc[5] = __builtin_amdgcn_mfma_f32_16x16x32_fp8_fp8(fa, fb5, acc[5], 0, 0, 0); \
        acc[6] = __builtin_amdgcn_mfma_f32_16x16x32_fp8_fp8(fa, fb6, acc[6], 0, 0, 0); acc[7] = __builtin_amdgcn_mfma_f32_16x16x32_fp8_fp8(fa, fb7, acc[7], 0, 0, 0); }
#define P8M_RD16(DST, ADDR, OFF) asm volatile("ds_read_u16 %0, %1 offset:" #OFF : "=v"(DST) : "v"(ADDR) : "memory")
#define P8M_IDS(G, ADDR) { P8M_RD16(G[0], ADDR, 0); P8M_RD16(G[1], ADDR, 16); P8M_RD16(G[2], ADDR, 32); P8M_RD16(G[3], ADDR, 48); P8M_RD16(G[4], ADDR, 64); P8M_RD16(G[5], ADDR, 80); P8M_RD16(G[6], ADDR, 96); P8M_RD16(G[7], ADDR, 112); }
#define P8M_HALF(P, H, B) { unsigned g_[8], cw_; const unsigned ia_ = wl32 + 18432u + 256u * (unsigned)(P) + 128u * (H) + 2u * (unsigned)xg, ca_ = wl32 + 18944u + 256u * (unsigned)(P) + 128u * (H) + 2u * (unsigned)lane; \
        P8M_IDS(g_, ia_) P8M_RD16(cw_, ca_, 0);                                                                                                 \
        asm volatile("s_waitcnt lgkmcnt(0)" : "+v"(g_[0]), "+v"(g_[1]), "+v"(g_[2]), "+v"(g_[3]), "+v"(g_[4]), "+v"(g_[5]), "+v"(g_[6]), "+v"(g_[7]), "+v"(cw_) :: "memory"); \
        const unsigned w_ = cw_ * 0x10001u; const u32x4 w4_ = {w_, w_, w_, w_};                                                                   \
        asm volatile("ds_write_b128 %0, %1" :: "v"(wl32 + 16384u + 1024u * (B) + 16u * (unsigned)lane), "v"(w4_) : "memory");                         \
        _Pragma("unroll") for (int ii = 0; ii < 8; ++ii) __builtin_amdgcn_global_load_lds((const unsigned*)(vbase + (g_[ii] * 128u + ((ii & 1) ? off_o : off_e))), (LAS unsigned*)(wl + (B) * 8192 + ii * 1024), 16, 0, 0); }
#define P8M_SMALL(T, P) { __builtin_amdgcn_global_load_lds((const unsigned*)(F.EID() + (unsigned)((T) * 128)) + lane, (LAS unsigned*)(wl + 18432 + 256 * (P)), 4, 0, 0);       \
        __builtin_amdgcn_global_load_lds((const unsigned*)(F.CB() + (unsigned)((T) * 128)) + lane, (LAS unsigned*)(wl + 18944 + 256 * (P)), 4, 0, 0);                                 \
        __builtin_amdgcn_global_load_lds((const unsigned*)(F.H1B() + (unsigned)((T) * 1024 + 128 * s)) + lane, (LAS unsigned*)(wl + 19456 + 256 * (P)), 4, 0, 0); }
#define P8M_WAIT(N) asm volatile("s_waitcnt vmcnt(" #N ")" ::: "memory")
template <int QPASS>
__device__ __forceinline__ void p8v_mfma(const Frame& F) {
    unsigned* ctl = (unsigned*)(F.ws + WS_CTL);
    int cur = (int)(xb_xcc_id() & 7u);
    LAS unsigned char* wl = F.lds + F.wave * 19968;
    for (;;) { const int itm = next_item(F, ctl, QPASS, cur); if (itm < 0) break;
        const int s = itm >> 16, chunk = itm & 0xffff; cur = s;
        const int lane = fresh((int)threadIdx.x) & 63, xg = lane >> 3, ch = lane & 7, i16 = lane & 15, kg = lane >> 4;
        const int t0 = __builtin_amdgcn_readfirstlane(chunk * (8 * XQ_TOK) + F.wave * XQ_TOK);
        const unsigned char* vbase = F.V8() + (size_t)s * (NEXP * 128);
        const unsigned off_e = 16u * (unsigned)(ch ^ (xg >> 1)), off_o = 16u * (unsigned)(ch ^ (4 | (xg >> 1)));
        const int r0 = 8 * kg + (i16 >> 1), sl = (4 * (kg & 1)) | (i16 >> 2);
        const unsigned wl32 = (unsigned)(size_t)wl;
        unsigned ab[8];
#pragma unroll
        for (int j = 0; j < 8; ++j) ab[j] = wl32 + (unsigned)(128 * r0 + 16 * (j ^ sl) + 8 * (i16 & 1));
        const unsigned aa = wl32 + (unsigned)(16 * r0 + 8 * (i16 & 1));
        const int col0 = 128 * s + lane;
        asm volatile("s_waitcnt vmcnt(0)" ::: "memory");
        P8M_SMALL(t0, 0)
        P8M_WAIT(0);
        P8M_HALF(0, 0u, 0u)
        float po0 = 0.f, po1 = 0.f;
#pragma unroll 1
        for (int i = 0; i < XQ_TOK; ++i) {
            const int t = t0 + i, tn = t0 + (i < XQ_TOK - 1 ? i + 1 : XQ_TOK - 1), tp = t0 + (i > 0 ? i - 1 : 0), par = i & 1;
            float cs; { const float* csp_ = CSP(F) + t; asm volatile("s_load_dword %0, %1, 0x0" : "=s"(cs) : "s"(csp_) : "memory"); }
            f32x4 acc[8];
#pragma unroll
            for (int j = 0; j < 8; ++j) acc[j] = (f32x4){0.f, 0.f, 0.f, 0.f};
            P8M_SMALL(tn, par ^ 1)
            P8M_HALF(par, 1u, 1u)
            P8M_WAIT(11);
            F.out[(unsigned)(tp * 1024 + col0)] = po0; F.out[(unsigned)(tp * 1024 + col0 + 64)] = po1;
            __builtin_amdgcn_sched_barrier(0);
            P8M_STEP(0, 16384) P8M_STEP(4096, 16896)
            __builtin_amdgcn_sched_barrier(0);
            P8M_WAIT(10);
            P8M_HALF(par ^ 1, 0u, 0u)
            P8M_WAIT(10);
            __builtin_amdgcn_sched_barrier(0);
            P8M_STEP(8192, 17408) P8M_STEP(12288, 17920)
            __builtin_amdgcn_sched_barrier(0);
            unsigned h1ar, h1br; const unsigned ha_ = wl32 + 19456u + 256u * (unsigned)par + 2u * (unsigned)lane;
            P8M_RD16(h1ar, ha_, 0); P8M_RD16(h1br, ha_, 128);
            asm volatile("s_waitcnt lgkmcnt(0)" : "+v"(h1ar), "+v"(h1br) :: "memory");
            float sj[8];
#pragma unroll
            for (int j = 0; j < 8; ++j) sj[j] = acc[j][0] + acc[j][1];
            const float v0 = kg == 0 ? sj[0] : kg == 1 ? sj[1] : kg == 2 ? sj[2] : sj[3], v1 = kg == 0 ? sj[4] : kg == 1 ? sj[5] : kg == 2 ? sj[6] : sj[7];
            po0 = __uint_as_float(h1ar << 16) + v0 * cs; po1 = __uint_as_float(h1br << 16) + v1 * cs;
            __builtin_amdgcn_sched_barrier(0);
        }
        F.out[(unsigned)((t0 + XQ_TOK - 1) * 1024 + col0)] = po0; F.out[(unsigned)((t0 + XQ_TOK - 1) * 1024 + col0 + 64)] = po1;
        asm volatile("s_waitcnt vmcnt(0)" ::: "memory");
    }
}
__device__ __forceinline__ bool p8v_calibrate(const Frame& F) {
    const int lane = fresh((int)threadIdx.x) & 63, i16 = lane & 15;
    LAS unsigned char* wl = F.lds + F.wave * 19968;
    if (lane < 32) *(LAS unsigned*)(wl + 4 * lane) = (unsigned)(4 * lane) * 0x01010101u + 0x03020100u;
    const i32x2 v = __builtin_amdgcn_ds_read_tr8_b64_v2i32((LAS i32x2*)(wl + 16 * (i16 >> 1) + 8 * (i16 & 1)));
    const unsigned n = (unsigned)i16;
    const unsigned e0 = n | ((16u + n) << 8) | ((32u + n) << 16) | ((48u + n) << 24), e1 = (64u + n) | ((80u + n) << 8) | ((96u + n) << 16) | ((112u + n) << 24);
    const bool okw = __ballot((unsigned)v[0] == e0 && (unsigned)v[1] == e1) == ~0ull;
    volatile LAS int* flag = (volatile LAS int*)(F.lds + LDS_BYTES - 48);
    __syncthreads();
    if (F.tid == 0) *flag = 1;
    __syncthreads();
    if (!okw && (fresh((int)threadIdx.x) & 63) == 0) *flag = 0;
    __syncthreads();
    return *flag != 0;
}

constexpr int NPHASE = 10;
__global__ void __launch_bounds__(NTHR, 2) mk_fwd(Args args) {
    extern __shared__ __attribute__((aligned(16))) unsigned char lds_raw[];
    Frame F;
    F.lds = (LAS unsigned char*)lds_raw;
    F.tid = threadIdx.x; F.lane = F.tid & 63; F.wave = __builtin_amdgcn_readfirstlane(F.tid >> 6); F.G = gridDim.x; F.bid = blockIdx.x;
    F.x = args.in[0]; F.meta = args.in[1]; F.g1 = args.in[2]; F.w_in = args.in[3]; F.gq = args.in[4]; F.gk = args.in[5]; F.pool_w = args.in[6]; F.pool_scale = args.in[7];
    F.w_out = args.in[8]; F.g2 = args.in[9]; F.wq = args.in[10]; F.sk1 = args.in[11]; F.sk2 = args.in[12]; F.pu = args.in[13]; F.pv = args.in[14];
    F.out = args.out; F.ws = args.ws; unsigned char* ws = args.ws;
    const int lo = args.ph_lo, hi = args.ph_hi;
#ifndef PHASE_MASK
#define PHASE_MASK 0x3ff
#endif
#define IN(k) (((PHASE_MASK >> (k)) & 1) && lo <= (k) && (k) < hi)
    volatile LAS unsigned* bst = (volatile LAS unsigned*)(F.lds + LDS_BYTES - 16);
    if (F.tid == 0) { bst[0] = 0u; bst[1] = 0u; }
    __syncthreads();
    XcdBarrier bar = xcd_barrier_post((unsigned*)(ws + WS_CTL), bst);
#define GSYNC(k) do { if (IN(k) && IN((k) + 1)) xcd_barrier(bar); } while (0)
    if (IN(0)) { p0_prologue(F); }
    GSYNC(0);
    if (IN(1)) { { pg8::Gemm g{F.XN(), F.WIN(), MPAD, NZP, 1024}; pg8::StaticOrder S; S.init(MPAD, NZP, F.G, F.bid); EpiIn E{F.Q(), F.K(), F.VV(), F.QI(), F.KI(), F.UP(), F.WI(), F.gq, F.gk}; pg8::gemm_phase<EpiIn, pg8::StaticOrder>(F.lds, g, S, E);
        if (F.bid >= p1_first_idle(F.G)) p7b_tables(F, (F.bid - p1_first_idle(F.G)) * 8 + F.wave, (F.G - p1_first_idle(F.G)) * 8, 0, tables_rows_p1(F.G)); } }
    GSYNC(1);
    if (IN(3)) { p2_weff(F); p2_pool(F); p3_indexer(F); }
    GSYNC(3);
    if (IN(4)) { p4_attention(F); }
    GSYNC(4);
    if (IN(5)) { { pg8::Gemm g{F.MIX(), F.WOUT(), MREAL, 1024, 1024}; pg8::StaticOrder S; S.init(MREAL, 1024, F.G, F.bid); EpiOut E{F.x, F.out, F.H1B(), F.SUMSQ()}; pg8::gemm_phase<EpiOut, pg8::StaticOrder>(F.lds, g, S, E); } }
    GSYNC(5);
    if (IN(6)) { { pg8::Gemm g{F.H1B(), F.WQ(), MREAL, 2048, 1024}; pg8::StaticOrder S; S.init(MREAL, 2048, F.G, F.bid); EpiQP E{F.QP(), F.SUMSQ()}; pg8::gemm_phase<EpiQP, pg8::StaticOrder>(F.lds, g, S, E); } }
    if (IN(7)) { p7_routing(F); }
    GSYNC(7);
    if (IN(8)) { p8u_sliced<0>(F); xcd_barrier(bar); p8c_combine(F); }
    GSYNC(8);
    if (IN(9)) { if (p8v_calibrate(F)) p8v_mfma<1>(F);
        else p8v_experts<1>(F); }

#undef IN
#undef GSYNC
}
}

extern "C" void kernel_launch(void* const* d_in, const int* in_sizes, int n_in, void* d_out, int out_size, void* d_ws, size_t ws_size, hipStream_t stream) {
    static int grid = 0;
    if (grid == 0) {
        if (n_in != 15 || out_size != mk::MREAL * 1024 || ws_size < mk::WS_END) { fprintf(stderr, "kernel_launch: unexpected problem (n_in %d out %d ws %zu)\n", n_in, out_size, ws_size); grid = -1; return; }
        int dev = 0, cus = 0;
        if (hipGetDevice(&dev) != hipSuccess || hipDeviceGetAttribute(&cus, hipDeviceAttributeMultiprocessorCount, dev) != hipSuccess) { grid = -1; return; }
        if (hipFuncSetAttribute((const void*)mk::mk_fwd, hipFuncAttributeMaxDynamicSharedMemorySize, mk::LDS_BYTES) != hipSuccess) { fprintf(stderr, "kernel_launch: hipFuncSetAttribute failed\n"); grid = -1; return; }
        int per_cu = 0;
        if (hipOccupancyMaxActiveBlocksPerMultiprocessor(&per_cu, (const void*)mk::mk_fwd, mk::NTHR, mk::LDS_BYTES) != hipSuccess || per_cu < 1) { fprintf(stderr, "kernel_launch: occupancy query says %d\n", per_cu); grid = -1; return; }
        grid = cus;
    }
    if (grid < 0) return;
    if (hipMemsetAsync((char*)d_ws + mk::WS_CTL, 0, 32768, stream) != hipSuccess) { fprintf(stderr, "kernel_launch: memset failed\n"); return; }
    mk::Args a{};
    for (int i = 0; i < 15; ++i) a.in[i] = (const float*)d_in[i];
    a.out = (float*)d_out; a.ws = (unsigned char*)d_ws; a.ph_lo = 0; a.ph_hi = mk::NPHASE;
    void* kargs[] = {&a};
    hipError_t e = hipLaunchCooperativeKernel((const void*)mk::mk_fwd, dim3(grid), dim3(mk::NTHR), kargs, mk::LDS_BYTES, stream);
    if (e != hipSuccess) fprintf(stderr, "kernel_launch: cooperative launch failed: %s (grid %d)\n", hipGetErrorString(e), grid);

}
```

```cpp
#include <hip/hip_runtime.h>
#include <cstdio>
#include <cstdint>
namespace pg8 {
#define PG8_LAS __attribute__((address_space(3)))
typedef unsigned short bf16_t;
typedef short bf16x8 __attribute__((ext_vector_type(8)));
typedef float f32x4 __attribute__((ext_vector_type(4)));
typedef unsigned u32x4 __attribute__((ext_vector_type(4)));
constexpr int BM = 256, BK = 64, HALF = 128, HTB = HALF * BK * 2  , STAGE_BYTES = 8 * HTB, NXCD = 8, WGM = 8;

__host__ __device__ __forceinline__ int lds_byte(int r, int c) { const int st = (r >> 4) * 2 + (c >> 5), rr = r & 15, cc = c & 31, ob = rr * 64 + cc * 2; return st * 1024 + (ob ^ (((ob >> 9) & 1) << 5)); }
__host__ __device__ __forceinline__ void stage_rc(int b, int& R, int& C) { const int st = b / 1024, sb = b % 1024, swz = sb ^ (((sb >> 9) & 1) << 5); R = (st >> 1) * 16 + swz / 64; C = (st & 1) * 32 + (swz % 64) / 2; }
__host__ __device__ __forceinline__ int perm32(int rho) { const int n = rho >> 4, i = rho & 15; return 8 * (i >> 2) + 4 * n + (i & 3); }

struct Unit { int pm, pn; };
struct Gemm { const bf16_t* A; const bf16_t* Bt; int M, N, K; };
struct StaticOrder {
    int nM, nN, nwg, G, c;
    __host__ __device__ void init(int M, int N, int G_, int c_) { nM = M / BM; nN = N / BM; nwg = nM * nN; G = G_; c = c_; }
    __host__ __device__ bool next(int i, Unit& u) const {
        const long L = (long)i * G + c; if (L >= nwg) return false;
        int wgid = (int)L; { const int q = nwg / NXCD, r = nwg % NXCD, xcd = wgid % NXCD, off = wgid / NXCD; wgid = (xcd < r ? xcd * (q + 1) : r * (q + 1) + (xcd - r) * q) + off; }
        const int nig = WGM * nN, gid = wgid / nig, fm = gid * WGM, gsz = (nM - fm) < WGM ? (nM - fm) : WGM;
        u.pm = fm + ((wgid % nig) % gsz); u.pn = (wgid % nig) / gsz; return true;
    }
    __device__ __forceinline__ void a_ready(const Unit&) const {}
    __device__ __forceinline__ void done(const Unit&) const {}
};
__device__ __forceinline__ unsigned cvt_pk_bf16(float lo, float hi) { unsigned r; asm volatile("v_cvt_pk_bf16_f32 %0, %1, %2" : "=v"(r) : "v"(lo), "v"(hi)); return r; }
template <class Epi, class Sched>
__device__ __forceinline__ void gemm_phase(PG8_LAS unsigned char* lds, const Gemm g, const Sched& S, const Epi& E) {
    int tid_ = threadIdx.x; asm volatile("" : "+v"(tid_));
    const int tid = tid_, wid = __builtin_amdgcn_readfirstlane(tid >> 6), lane = tid & 63, wr = wid >> 2, wc = wid & 3, fr = lane & 15, fq = lane >> 4;
    const int K = g.K, nt = K / BK;
    unsigned voffA[2], voffB[2];
#pragma unroll
    for (int i = 0; i < 2; ++i) { int R, C; stage_rc(tid * 16 + i * 8192, R, C); const int Rb = Epi::PERM ? ((R & ~31) + perm32(R & 31)) : R;
        voffA[i] = (unsigned)(R * K + C) * 2u; voffB[i] = (unsigned)(Rb * K + C) * 2u; }
    const size_t kstep = (size_t)(BK * 2);
    const size_t hstep = (size_t)HALF * K * 2;
    const size_t tstep = 2 * hstep;
    const unsigned ldsw = (unsigned)wid * 1024u;
    const int aoff = lds_byte(wr * 64 + fr, fq * 8), boff = lds_byte(wc * 32 + fr, fq * 8);
#define PG8_SA(b, h) (((b) * 2 + (h)) * HTB)
#define PG8_SB(b, h) ((4 + (b) * 2 + (h)) * HTB)
#define PG8_STAGE(bufoff, gbase, voff) do { _Pragma("unroll") for (int _i = 0; _i < 2; ++_i) \
        __builtin_amdgcn_global_load_lds((const unsigned*)((const char*)(gbase) + (voff)[_i]), (PG8_LAS unsigned*)(lds + (bufoff) + ldsw + _i * 8192), 16, 0, 0); } while (0)
#define PG8_LDA(dst, b, h) do { _Pragma("unroll") for (int m = 0; m < 4; ++m) _Pragma("unroll") for (int k = 0; k < 2; ++k) dst[m][k] = *(const PG8_LAS bf16x8*)(lds + PG8_SA(b, h) + aoff + m * 2048 + k * 1024); } while (0)
#define PG8_LDB(dst, b, h) do { _Pragma("unroll") for (int n = 0; n < 2; ++n) _Pragma("unroll") for (int k = 0; k < 2; ++k) dst[n][k] = *(const PG8_LAS bf16x8*)(lds + PG8_SB(b, h) + boff + n * 2048 + k * 1024); } while (0)
#define PG8_MMA(ai, bj, At, Bt) do { __builtin_amdgcn_s_setprio(1); _Pragma("unroll") for (int m = 0; m < 4; ++m) _Pragma("unroll") for (int n = 0; n < 2; ++n) _Pragma("unroll") for (int k = 0; k < 2; ++k) \
        acc[ai][bj][m][n] = __builtin_amdgcn_mfma_f32_16x16x32_bf16(Bt[n][k], At[m][k], acc[ai][bj][m][n], 0, 0, 0); __builtin_amdgcn_s_setprio(0); } while (0)
#define PG8_WAIT_V(n) asm volatile("s_waitcnt vmcnt(" #n ")" ::: "memory")
#define PG8_WAIT_L(n) asm volatile("s_waitcnt lgkmcnt(" #n ")" ::: "memory")
#define PG8_BAR __builtin_amdgcn_s_barrier()
#define PG8_SCHED __builtin_amdgcn_sched_barrier(0)
    Unit cur, nxt; int ui = 0;
    if (!S.next(0, cur)) return;
    f32x4 acc[2][2][4][2];
#pragma unroll
    for (int a = 0; a < 2; ++a)
#pragma unroll
        for (int b = 0; b < 2; ++b)
#pragma unroll
            for (int m = 0; m < 4; ++m)
#pragma unroll
                for (int n = 0; n < 2; ++n) acc[a][b][m][n] = (f32x4){0.f, 0.f, 0.f, 0.f};
    bf16x8 At[4][2], B0[2][2], B1[2][2];
    const char* cA = (const char*)g.A + (size_t)cur.pm * tstep; const char* cB = (const char*)g.Bt + (size_t)cur.pn * tstep;
    S.a_ready(cur);
    PG8_STAGE(PG8_SB(0, 0), cB, voffB); PG8_STAGE(PG8_SA(0, 0), cA, voffA); PG8_STAGE(PG8_SB(0, 1), cB + hstep, voffB); PG8_STAGE(PG8_SA(0, 1), cA + hstep, voffA);
    if (wr == 1) PG8_BAR;
    PG8_WAIT_V(4); PG8_BAR;
    PG8_STAGE(PG8_SB(1, 0), cB + kstep, voffB); PG8_STAGE(PG8_SA(1, 0), cA + kstep, voffA); PG8_STAGE(PG8_SB(1, 1), cB + hstep + kstep, voffB);
    PG8_WAIT_V(6); PG8_BAR;
    for (;;) {
        const bool has_next = S.next(ui + 1, nxt);
        const char* nA = has_next ? (const char*)g.A + (size_t)nxt.pm * tstep : cA; const char* nB = has_next ? (const char*)g.Bt + (size_t)nxt.pn * tstep : cB;
        for (int t = 0; t < nt; t += 2) {
            const bool last = (t == nt - 2);
            const char* a1 = cA + (size_t)(t + 1) * kstep;
            const char* a2 = last ? nA : cA + (size_t)(t + 2) * kstep; const char* b2 = last ? nB : cB + (size_t)(t + 2) * kstep;
            const char* a3 = a2 + kstep; const char* b3 = b2 + kstep;
            if (last && has_next) S.a_ready(nxt);
            PG8_LDB(B0, 0, 0); PG8_SCHED; PG8_LDA(At, 0, 0); PG8_STAGE(PG8_SA(1, 1), a1 + hstep, voffA);
            PG8_WAIT_L(8); PG8_BAR; PG8_WAIT_L(0); PG8_MMA(0, 0, At, B0); PG8_BAR; PG8_SCHED;
            PG8_LDB(B1, 0, 1); PG8_STAGE(PG8_SB(0, 0), b2, voffB);
            PG8_BAR; PG8_WAIT_L(0); PG8_MMA(0, 1, At, B1); PG8_BAR;
            PG8_LDA(At, 0, 1); PG8_STAGE(PG8_SA(0, 0), a2, voffA);
            PG8_BAR; PG8_WAIT_L(0); PG8_MMA(1, 0, At, B0); PG8_BAR; PG8_SCHED;
            PG8_STAGE(PG8_SB(0, 1), b2 + hstep, voffB);
            PG8_WAIT_V(6); PG8_BAR; PG8_MMA(1, 1, At, B1); PG8_BAR;
            PG8_LDB(B0, 1, 0); PG8_SCHED; PG8_LDA(At, 1, 0); PG8_STAGE(PG8_SA(0, 1), a2 + hstep, voffA);
            PG8_WAIT_L(8); PG8_BAR; PG8_WAIT_L(0); PG8_MMA(0, 0, At, B0); PG8_BAR; PG8_SCHED;
            PG8_LDB(B1, 1, 1); PG8_STAGE(PG8_SB(1, 0), b3, voffB);
            PG8_BAR; PG8_WAIT_L(0); PG8_MMA(0, 1, At, B1); PG8_BAR;
            PG8_LDA(At, 1, 1); PG8_STAGE(PG8_SA(1, 0), a3, voffA);
            PG8_BAR; PG8_WAIT_L(0); PG8_MMA(1, 0, At, B0); PG8_BAR; PG8_SCHED;
            PG8_STAGE(PG8_SB(1, 1), b3 + hstep, voffB);
            PG8_WAIT_V(6); PG8_BAR; PG8_MMA(1, 1, At, B1); PG8_BAR;
        }
        if constexpr (!Epi::AFTER_DRAIN) { E(acc, cur, wr, wc, fr, fq); S.done(cur); }
        if (!has_next) break;
#pragma unroll
        for (int a = 0; a < 2; ++a)
#pragma unroll
            for (int b = 0; b < 2; ++b)
#pragma unroll
                for (int m = 0; m < 4; ++m)
#pragma unroll
                    for (int n = 0; n < 2; ++n) acc[a][b][m][n] = (f32x4){0.f, 0.f, 0.f, 0.f};
        cur = nxt; cA = nA; cB = nB; ++ui;
    }
    PG8_WAIT_V(0);
    if (wr == 0) PG8_BAR;
    PG8_BAR;
    if constexpr (Epi::AFTER_DRAIN) { E.fused(acc, cur, wr, wc, fr, fq, lds, wid, lane); S.done(cur); }
#undef PG8_SA
#undef PG8_SB
#undef PG8_STAGE
#undef PG8_LDA
#undef PG8_LDB
#undef PG8_MMA
#undef PG8_WAIT_V
#undef PG8_WAIT_L
#undef PG8_BAR
#undef PG8_SCHED
}
}
#define XB_TMO      128
#define XB_XCNT(j)  (256  + 64 * (j))
#define XB_XSUB(j)  (1280 + 64 * (j))
#define XB_XGEN(j)  (2304 + 64 * (j))
#define XB_TOP      3328
#define XB_TOPGEN   3392
#define XCD_BAR_WORDS 3456
#define XB_SPIN_CAP (1u << 18)

__device__ __forceinline__ unsigned xb_ld(unsigned* p)              { return __hip_atomic_load(p, __ATOMIC_RELAXED, __HIP_MEMORY_SCOPE_AGENT); }
__device__ __forceinline__ unsigned xb_add(unsigned* p, unsigned v) { return __hip_atomic_fetch_add(p, v, __ATOMIC_RELAXED, __HIP_MEMORY_SCOPE_AGENT); }
__device__ __forceinline__ unsigned xb_xcc_id() { return (unsigned)__builtin_amdgcn_s_getreg((3 << 11) | 20) & 0xFu; }
#define XB_SPIN(cond, bar) do { unsigned _sp = 0; while (cond) { __builtin_amdgcn_s_sleep(1); \
    if ((++_sp & 255u) == 0u) { if (xb_ld(&(bar)[XB_TMO])) break; if (_sp > XB_SPIN_CAP) { atomicAdd(&(bar)[XB_TMO], 1u); break; } } } } while (0)

struct XcdBarrier {
    unsigned* bar; unsigned x;
    volatile __attribute__((address_space(3))) unsigned* st;
};

__device__ __forceinline__ XcdBarrier xcd_barrier_post(unsigned* bar, volatile __attribute__((address_space(3))) unsigned* st) {
    XcdBarrier b; b.bar = bar; b.x = xb_xcc_id(); b.st = st;
    if (threadIdx.x == 0) (void)xb_add(&bar[XB_XCNT(b.x)], 1u);
    return b;
}
__device__ __forceinline__ void xcd_barrier_complete(unsigned* bar, unsigned x, unsigned& nloc, unsigned& nx) {
    const unsigned G = gridDim.x * gridDim.y * gridDim.z;
    unsigned sum, cnt, mine, sp = 0u;
    for (;;) {
        sum = 0u; cnt = 0u; mine = 0u;
#pragma unroll
        for (unsigned j = 0; j < 16; ++j) { const unsigned c = xb_ld(&bar[XB_XCNT(j)]); sum += c; cnt += (c > 0u) ? 1u : 0u; mine = (j == x) ? c : mine; }
        if (sum == G) break;
        __builtin_amdgcn_s_sleep(1);
        if ((++sp & 255u) == 0u) { if (xb_ld(&bar[XB_TMO])) break; if (sp > XB_SPIN_CAP) { atomicAdd(&bar[XB_TMO], 1u); break; } }
    }
    nloc = mine > 0u ? mine : 1u; nx = cnt > 0u ? cnt : 1u;
}

template <int NPF = 0>
__device__ __forceinline__ void xcd_barrier(const XcdBarrier& b) {
    asm volatile("s_waitcnt vmcnt(%0)" :: "n"(NPF) : "memory");
    if constexpr (NPF > 0) { asm volatile("s_waitcnt lgkmcnt(0)" ::: "memory"); __builtin_amdgcn_s_barrier(); }
    else __syncthreads();
    if (threadIdx.x == 0) {
        unsigned* bar = b.bar;
        if constexpr (NPF == 0) __builtin_amdgcn_s_waitcnt(0);
        unsigned nloc = b.st[0], nx = b.st[1];
        if (nloc == 0u) { xcd_barrier_complete(bar, b.x, nloc, nx); b.st[0] = nloc; b.st[1] = nx; }
        const unsigned old = xb_add(&bar[XB_XSUB(b.x)], 1u);
        const unsigned gen = old / nloc;
        if (old + 1u == (gen + 1u) * nloc) {
            __builtin_amdgcn_fence(__ATOMIC_RELEASE, "agent");
            asm volatile("s_waitcnt vmcnt(0)" ::: "memory");
            const unsigned og = xb_add(&bar[XB_TOP], 1u);
            const unsigned tg = og / nx;
            if (og + 1u == (tg + 1u) * nx) xb_add(&bar[XB_TOPGEN], 1u);
            else XB_SPIN(xb_ld(&bar[XB_TOPGEN]) == tg, bar);
            __builtin_amdgcn_fence(__ATOMIC_ACQUIRE, "agent");
            xb_add(&bar[XB_XGEN(b.x)], 1u);
            asm volatile("s_waitcnt vmcnt(0)" ::: "memory");
        } else {
            asm volatile("buffer_inv sc1" ::: "memory");
            XB_SPIN(xb_ld(&bar[XB_XGEN(b.x)]) == gen, bar);
            asm volatile("s_waitcnt vmcnt(0)" ::: "memory");
        }
    }
    __syncthreads();
}

namespace mk {
using pg8::bf16_t; using pg8::bf16x8; using pg8::f32x4; using pg8::u32x4; using pg8::cvt_pk_bf16;
typedef float f32x16 __attribute__((ext_vector_type(16)));
typedef unsigned u32x2 __attribute__((ext_vector_type(2)));
typedef short s16x4 __attribute__((ext_vector_type(4)));
#define LAS __attribute__((address_space(3)))
#define MFMA32(a, b, c) __builtin_amdgcn_mfma_f32_32x32x16_bf16((a), (b), (c), 0, 0, 0)

constexpr int DM = 1024, NB = 8, SEQ = 2048, TT = 2064, NMETA = 16;
constexpr int MREAL = NB * SEQ, MROWS = MREAL + NMETA, MPAD = 16640;
constexpr int NZ = 2632, NZP = 2816;
constexpr int OFF_Q = 0, OFF_K = 512, OFF_V = 1024, OFF_POOL = 1536, OFF_IQ = 2048, OFF_IK = 2560, OFF_IW = 2624;
constexpr int NEXP = 16384;
constexpr float RMS_EPS = 1e-6f, LOG2E = 1.4426950408889634f;
constexpr int NTHR = 512, LDS_BYTES = 163840;
constexpr int MASKW = 68;
constexpr int SCW = 2112;

constexpr size_t WS_CTL = 0;
constexpr size_t WS_SUMSQ = 65536;
constexpr size_t WS_WIN = WS_SUMSQ + 65536;
constexpr size_t WS_WOUT = WS_WIN + (size_t)NZP * 1024 * 2;
constexpr size_t WS_WQ = WS_WOUT + (size_t)1024 * 1024 * 2;
constexpr size_t WS_SK = WS_WQ + (size_t)2048 * 1024 * 2;
constexpr size_t WS_KI = WS_SK + 65536;
constexpr size_t WS_WI = WS_KI + (size_t)NB * TT * 64 * 2;
constexpr size_t WS_MASK = WS_WI + (size_t)MREAL * 8 * 4;
constexpr size_t WS_XN = WS_MASK + (size_t)MREAL * MASKW * 4;
constexpr size_t WS_MIX = WS_XN + (size_t)MPAD * 1024 * 2;
constexpr size_t WS_Q = WS_MIX + (size_t)MREAL * 1024 * 2;
constexpr size_t WS_K = WS_Q + (size_t)MREAL * 512 * 2;
constexpr size_t WS_VV = WS_K + (size_t)NB * TT * 512 * 2;
constexpr size_t WS_QI = WS_VV + (size_t)NB * TT * 512 * 2;
constexpr size_t WS_UP = WS_QI + (size_t)MREAL * 512 * 2;
constexpr size_t WS_U8 = WS_UP + (size_t)MROWS * 512 * 2;
constexpr size_t WS_SCL = WS_U8 + (size_t)NEXP * 1024;
constexpr size_t WS_C = WS_SCL + 131072;
constexpr size_t WS_V8 = WS_C + (size_t)MREAL * 128 * 4;
constexpr size_t WS_H1B = WS_V8 + (size_t)NEXP * 1024;
constexpr size_t WS_EID = WS_H1B + (size_t)MREAL * 1024 * 2;
constexpr size_t WS_TW = WS_EID + (size_t)MREAL * 128 * 8;
constexpr size_t WS_END = WS_TW + (size_t)1024 * 512 * 2;
constexpr size_t WS_QP = WS_Q;
static_assert(WS_END <= 268435456ull, "workspace");
static_assert((WS_MASK % 16) == 0 && (WS_XN % 256) == 0 && (WS_UP % 256) == 0 && (WS_K % 256) == 0 && (WS_U8 % 256) == 0, "align");
static_assert(WS_QP + (size_t)MREAL * 2048 * 2 <= WS_UP, "QP fits over Q..QI");
static_assert(WS_MIX == WS_XN + (size_t)MPAD * 1024 * 2 && WS_XN + (size_t)8 * MREAL * 128 * 4 <= WS_Q, "PART (f32 [8][16384][128]) fits over XN | MIX (dead after the input / output projections)");

struct Args { const float* in[15]; float* out; unsigned char* ws; int ph_lo, ph_hi; };

struct Frame {
    const float *x, *meta, *g1, *w_in, *gq, *gk, *pool_w, *pool_scale, *w_out, *g2, *wq, *sk1, *sk2, *pu, *pv;
    float* out; unsigned char* ws; LAS unsigned char* lds;
    int tid, lane, wave, G, bid;
#define WSPTR(name, type, off) __device__ __forceinline__ type* name() const { return (type*)(ws + (off)); }
    WSPTR(SUMSQ, float, WS_SUMSQ) WSPTR(WIN, bf16_t, WS_WIN) WSPTR(WOUT, bf16_t, WS_WOUT) WSPTR(WQ, bf16_t, WS_WQ) WSPTR(SK, bf16_t, WS_SK)
    WSPTR(KI, bf16_t, WS_KI) WSPTR(WI, float, WS_WI) WSPTR(MASK, unsigned, WS_MASK) WSPTR(XN, bf16_t, WS_XN) WSPTR(H1B, bf16_t, WS_H1B) WSPTR(MIX, bf16_t, WS_MIX)
    WSPTR(Q, bf16_t, WS_Q) WSPTR(K, bf16_t, WS_K) WSPTR(VV, bf16_t, WS_VV) WSPTR(QI, bf16_t, WS_QI) WSPTR(UP, bf16_t, WS_UP) WSPTR(QP, bf16_t, WS_QP)
    WSPTR(U8, unsigned char, WS_U8) WSPTR(V8, unsigned char, WS_V8) WSPTR(SU, float, WS_SCL) WSPTR(SV, float, WS_SCL + NEXP * 4)
    WSPTR(TW, bf16_t, WS_TW) WSPTR(PART, bf16_t  , WS_XN) WSPTR(EID, bf16_t  , WS_EID) WSPTR(GATE, float, WS_EID + (size_t)MREAL * 128 * 4) WSPTR(CB, bf16_t  , WS_C)
#undef WSPTR
};


__device__ __forceinline__ int fresh(int v) { asm volatile("" : "+v"(v)); return v; }
__device__ __forceinline__ bf16_t f2bf(float f) { return (bf16_t)(cvt_pk_bf16(f, 0.f) & 0xffffu); }
__device__ __forceinline__ float bf2f(bf16_t b) { return __uint_as_float(((unsigned)b) << 16); }
__device__ __forceinline__ float bflo(unsigned w) { return __uint_as_float(w << 16); }
__device__ __forceinline__ float bfhi(unsigned w) { return __uint_as_float(w & 0xffff0000u); }
__device__ __forceinline__ float wave_sum(float v) {
#pragma unroll
    for (int o = 32; o > 0; o >>= 1) v += __shfl_xor(v, o);
    return v; }
__device__ __forceinline__ float half_sum32(float v) {
#pragma unroll
    for (int o = 16; o > 0; o >>= 1) v += __shfl_xor(v, o);
    return v; }

__host__ __device__ __forceinline__ int win_src_col(int np) {
    const int pn = np >> 8, cl = np & 255, bj = cl >> 7, wc = (cl >> 5) & 3, w = cl & 31;
    if (pn < 2) return OFF_Q + (4 * pn + wc) * 64 + 32 * bj + w;
    if (pn < 4) return OFF_K + (4 * (pn - 2) + wc) * 64 + 32 * bj + w;
    if (pn < 8) return np;
    if (pn < 10) return OFF_IQ + (4 * (pn - 8) + wc) * 64 + 32 * bj + w;
    if (wc == 0) return OFF_IK + 32 * bj + w;
    if (wc == 1 && bj == 0 && w < 8) return OFF_IW + w;
    return -1;
}
template <bool WINPERM>
__device__ __forceinline__ void transpose_tile(const Frame& F, LAS float* tile, const float* W, int ldw, int N, bf16_t* Wt, int ldt, const float* kscale, int k0, int n0) {
    const int lane = F.lane, kk = lane >> 4, n4 = (lane & 15) * 4;
    int src = n0 + n4; bool ok = src < N;
    if (WINPERM) { src = win_src_col(n0 + n4); ok = src >= 0; }
    f32x4 v[16];
#pragma unroll
    for (int p = 0; p < 16; ++p) { v[p] = (f32x4){0.f, 0.f, 0.f, 0.f}; if (ok) v[p] = *(const f32x4*)(W + (size_t)(k0 + 4 * p + kk) * ldw + src); }
#pragma unroll
    for (int p = 0; p < 16; ++p) { const float s = kscale ? kscale[k0 + 4 * p + kk] : 1.f;
#pragma unroll
        for (int i = 0; i < 4; ++i) tile[(4 * p + kk) * 65 + n4 + i] = v[p][i] * s; }
#pragma unroll
    for (int k8 = 0; k8 < 8; ++k8) { float x[8];
#pragma unroll
        for (int i = 0; i < 8; ++i) x[i] = tile[(8 * k8 + i) * 65 + lane];
        u32x4 w; w.x = cvt_pk_bf16(x[0], x[1]); w.y = cvt_pk_bf16(x[2], x[3]); w.z = cvt_pk_bf16(x[4], x[5]); w.w = cvt_pk_bf16(x[6], x[7]);
        *(u32x4*)(Wt + (size_t)(n0 + lane) * ldt + k0 + 8 * k8) = w; }
}

__device__ __forceinline__ void p0_prologue(const Frame& F) {
    const int gtid = F.bid * NTHR + F.tid, gsz = F.G * NTHR, lane = F.lane;
    const int gw = F.bid * 8 + F.wave, nw = F.G * 8;
    { constexpr int NU = MPAD / 8; const int nfull = (NU / nw) * nw, lu = nfull + (nw - 1 - gw);
      f32x4 g[4];
#pragma unroll
      for (int i = 0; i < 4; ++i) g[i] = *(const f32x4*)(F.g1 + 256 * i + 4 * lane);
      for (int u0 = gw; u0 < nfull + nw; u0 += nw) { const int u = u0 < nfull ? u0 : lu; if (u >= NU) break;
        f32x4 v[8][4]; float ss[8];
#pragma unroll
        for (int r = 0; r < 8; ++r) { const int row = 8 * u + r;
            const float* src = row < MREAL ? F.x + (size_t)row * 1024 : F.meta + (size_t)(row < MROWS ? row - MREAL : 0) * 1024;
#pragma unroll
            for (int i = 0; i < 4; ++i) v[r][i] = *(const f32x4*)(src + 256 * i + 4 * lane); }
#pragma unroll
        for (int r = 0; r < 8; ++r) { float s = 0.f;
#pragma unroll
            for (int i = 0; i < 4; ++i) s += v[r][i][0] * v[r][i][0] + v[r][i][1] * v[r][i][1] + v[r][i][2] * v[r][i][2] + v[r][i][3] * v[r][i][3];
            ss[r] = s; }
#pragma unroll
        for (int o = 32; o > 0; o >>= 1) {
#pragma unroll
            for (int r = 0; r < 8; ++r) ss[r] += __shfl_xor(ss[r], o); }
#pragma unroll
        for (int r = 0; r < 8; ++r) { const int row = 8 * u + r; const float rs = row < MROWS ? rsqrtf(ss[r] * (1.f / 1024.f) + RMS_EPS) : 0.f;
            bf16_t* dst = F.XN() + (size_t)row * 1024;
#pragma unroll
            for (int i = 0; i < 4; ++i) { u32x2 w; w.x = cvt_pk_bf16(v[r][i][0] * rs * g[i][0], v[r][i][1] * rs * g[i][1]); w.y = cvt_pk_bf16(v[r][i][2] * rs * g[i][2], v[r][i][3] * rs * g[i][3]);
                *(u32x2*)(dst + 256 * i + 4 * lane) = w; } }
      } }
    { LAS float* tile = (LAS float*)F.lds + F.wave * (64 * 65);
      for (int t = gw; t < 704 + 256 + 512; t += nw) {
          if (t < 704) transpose_tile<true>(F, tile, F.w_in, NZ, NZ, F.WIN(), 1024, nullptr, (t & 15) * 64, (t >> 4) * 64);
          else if (t < 960) { const int q = t - 704, kt = q & 15;
              if (kt < 8) transpose_tile<false>(F, tile, F.w_out, 1024, 1024, F.WOUT(), 1024, nullptr, kt * 64, (q >> 4) * 64);
              else transpose_tile<false>(F, tile, F.w_out + (size_t)512 * 1024, 1024, 1024, F.TW(), 512, nullptr, (kt - 8) * 64, (q >> 4) * 64); }
          else { const int q = t - 960; transpose_tile<false>(F, tile, F.wq, 2048, 2048, F.WQ(), 1024, F.g2, (q & 15) * 64, (q >> 4) * 64); } } }
    for (int idx = gtid; idx < 2 * 128 * 128; idx += gsz) F.SK()[idx] = f2bf(idx < 16384 ? F.sk1[idx] : F.sk2[idx - 16384]);
    for (int idx = gtid; idx < MREAL; idx += gsz) F.SUMSQ()[idx] = 0.f;
}

__device__ __forceinline__ float sum_rows4(float s) {
    auto a = __builtin_amdgcn_permlane16_swap(__float_as_uint(s), __float_as_uint(s), false, false); s = __uint_as_float(a[0]) + __uint_as_float(a[1]);
    auto c = __builtin_amdgcn_permlane32_swap(__float_as_uint(s), __float_as_uint(s), false, false); return __uint_as_float(c[0]) + __uint_as_float(c[1]); }
struct EpiIn {
    static constexpr bool PERM = true, AFTER_DRAIN = false;
    bf16_t *Q, *K, *VV, *QI, *KI, *UP; float* WI; const float *gq, *gk;
    __device__ __forceinline__ static u32x4 pk8(const f32x4 a, const f32x4 b) { u32x4 w; w.x = cvt_pk_bf16(a[0], a[1]); w.y = cvt_pk_bf16(a[2], a[3]); w.z = cvt_pk_bf16(b[0], b[1]); w.w = cvt_pk_bf16(b[2], b[3]); return w; }
    __device__ __forceinline__ void operator()(const f32x4 (&acc)[2][2][4][2], const pg8::Unit& u, int wr, int wc, int fr, int fq) const {
        const int pn = u.pn;
        const int kind = pn < 2 ? 0 : pn < 4 ? 1 : pn < 6 ? 2 : pn < 8 ? 3 : pn < 10 ? 4 : 5;
        const bool headk = (kind <= 1) || kind == 4 || (kind == 5 && wc == 0);
        const float* gp = (kind == 1 ? gk : gq) + 8 * fq;
        const int head = 4 * (pn & 1) + wc;
        float frq[2][4];
#pragma unroll
        for (int n = 0; n < 2; ++n)
#pragma unroll
            for (int i = 0; i < 4; ++i) frq[n][i] = __builtin_amdgcn_exp2f(-(float)(8 * fq + 4 * n + i) * 0.41524101186092029f) * 0.15915494309189535f;
        f32x4 gv[2][2];
#pragma unroll
        for (int bj = 0; bj < 2; ++bj)
#pragma unroll
            for (int n = 0; n < 2; ++n) { gv[bj][n] = (f32x4){1.f, 1.f, 1.f, 1.f}; if (kind <= 1) gv[bj][n] = *(const f32x4*)(gp + 32 * bj + 4 * n); }
#pragma unroll
        for (int ai = 0; ai < 2; ++ai)
#pragma unroll
            for (int m = 0; m < 4; ++m) {
                int row_ = u.pm * 256 + ai * 128 + wr * 64 + m * 16 + fr; asm volatile("" : "+v"(row_));
                const int row = row_;
                const bool real = row < MREAL, valid = row < MROWS;
                const int b = real ? row >> 11 : 0, pos = real ? (row & 2047) + NMETA : (valid ? row - MREAL : 0);
                f32x4 v[2][2];
#pragma unroll
                for (int bj = 0; bj < 2; ++bj)
#pragma unroll
                    for (int n = 0; n < 2; ++n) v[bj][n] = acc[ai][bj][m][n];
                if (kind <= 1) {
                    float ss = 0.f;
#pragma unroll
                    for (int bj = 0; bj < 2; ++bj)
#pragma unroll
                        for (int n = 0; n < 2; ++n) ss += v[bj][n][0] * v[bj][n][0] + v[bj][n][1] * v[bj][n][1] + v[bj][n][2] * v[bj][n][2] + v[bj][n][3] * v[bj][n][3];
                    ss = sum_rows4(ss);
                    const float rs = rsqrtf(ss * (1.f / 64.f) + RMS_EPS);
#pragma unroll
                    for (int bj = 0; bj < 2; ++bj)
#pragma unroll
                        for (int n = 0; n < 2; ++n) v[bj][n] = v[bj][n] * (kind == 0 ? rs * (0.125f * LOG2E) : rs) * gv[bj][n];
                }
                if (headk) {
                    const float fpos = (float)pos;
#pragma unroll
                    for (int n = 0; n < 2; ++n) { f32x4 cs, sn;
#pragma unroll
                        for (int i = 0; i < 4; ++i) { const float rev = __builtin_amdgcn_fractf(fpos * frq[n][i]); cs[i] = __builtin_amdgcn_cosf(rev); sn[i] = __builtin_amdgcn_sinf(rev); }
                        const f32x4 x1 = v[0][n], x2 = v[1][n];
                        v[0][n] = x1 * cs - x2 * sn; v[1][n] = x2 * cs + x1 * sn; }
                }
                if (kind == 0 || kind == 4) { if (real) { bf16_t* d = (kind ? QI : Q) + (size_t)row * 512 + head * 64 + 8 * fq;
#pragma unroll
                        for (int bj = 0; bj < 2; ++bj) *(u32x4*)(d + 32 * bj) = pk8(v[bj][0], v[bj][1]); } }
                else if (kind == 1 || kind == 2) { if (valid) { const int col = (kind == 1 ? head * 64 : (pn - 4) * 256 + 32 * wc) + 8 * fq; const int cstep = kind == 1 ? 32 : 128; bf16_t* base = kind == 1 ? K : VV;
                        const int nrep = real ? 1 : NB;
                        for (int rb = 0; rb < nrep; ++rb) { bf16_t* d = base + (size_t)((real ? b : rb) * TT + pos) * 512 + col;
#pragma unroll
                            for (int bj = 0; bj < 2; ++bj) *(u32x4*)(d + cstep * bj) = pk8(v[bj][0], v[bj][1]); } } }
                else if (kind == 3) { if (valid) { bf16_t* d = UP + (size_t)row * 512 + (pn - 6) * 256 + 32 * wc + 8 * fq;
#pragma unroll
                        for (int bj = 0; bj < 2; ++bj) *(u32x4*)(d + 128 * bj) = pk8(v[bj][0], v[bj][1]); } }
                else {
                    if (wc == 0) { if (valid) { const int nrep = real ? 1 : NB;
                            for (int rb = 0; rb < nrep; ++rb) { bf16_t* d = KI + (size_t)((real ? b : rb) * TT + pos) * 64 + 8 * fq;
#pragma unroll
                                for (int bj = 0; bj < 2; ++bj) *(u32x4*)(d + 32 * bj) = pk8(v[bj][0], v[bj][1]); } } }
                    else if (wc == 1 && fq == 0 && real) { *(f32x4*)(WI + (size_t)row * 8) = v[0][0] * 0.044194173824159216f; *(f32x4*)(WI + (size_t)row * 8 + 4) = v[0][1] * 0.044194173824159216f; }
                }
                asm volatile("" ::: "memory");
            }
    }
};
struct EpiOut {
    static constexpr bool PERM = false, AFTER_DRAIN = false;
    const float* X; float* out; bf16_t* H1B; float* sumsq;
    __device__ __forceinline__ void operator()(const f32x4 (&acc)[2][2][4][2], const pg8::Unit& u, int wr, int wc, int fr, int fq) const {
        const int row0 = u.pm * 256 + wr * 64 + fr, col0 = u.pn * 256 + wc * 32 + 4 * fq;
        f32x4 xs[3][4];
#define EPIOUT_LDX(it_, d) do { const size_t off_ = (size_t)(row0 + ((it_) >> 2) * 128 + ((it_) & 3) * 16) * 1024 + col0; \
        _Pragma("unroll") for (int bj = 0; bj < 2; ++bj) _Pragma("unroll") for (int n = 0; n < 2; ++n) d[bj * 2 + n] = *(const f32x4*)(X + off_ + bj * 128 + n * 16); } while (0)
        EPIOUT_LDX(0, xs[0]); EPIOUT_LDX(1, xs[1]);
#pragma unroll
        for (int it = 0; it < 8; ++it) { const int ai = it >> 2, m = it & 3;
            if (it + 2 < 8) EPIOUT_LDX(it + 2, xs[(it + 2) % 3]);
            const int row = row0 + ai * 128 + m * 16; const size_t off = (size_t)row * 1024 + col0; float ss = 0.f;
#pragma unroll
            for (int bj = 0; bj < 2; ++bj)
#pragma unroll
                for (int n = 0; n < 2; ++n) { const f32x4 h = xs[it % 3][bj * 2 + n] + acc[ai][bj][m][n];
                    u32x2 w; w.x = cvt_pk_bf16(h[0], h[1]); w.y = cvt_pk_bf16(h[2], h[3]); *(u32x2*)(H1B + off + bj * 128 + n * 16) = w;
                    ss += h[0] * h[0] + h[1] * h[1] + h[2] * h[2] + h[3] * h[3]; }
            ss = sum_rows4(ss);
            if (fq == 0) atomicAdd(sumsq + row, ss); }
#undef EPIOUT_LDX
    }
};
struct EpiQP {
    static constexpr bool PERM = true, AFTER_DRAIN = false;
    bf16_t* O; const float* sumsq;
    __device__ __forceinline__ void operator()(const f32x4 (&acc)[2][2][4][2], const pg8::Unit& u, int wr, int wc, int fr, int fq) const {
        const int row0 = u.pm * 256 + wr * 64 + fr, col0 = u.pn * 256 + wc * 32 + 8 * fq;
        float sq[8];
#pragma unroll
        for (int it = 0; it < 8; ++it) sq[it] = sumsq[row0 + (it >> 2) * 128 + (it & 3) * 16];
#pragma unroll
        for (int ai = 0; ai < 2; ++ai)
#pragma unroll
            for (int m = 0; m < 4; ++m) { const int row = row0 + ai * 128 + m * 16; bf16_t* rowp = O + (size_t)row * 2048 + col0;
                const float rs = rsqrtf(sq[ai * 4 + m] * (1.f / 1024.f) + RMS_EPS);
#pragma unroll
                for (int bj = 0; bj < 2; ++bj) { const f32x4 v0 = acc[ai][bj][m][0] * rs, v1 = acc[ai][bj][m][1] * rs;
                    u32x4 w; w.x = cvt_pk_bf16(v0[0], v0[1]); w.y = cvt_pk_bf16(v0[2], v0[3]); w.z = cvt_pk_bf16(v1[0], v1[1]); w.w = cvt_pk_bf16(v1[2], v1[3]);
                    *(u32x4*)(rowp + bj * 128) = w; } }
    }
};

__device__ __forceinline__ int zrow_of(int b, int pos) { return pos < NMETA ? MREAL + pos : b * SEQ + pos - NMETA; }

__device__ __forceinline__ bf16_t f2bf_c(float f) { unsigned u = __float_as_uint(f); u += 0x7FFFu + ((u >> 16) & 1u); return (bf16_t)(u >> 16); }
__device__ __forceinline__ void p2_weff(const Frame& F) {
    const int lane = fresh((int)threadIdx.x) & 63, hk = lane >> 5, l31 = lane & 31;
    for (int t = F.bid * 8 + F.wave; t < 512; t += F.G * 8) {
        const int n0 = (t & 31) * 32, gc0 = (t >> 5) * 32, g = gc0 >> 7;
        f32x16 acc = {};
        const bf16_t* ap = F.TW() + (size_t)(n0 + l31) * 512 + g * 128 + 8 * hk;
        const float* bp = F.pool_w + (size_t)(gc0 + l31) * 128 + 8 * hk; const float* sp = F.pool_scale + g * 128 + 8 * hk;
#pragma unroll
        for (int ks = 0; ks < 8; ++ks) {
            const bf16x8 a = *(const bf16x8*)(ap + 16 * ks);
            const f32x4 w0 = *(const f32x4*)(bp + 16 * ks) * *(const f32x4*)(sp + 16 * ks), w1 = *(const f32x4*)(bp + 16 * ks + 4) * *(const f32x4*)(sp + 16 * ks + 4);
            u32x4 bw; bw.x = cvt_pk_bf16(w0[0], w0[1]); bw.y = cvt_pk_bf16(w0[2], w0[3]); bw.z = cvt_pk_bf16(w1[0], w1[1]); bw.w = cvt_pk_bf16(w1[2], w1[3]);
            acc = MFMA32(a, __builtin_bit_cast(bf16x8, bw), acc); }
#pragma unroll
        for (int r = 0; r < 16; ++r) F.WOUT()[(size_t)(n0 + (r & 3) + 8 * (r >> 2) + 4 * hk) * 1024 + 512 + gc0 + l31] = f2bf_c(acc[r]);
    }
}
__device__ __forceinline__ void p2_pool(const Frame& F) {
    const int lane = fresh((int)threadIdx.x) & 63, g = lane >> 4, w = 2 << g;
    const float iw = 1.f / (float)w;
    auto load_row = [&](const int row, u32x4 (&d)[16]) { const int b = row >> 11, pos = (row & 2047) + NMETA;
#pragma unroll
        for (int ii = 0; ii < 16; ++ii) { d[ii] = (u32x4){0u, 0u, 0u, 0u};
            if (ii < w) d[ii] = *(const u32x4*)(F.UP() + (size_t)zrow_of(b, pos - ii) * 512 + 8 * lane); } };
    auto finish_row = [&](const int row, const u32x4 (&d)[16]) { float sum[8];
#pragma unroll
        for (int i = 0; i < 8; ++i) sum[i] = 0.f;
#pragma unroll
        for (int ii = 0; ii < 16; ++ii) { const u32x4 v = d[ii];
            sum[0] += bflo(v.x); sum[1] += bfhi(v.x); sum[2] += bflo(v.y); sum[3] += bfhi(v.y); sum[4] += bflo(v.z); sum[5] += bfhi(v.z); sum[6] += bflo(v.w); sum[7] += bfhi(v.w); }
        const u32x4 v0 = d[0];
        u32x4 o; o.x = cvt_pk_bf16(sum[0] * iw - bflo(v0.x), sum[1] * iw - bfhi(v0.x)); o.y = cvt_pk_bf16(sum[2] * iw - bflo(v0.y), sum[3] * iw - bfhi(v0.y));
        o.z = cvt_pk_bf16(sum[4] * iw - bflo(v0.z), sum[5] * iw - bfhi(v0.z)); o.w = cvt_pk_bf16(sum[6] * iw - bflo(v0.w), sum[7] * iw - bfhi(v0.w));
        *(u32x4*)(F.MIX() + (size_t)row * 1024 + 512 + 8 * lane) = o; };
    const int rstep = F.G * 8 * 2;
    int row0 = (F.bid * 8 + F.wave) * 2;
    u32x4 xa[16], xb[16];
    if (row0 < MREAL) load_row(row0, xa);
    for (; row0 < MREAL; row0 += rstep) {
        load_row(row0 + 1, xb);
        finish_row(row0, xa);
        if (row0 + rstep < MREAL) load_row(row0 + rstep, xa);
        finish_row(row0 + 1, xb);
    }
}

__device__ __forceinline__ void indexer_item(const Frame& F, const int b, const int qt32) {
    constexpr int NTB = 65;
    const int lane = fresh((int)threadIdx.x) & 63, tid = (int)threadIdx.x, wv = F.wave, hk = lane >> 5, l31 = lane & 31;
    const int c = qt32 >> 1, nvis = 80 + 64 * c, ntile = 3 + 2 * c, nsteps = (ntile + 3) >> 2;
    const int qrow0 = b * SEQ + qt32 * 32 + 4 * wv;
    constexpr int NST = (NTB + 3) / 4;
    const int blk = l31 >> 3, hf = (l31 >> 2) & 1, e = l31 & 3;
    const int ql = 2 * hf + (blk >> 1), head = 4 * (blk & 1) + e;
    bf16x8 af[4];
    { const bf16_t* qip = F.QI() + (size_t)(qrow0 + ql) * 512 + head * 64 + 8 * hk;
#pragma unroll
      for (int ks = 0; ks < 4; ++ks) af[ks] = *(const bf16x8*)(qip + 16 * ks); }
    float wreg[16];
    { const float* wp = F.WI() + (size_t)(qrow0 + 2 * hk) * 8;
#pragma unroll
      for (int k = 0; k < 4; ++k) { const f32x4 w4 = *(const f32x4*)(wp + 4 * k);
#pragma unroll
          for (int i = 0; i < 4; ++i) wreg[4 * k + i] = w4[i]; } }
    const int st_key = tid >> 3, st_c8 = tid & 7;
    const unsigned st_off = st_key * 128 + ((st_c8 ^ (st_key & 7)) * 16);
    const bf16_t* kisrc = F.KI() + (size_t)(b * TT) * 64 + st_c8 * 8;
    u32x4 sa, sb;
    { int k0 = st_key, k1 = 64 + st_key; sa = *(const u32x4*)(kisrc + (size_t)k0 * 64); sb = *(const u32x4*)(kisrc + (size_t)k1 * 64); }
    *(LAS u32x4*)(F.lds + st_off) = sa; *(LAS u32x4*)(F.lds + 8192 + st_off) = sb;
    if (nsteps > 1) { int k0 = 128 + st_key, k1 = 192 + st_key; k0 = k0 < TT ? k0 : TT - 1; k1 = k1 < TT ? k1 : TT - 1; sa = *(const u32x4*)(kisrc + (size_t)k0 * 64); sb = *(const u32x4*)(kisrc + (size_t)k1 * 64); }
    __syncthreads();
    unsigned comp[2][NTB];
#pragma unroll
    for (int st = 0; st < NST; ++st) {
        if (st < nsteps) {
            const int buf = st & 1;
            u32x4 na = sa, nb = sb;
            if (st + 2 < nsteps) { int k0 = 128 * (st + 2) + st_key, k1 = k0 + 64; k0 = k0 < TT ? k0 : TT - 1; k1 = k1 < TT ? k1 : TT - 1; na = *(const u32x4*)(kisrc + (size_t)k0 * 64); nb = *(const u32x4*)(kisrc + (size_t)k1 * 64); }
#pragma unroll
            for (int tl = 0; tl < 4; ++tl) { constexpr int dummy = 0; (void)dummy; const int j = 4 * st + tl;
                if (j < NTB) {
                    unsigned c0 = 0u, c1 = 0u;
                    if (j < ntile) {
                        LAS const unsigned char* kb = F.lds + buf * 16384 + (32 * tl + l31) * 128;
                        f32x16 acc = {};
#pragma unroll
                        for (int ks = 0; ks < 4; ++ks) { const bf16x8 bfr = *(LAS const bf16x8*)(kb + (((2 * ks + hk) ^ (l31 & 7)) * 16)); acc = MFMA32(af[ks], bfr, acc); }
                        float s0 = 0.f, s1 = 0.f;
#pragma unroll
                        for (int r = 0; r < 8; ++r) { s0 += wreg[r] * fmaxf(acc[r], 0.f); s1 += wreg[r + 8] * fmaxf(acc[r + 8], 0.f); }
                        const int key = 32 * j + l31;
                        if (key < nvis) { unsigned u0 = __float_as_uint(s0), u1 = __float_as_uint(s1); if (u0 == 0x80000000u) u0 = 0u; if (u1 == 0x80000000u) u1 = 0u;
                            c0 = ((u0 ^ ((u0 >> 31) ? 0xFFFFFFFFu : 0x80000000u)) & ~0xFFFu) | (unsigned)(4095 - key);
                            c1 = ((u1 ^ ((u1 >> 31) ? 0xFFFFFFFFu : 0x80000000u)) & ~0xFFFu) | (unsigned)(4095 - key); }
                    }
                    comp[0][j] = c0; comp[1][j] = c1;
                    __builtin_amdgcn_sched_barrier(0);
                } }
            if (st + 1 < nsteps) { *(LAS u32x4*)(F.lds + (buf ^ 1) * 16384 + st_off) = sa; *(LAS u32x4*)(F.lds + (buf ^ 1) * 16384 + 8192 + st_off) = sb; }
            sa = na; sb = nb;
            __syncthreads();
        } else {
#pragma unroll
            for (int tl = 0; tl < 4; ++tl) { const int j = 4 * st + tl; if (j < NTB) { comp[0][j] = 0u; comp[1][j] = 0u; } }
        }
    }
    unsigned tA0 = 1u, tA1 = 1u, tB0 = 1u, tB1 = 1u;
    if (nvis > 256) { tA0 = tA1 = tB0 = tB1 = 0u; bool dA0 = false, dA1 = false, dB0 = false, dB1 = false;
#pragma unroll 1
        for (int bit = 31; bit >= 0; --bit) {
            const unsigned m = 1u << bit;
            const unsigned cand0 = (hk ? tB0 : tA0) | m, cand1 = (hk ? tB1 : tA1) | m;
            int p0 = 0, p1 = 0;
#define IDX_CNT(LO, HI) _Pragma("unroll") for (int j = (LO); j < (HI); ++j) { p0 += (comp[0][j] >= cand0) ? 1 : 0; p1 += (comp[1][j] >= cand1) ? 1 : 0; }
            IDX_CNT(0, 17)
            if (ntile > 17) { IDX_CNT(17, 33) if (ntile > 33) { IDX_CNT(33, 49) if (ntile > 49) { IDX_CNT(49, 65) } } }
#undef IDX_CNT
            p0 += __builtin_amdgcn_update_dpp(0, p0, 0xB1, 0xF, 0xF, false); p1 += __builtin_amdgcn_update_dpp(0, p1, 0xB1, 0xF, 0xF, false);
            p0 += __builtin_amdgcn_update_dpp(0, p0, 0x4E, 0xF, 0xF, false); p1 += __builtin_amdgcn_update_dpp(0, p1, 0x4E, 0xF, 0xF, false);
            p0 += __builtin_amdgcn_update_dpp(0, p0, 0x141, 0xF, 0xF, false); p1 += __builtin_amdgcn_update_dpp(0, p1, 0x141, 0xF, 0xF, false);
            p0 += __builtin_amdgcn_update_dpp(0, p0, 0x140, 0xF, 0xF, false); p1 += __builtin_amdgcn_update_dpp(0, p1, 0x140, 0xF, 0xF, false);
            const int cA0 = __builtin_amdgcn_readlane(p0, 0) + __builtin_amdgcn_readlane(p0, 16), cB0 = __builtin_amdgcn_readlane(p0, 32) + __builtin_amdgcn_readlane(p0, 48);
            const int cA1 = __builtin_amdgcn_readlane(p1, 0) + __builtin_amdgcn_readlane(p1, 16), cB1 = __builtin_amdgcn_readlane(p1, 32) + __builtin_amdgcn_readlane(p1, 48);
            if (!dA0 && cA0 >= 256) { tA0 |= m; dA0 = (cA0 == 256); }
            if (!dA1 && cA1 >= 256) { tA1 |= m; dA1 = (cA1 == 256); }
            if (!dB0 && cB0 >= 256) { tB0 |= m; dB0 = (cB0 == 256); }
            if (!dB1 && cB1 >= 256) { tB1 |= m; dB1 = (cB1 == 256); }
            if (dA0 && dA1 && dB0 && dB1) break; } }
    const unsigned t0 = hk ? tB0 : tA0, t1 = hk ? tB1 : tA1;
    int mq[4] = {0, 0, 0, 0};
    unsigned w64[4] = {0u, 0u, 0u, 0u};
#pragma unroll
    for (int j = 0; j < NTB; ++j) { const unsigned long long m0 = __ballot(comp[0][j] >= t0), m1 = __ballot(comp[1][j] >= t1);
        if (j < 64) {
            asm volatile("v_writelane_b32 %0, %2, %4\n\tv_writelane_b32 %1, %3, %4" : "+v"(mq[0]), "+v"(mq[2]) : "s"((int)(unsigned)m0), "s"((int)(unsigned)(m0 >> 32)), "i"(j < 64 ? j : 0));
            asm volatile("v_writelane_b32 %0, %2, %4\n\tv_writelane_b32 %1, %3, %4" : "+v"(mq[1]), "+v"(mq[3]) : "s"((int)(unsigned)m1), "s"((int)(unsigned)(m1 >> 32)), "i"(j < 64 ? j : 0));
        } else { w64[0] = (unsigned)m0; w64[2] = (unsigned)(m0 >> 32); w64[1] = (unsigned)m1; w64[3] = (unsigned)(m1 >> 32); } }
#pragma unroll
    for (int q = 0; q < 4; ++q) { unsigned* mrow = F.MASK() + (size_t)(qrow0 + q) * MASKW;
        if (lane <= ntile + 2 && lane < 64) mrow[lane] = lane < ntile ? (unsigned)mq[q] : 0u;
        if (lane < 4 && 64 + lane <= ntile + 2) mrow[64 + lane] = (64 + lane < ntile) ? w64[q] : 0u; }
    __syncthreads();
}

__device__ __forceinline__ void p3_indexer(const Frame& F) {
    for (int it = F.bid; it < 512; it += F.G) {
        const int half = it >> 8, ii = half ? 511 - (it & 255) : it;
        indexer_item(F, ii & 7, 63 - (ii >> 3));
    }
}

typedef short v4i16_t __attribute__((ext_vector_type(4)));
__device__ __forceinline__ s16x4 vtr(LAS const unsigned char* p) { return __builtin_bit_cast(s16x4, __builtin_amdgcn_ds_read_tr16_b64_v4i16((LAS v4i16_t*)p)); }

struct AttnPf { bf16x8 q[4]; u32x4 kv[4]; };
__device__ __forceinline__ void p4_item_loads(const Frame& F, const int it_, AttnPf& pf) {
    const int lane = fresh((int)threadIdx.x) & 63, wv = F.wave, tid = (int)threadIdx.x, hk = lane >> 5, l31 = lane & 31;
    const int st_which = tid >> 8, st_r = (tid & 255) >> 3, st_c8 = tid & 7;
    const int it = it_ < 512 ? it_ : 511;
    const int pr = it & 255, half = it >> 8, cp = pr & 3, bh = pr >> 2, b = bh >> 3, h = bh & 7, c4 = half ? 7 - cp : cp;
    const int qrow = b * SEQ + 256 * c4 + 32 * wv + l31;
#pragma unroll
    for (int ks = 0; ks < 4; ++ks) pf.q[ks] = *(const bf16x8*)(F.Q() + (size_t)qrow * 512 + h * 64 + 16 * ks + 8 * hk);
    const bf16_t* stsrc = (st_which ? F.VV() : F.K()) + (size_t)(b * TT) * 512 + h * 64 + st_c8 * 8;
#pragma unroll
    for (int q = 0; q < 4; ++q) pf.kv[q] = *(const u32x4*)(stsrc + (size_t)(32 * q + st_r) * 512);
}
__device__ __forceinline__ void p4_attention(const Frame& F, AttnPf& pf, const bool have_first) {
    const int lane = fresh((int)threadIdx.x) & 63, wv = F.wave, tid = (int)threadIdx.x, hk = lane >> 5, l31 = lane & 31;
    float gb; { float a = fabsf(F.gq[lane]), bq = fabsf(F.gk[lane]);
#pragma unroll
        for (int o = 32; o > 0; o >>= 1) { a = fmaxf(a, __shfl_xor(a, o)); bq = fmaxf(bq, __shfl_xor(bq, o)); }
        gb = a * bq; }
    const float NMB = -8.f * gb * 1.02f * LOG2E;
    const int st_which = tid >> 8, st_r = (tid & 255) >> 3, st_c8 = tid & 7;
    const unsigned st_off = st_which ? (32768u + st_r * 128 + st_c8 * 16) : (st_r * 128 + ((st_c8 ^ (st_r & 7)) * 16));
    for (int it = F.bid; it < 512; it += F.G) {
        const int pr = it & 255, half = it >> 8, cp = pr & 3, bh = pr >> 2, b = bh >> 3, h = bh & 7, c4 = half ? 7 - cp : cp;
        const int qrow = b * SEQ + 256 * c4 + 32 * wv + l31;
        const int cch = 4 * c4 + (wv >> 1), nt = (80 + 64 * cch + 127) >> 7, ntmax = (80 + 64 * (4 * c4 + 3) + 127) >> 7;
        if (!(have_first && it == F.bid)) p4_item_loads(F, it, pf);
        bf16x8 qf[4];
#pragma unroll
        for (int ks = 0; ks < 4; ++ks) qf[ks] = pf.q[ks];
        const bf16_t* stsrc = (st_which ? F.VV() : F.K()) + (size_t)(b * TT) * 512 + h * 64 + st_c8 * 8;
        f32x16 o0 = {}, o1 = {}; float lsum = 0.f;
        u32x4 sa[4];
#pragma unroll
        for (int q = 0; q < 4; ++q) sa[q] = pf.kv[q];
        u32x4 mw = *(const u32x4*)(F.MASK() + (size_t)qrow * MASKW);
#pragma unroll
        for (int q = 0; q < 4; ++q) *(LAS u32x4*)(F.lds + 4096 * q + st_off) = sa[q];
        if (ntmax > 1) {
#pragma unroll
            for (int q = 0; q < 4; ++q) { int k = 128 + 32 * q + st_r; k = k < TT ? k : TT - 1; sa[q] = *(const u32x4*)(stsrc + (size_t)k * 512); } }
        __syncthreads();
        for (int j = 0; j < ntmax; ++j) {
            const int buf = j & 1;
            u32x4 mw_next = {0u, 0u, 0u, 0u}; u32x4 na[4];
#pragma unroll
            for (int q = 0; q < 4; ++q) na[q] = sa[q];
            if (j + 2 < ntmax) {
#pragma unroll
                for (int q = 0; q < 4; ++q) { int k = 128 * (j + 2) + 32 * q + st_r; k = k < TT ? k : TT - 1; na[q] = *(const u32x4*)(stsrc + (size_t)k * 512); } }
            if (j + 1 < nt) mw_next = *(const u32x4*)(F.MASK() + (size_t)qrow * MASKW + 4 * (j + 1));
            if (j < nt) {
                LAS const unsigned char* kb = F.lds + buf * 16384; LAS const unsigned char* vb = F.lds + 32768 + buf * 16384;
#pragma unroll
                for (int hp = 0; hp < 2; ++hp) {
                    f32x16 s[2];
#pragma unroll
                    for (int hh = 0; hh < 2; ++hh)
#pragma unroll
                        for (int r = 0; r < 16; ++r) s[hh][r] = NMB;
#pragma unroll
                    for (int ks = 0; ks < 4; ++ks)
#pragma unroll
                        for (int hh = 0; hh < 2; ++hh) { const bf16x8 kf = *(LAS const bf16x8*)(kb + (64 * hp + 32 * hh + l31) * 128 + (((2 * ks + hk) ^ (l31 & 7)) * 16)); s[hh] = MFMA32(kf, qf[ks], s[hh]); }
                    bf16x8 pf[2][2];
#pragma unroll
                    for (int hh = 0; hh < 2; ++hh) {
                        const unsigned w2 = mw[2 * hp + hh] >> (4 * hk);
                        float p[16];
#pragma unroll
                        for (int r = 0; r < 16; ++r) { p[r] = __uint_as_float(__float_as_uint(__builtin_amdgcn_exp2f(s[hh][r])) & (unsigned)__builtin_amdgcn_sbfe((int)w2, (r & 3) + 8 * (r >> 2), 1)); lsum += p[r]; }
#pragma unroll
                        for (int s2 = 0; s2 < 2; ++s2) { u32x4 w; w.x = cvt_pk_bf16(p[8 * s2 + 0], p[8 * s2 + 1]); w.y = cvt_pk_bf16(p[8 * s2 + 2], p[8 * s2 + 3]);
                            w.z = cvt_pk_bf16(p[8 * s2 + 4], p[8 * s2 + 5]); w.w = cvt_pk_bf16(p[8 * s2 + 6], p[8 * s2 + 7]); pf[hh][s2] = __builtin_bit_cast(bf16x8, w); }
                    }
                    const int i16 = lane & 15, g1 = (lane >> 4) & 1;
#pragma unroll
                    for (int hh = 0; hh < 2; ++hh) {
                        LAS const unsigned char* vp = vb + (64 * hp + 32 * hh + 4 * hk + (i16 >> 2)) * 128 + (16 * g1 + 4 * (i16 & 3)) * 2;
#pragma unroll
                        for (int s2 = 0; s2 < 2; ++s2) {
                            { const s16x4 lo = vtr(vp + (16 * s2) * 128), hi = vtr(vp + (16 * s2 + 8) * 128);
                              const bf16x8 vf = {lo[0], lo[1], lo[2], lo[3], hi[0], hi[1], hi[2], hi[3]}; o0 = MFMA32(vf, pf[hh][s2], o0); }
                            { const s16x4 lo = vtr(vp + (16 * s2) * 128 + 64), hi = vtr(vp + (16 * s2 + 8) * 128 + 64);
                              const bf16x8 vf = {lo[0], lo[1], lo[2], lo[3], hi[0], hi[1], hi[2], hi[3]}; o1 = MFMA32(vf, pf[hh][s2], o1); }
                        }
                    }
                }
            }
            if (j + 1 < ntmax) {
#pragma unroll
                for (int q = 0; q < 4; ++q) *(LAS u32x4*)(F.lds + (buf ^ 1) * 16384 + 4096 * q + st_off) = sa[q]; }
            mw = mw_next;
#pragma unroll
            for (int q = 0; q < 4; ++q) sa[q] = na[q];
            __syncthreads();
        }
        lsum += __shfl_xor(lsum, 32);
        const float inv = 1.f / lsum;
        bf16_t* dst = F.MIX() + (size_t)qrow * 1024 + h * 64 + 4 * hk;
#pragma unroll
        for (int g = 0; g < 4; ++g) {
            u32x2 w; w.x = cvt_pk_bf16(o0[4 * g] * inv, o0[4 * g + 1] * inv); w.y = cvt_pk_bf16(o0[4 * g + 2] * inv, o0[4 * g + 3] * inv); *(u32x2*)(dst + 8 * g) = w;
            u32x2 w1; w1.x = cvt_pk_bf16(o1[4 * g] * inv, o1[4 * g + 1] * inv); w1.y = cvt_pk_bf16(o1[4 * g + 2] * inv, o1[4 * g + 3] * inv); *(u32x2*)(dst + 32 + 8 * g) = w1; }
    }
}

template <int N> __device__ __forceinline__ void bitonic_sort_desc(float (&a)[N]) {
#pragma unroll
    for (int k = 2; k <= N; k <<= 1)
#pragma unroll
        for (int j = k >> 1; j > 0; j >>= 1)
#pragma unroll
            for (int i = 0; i < N; ++i) { const int l = i ^ j; if (l > i) { const bool desc = ((i & k) == 0) || (k == N); const float x = a[i], y = a[l];
                const float mx = fmaxf(x, y), mn = fminf(x, y); a[i] = desc ? mx : mn; a[l] = desc ? mn : mx; } }
}
__device__ __forceinline__ void sort16_desc(float (&a)[16]) {
#define S16_CE(i, j) { const float x_ = a[i], y_ = a[j]; a[i] = fmaxf(x_, y_); a[j] = fminf(x_, y_); }
    S16_CE(0, 13) S16_CE(1, 12) S16_CE(2, 15) S16_CE(3, 14) S16_CE(4, 8) S16_CE(5, 6) S16_CE(7, 11) S16_CE(9, 10)
    S16_CE(0, 5) S16_CE(1, 7) S16_CE(2, 9) S16_CE(3, 4) S16_CE(6, 13) S16_CE(8, 14) S16_CE(10, 15) S16_CE(11, 12)
    S16_CE(0, 1) S16_CE(2, 3) S16_CE(4, 5) S16_CE(6, 8) S16_CE(7, 9) S16_CE(10, 11) S16_CE(12, 13) S16_CE(14, 15)
    S16_CE(0, 2) S16_CE(1, 3) S16_CE(4, 10) S16_CE(5, 11) S16_CE(6, 7) S16_CE(8, 9) S16_CE(12, 14) S16_CE(13, 15)
    S16_CE(1, 2) S16_CE(3, 12) S16_CE(4, 6) S16_CE(5, 7) S16_CE(8, 10) S16_CE(9, 11) S16_CE(13, 14)
    S16_CE(1, 4) S16_CE(2, 6) S16_CE(5, 8) S16_CE(7, 10) S16_CE(9, 13) S16_CE(11, 14)
    S16_CE(2, 4) S16_CE(3, 6) S16_CE(9, 12) S16_CE(11, 13)
    S16_CE(3, 5) S16_CE(6, 8) S16_CE(7, 9) S16_CE(10, 12)
    S16_CE(3, 4) S16_CE(5, 6) S16_CE(7, 8) S16_CE(9, 10) S16_CE(11, 12)
    S16_CE(6, 7) S16_CE(8, 9)
#undef S16_CE
}
__device__ __forceinline__ void merge_top16(float (&a)[16], const float (&b)[16]) {
#pragma unroll
    for (int i = 0; i < 16; ++i) a[i] = fmaxf(a[i], b[15 - i]);
#pragma unroll
    for (int j = 8; j > 0; j >>= 1)
#pragma unroll
        for (int i = 0; i < 16; ++i) { const int l = i ^ j; if (l > i) { const float x = a[i], y = a[l]; a[i] = fmaxf(x, y); a[l] = fminf(x, y); } }
}
__device__ __forceinline__ void cex(float& x, int& px, float& y, int& py) { const bool sw = y > x; const float tx = sw ? y : x, ty = sw ? x : y; const int tp = sw ? py : px, tq = sw ? px : py; x = tx; y = ty; px = tp; py = tq; }

__host__ __device__ constexpr int cand_cnt(int i) { return 16 / (i + 1); }
__host__ __device__ constexpr int cand_off(int i) { int s = 0; for (int k = 0; k < i; ++k) s += cand_cnt(k); return s; }
static_assert(cand_off(16) == 50, "candidates");
template <int N> __device__ __forceinline__ void bitonic_sort_desc_kv(float (&a)[N], int (&p)[N]) {
#pragma unroll
    for (int k = 2; k <= N; k <<= 1)
#pragma unroll
        for (int j = k >> 1; j > 0; j >>= 1)
#pragma unroll
            for (int i = 0; i < N; ++i) { const int l = i ^ j; if (l > i) { const bool desc = ((i & k) == 0) || (k == N);
                if (desc) cex(a[i], p[i], a[l], p[l]); else cex(a[l], p[l], a[i], p[i]); } }
}
__device__ __forceinline__ void merge_top16_kv(float (&a)[16], int (&pa)[16], const float (&b)[16], const int (&pb)[16]) {
#pragma unroll
    for (int i = 0; i < 16; ++i) { const bool sw = b[15 - i] > a[i]; a[i] = sw ? b[15 - i] : a[i]; pa[i] = sw ? pb[15 - i] : pa[i]; }
#pragma unroll
    for (int j = 8; j > 0; j >>= 1)
#pragma unroll
        for (int i = 0; i < 16; ++i) { const int l = i ^ j; if (l > i) cex(a[i], pa[i], a[l], pa[l]); }
}
__device__ __forceinline__ void sub_top16(const Frame& F, LAS const unsigned char* skl, const bf16_t* qrow, float (&top)[16]) {
    const int lane = F.lane, hk = lane >> 5, l31 = lane & 31;
    bf16x8 bq[8];
#pragma unroll
    for (int ks = 0; ks < 8; ++ks) bq[ks] = *(const bf16x8*)(qrow + 16 * ks + 8 * hk);
#pragma unroll
    for (int mt = 0; mt < 4; ++mt) {
        f32x16 acc = {};
        const int key = 32 * mt + l31;
#pragma unroll
        for (int ks = 0; ks < 8; ++ks) { const bf16x8 a = *(LAS const bf16x8*)(skl + key * 256 + (((2 * ks + hk) ^ (key & 15)) * 16)); acc = MFMA32(a, bq[ks], acc); }
        float cur[16];
#pragma unroll
        for (int r = 0; r < 16; ++r) { const unsigned kidx = (unsigned)(32 * mt + (r & 3) + 8 * (r >> 2) + 4 * hk); cur[r] = __uint_as_float((__float_as_uint(acc[r]) & ~127u) | kidx); }
        sort16_desc(cur);
        if (mt == 0) {
#pragma unroll
            for (int i = 0; i < 16; ++i) top[i] = cur[i]; }
        else merge_top16(top, cur);
        __builtin_amdgcn_sched_barrier(0);
    }
    float oth[16];
#pragma unroll
    for (int i = 0; i < 16; ++i) oth[i] = __shfl_xor(top[i], 32);
    merge_top16(top, oth);
}

__host__ __device__ constexpr int p1_units() { return (MPAD / 256) * (NZP / 256); }
__host__ __device__ __forceinline__ int p1_first_idle(int G) { const int maxu = (p1_units() + G - 1) / G; return p1_units() - (maxu - 1) * G; }
__host__ __device__ __forceinline__ int tables_rows_p1(int G) { const int r = (G - p1_first_idle(G)) * 8 * 24; return r < 2 * NEXP ? r : 2 * NEXP; }
__device__ __forceinline__ unsigned pack_i8(float a, float b, float c, float d) {
    const unsigned ua = __float_as_uint(a + 12582912.f), ub = __float_as_uint(b + 12582912.f), uc = __float_as_uint(c + 12582912.f), ud = __float_as_uint(d + 12582912.f);
    return __builtin_amdgcn_perm(ub, ua, 0x0c0c0400u) | __builtin_amdgcn_perm(ud, uc, 0x04000c0cu);
}
__device__ __forceinline__ void tb_load4(const Frame& F, f32x4 (&v)[4][4], const int r0, const int lane) {
    const bool isv = r0 >= NEXP; const float* src = (isv ? F.pv : F.pu) + (size_t)(isv ? r0 - NEXP : r0) * 1024 + 4 * lane;
#pragma unroll
    for (int r = 0; r < 4; ++r)
#pragma unroll
        for (int i = 0; i < 4; ++i) v[r][i] = *(const f32x4*)(src + (size_t)r * 1024 + 256 * i);
}
__device__ __forceinline__ void tb_conv4(const Frame& F, f32x4 (&v)[4][4], const f32x4 (&g)[4], const int r0, const int lane) {
    const bool isv = r0 >= NEXP; const int e0 = isv ? r0 - NEXP : r0;
    float mx[4];
#pragma unroll
    for (int r = 0; r < 4; ++r) { float m = 0.f;
#pragma unroll
        for (int i = 0; i < 4; ++i) { if (!isv) v[r][i] = v[r][i] * g[i];
            m = fmaxf(m, fmaxf(fmaxf(fabsf(v[r][i][0]), fabsf(v[r][i][1])), fmaxf(fabsf(v[r][i][2]), fabsf(v[r][i][3])))); }
        mx[r] = m; }
#pragma unroll
    for (int o = 32; o > 0; o >>= 1) {
#pragma unroll
        for (int r = 0; r < 4; ++r) mx[r] = fmaxf(mx[r], __shfl_xor(mx[r], o)); }
    unsigned char* dst = (isv ? F.V8() : F.U8()) + (size_t)(lane >> 5) * (NEXP * 128) + (size_t)((4 * lane) & 127);
#pragma unroll
    for (int r = 0; r < 4; ++r) { const float qmax = isv ? 440.f : 127.f; const float sc = mx[r] > 0.f ? mx[r] / qmax : 1.f, inv = 1.f / sc;
#pragma unroll
        for (int i = 0; i < 4; ++i) { unsigned w;
            if (isv) { int p = __builtin_amdgcn_cvt_pk_fp8_f32(v[r][i][0] * inv, v[r][i][1] * inv, 0, false); p = __builtin_amdgcn_cvt_pk_fp8_f32(v[r][i][2] * inv, v[r][i][3] * inv, p, true); w = (unsigned)p; }
            else w = pack_i8(v[r][i][0] * inv, v[r][i][1] * inv, v[r][i][2] * inv, v[r][i][3] * inv);
            *(unsigned*)(dst + (size_t)(2 * i) * (NEXP * 128) + (size_t)(e0 + r) * 128) = w; }
        if (lane == 0) (isv ? F.SV() : F.SU())[e0 + r] = sc; }
}
__device__ __forceinline__ void p7b_tables(const Frame& F, const int widx, const int nworkers, const int rbeg, const int rend) {
    const int lane = fresh((int)threadIdx.x) & 63;
    f32x4 g[4];
#pragma unroll
    for (int i = 0; i < 4; ++i) g[i] = *(const f32x4*)(F.g2 + 256 * i + 4 * lane);
    int r0 = rbeg + widx * 8; if (r0 >= rend) return;
    f32x4 va[4][4], vb[4][4];
    tb_load4(F, va, r0, lane);
#pragma unroll 1
    for (;;) {
        tb_load4(F, vb, r0 + 4, lane);
        tb_conv4(F, va, g, r0, lane);
        const int rn = r0 + nworkers * 8; const bool more = rn < rend;
        if (more) tb_load4(F, va, rn, lane);
        tb_conv4(F, vb, g, r0 + 4, lane);
        if (!more) break;
        r0 = rn;
    }
}

__device__ __forceinline__ void p7_routing(const Frame& F) {
    const int lane = F.lane, hk = lane >> 5, l31 = lane & 31;
    for (int idx = F.tid; idx < 2 * 128 * 16; idx += NTHR) { const int tb = idx >> 11, key = (idx >> 4) & 127, c16 = idx & 15;
        const u32x4 v = *(const u32x4*)(F.SK() + (size_t)tb * 16384 + key * 128 + c16 * 8);
        *(LAS u32x4*)(F.lds + tb * 32768 + key * 256 + ((c16 ^ (key & 15)) * 16)) = v; }
    LAS unsigned* ctab = (LAS unsigned*)(F.lds + 131072);
    if (F.tid < 50) { int n = F.tid, i = 0; while (n >= cand_cnt(i)) { n -= cand_cnt(i); ++i; } ctab[F.tid] = (unsigned)((i << 4) | n); }
    LAS float* lt = (LAS float*)(F.lds + 65536) + F.wave * 2048;
    __syncthreads();
    constexpr int RW = 6;
    if (F.wave >= RW) { p7b_tables(F, F.bid * (8 - RW) + (F.wave - RW), F.G * (8 - RW), tables_rows_p1(F.G), 2 * NEXP); return; }
    pg8::StaticOrder S; S.init(MREAL, 2048, F.G, F.bid);
    for (int li = F.wave; ; li += RW) {
        pg8::Unit un; if (!S.next(li >> 3, un)) break;
        const int tt = un.pm * 8 + (li & 7), head = un.pn, tok = tt * 32 + l31;
        const bf16_t* qrow = F.QP() + (size_t)tok * 2048 + head * 256;
        float t1[16], t2[16];
        sub_top16(F, F.lds, qrow, t1);
        sub_top16(F, F.lds + 32768, qrow + 128, t2);
#pragma unroll
        for (int i = 0; i < 16; ++i) { lt[i * 64 + lane] = t1[i]; lt[(16 + i) * 64 + lane] = t2[i]; }
        float cv[4][16];
#pragma unroll
        for (int k = 50; k < 64; ++k) cv[k >> 4][k & 15] = -3.0e38f;
#pragma unroll
        for (int i = 0; i < 16; ++i)
#pragma unroll
            for (int j = 0; j < 16; ++j) if ((i + 1) * (j + 1) <= 16) {
                const int n = cand_off(i) + j;
                const float sum = __uint_as_float(__float_as_uint(t1[i]) & ~127u) + __uint_as_float(__float_as_uint(t2[j]) & ~127u);
                cv[n >> 4][n & 15] = __uint_as_float((__float_as_uint(sum) & ~63u) | (unsigned)n); }
#pragma unroll
        for (int g = 0; g < 4; ++g) sort16_desc(cv[g]);
        merge_top16(cv[0], cv[1]); merge_top16(cv[2], cv[3]); merge_top16(cv[0], cv[2]);
        float sv[16]; int ev[16];
#pragma unroll
        for (int k = 0; k < 16; ++k) { const unsigned ij = ctab[__float_as_uint(cv[0][k]) & 63u];
            const unsigned a = __float_as_uint(lt[(ij >> 4) * 64 + lane]), bb = __float_as_uint(lt[(16 + (ij & 15)) * 64 + lane]);
            sv[k] = __uint_as_float(a & ~127u) + __uint_as_float(bb & ~127u); ev[k] = (int)(((a & 127u) << 7) | (bb & 127u)); }
        float mx = sv[0];
#pragma unroll
        for (int k = 1; k < 16; ++k) mx = fmaxf(mx, sv[k]);
        float ge[16], gs = 0.f;
#pragma unroll
        for (int k = 0; k < 16; ++k) { ge[k] = __expf(sv[k] - mx); gs += ge[k]; }
        const float ginv = 1.f / gs;
        if (hk == 0) {
            bf16_t* ed = F.EID() + (size_t)tok * 128 + head * 16; float* gd = F.GATE() + (size_t)tok * 128 + head * 16;
#pragma unroll
            for (int k = 0; k < 16; k += 8) *(u32x4*)(ed + k) = (u32x4){(unsigned)ev[k] | ((unsigned)ev[k + 1] << 16), (unsigned)ev[k + 2] | ((unsigned)ev[k + 3] << 16), (unsigned)ev[k + 4] | ((unsigned)ev[k + 5] << 16), (unsigned)ev[k + 6] | ((unsigned)ev[k + 7] << 16)};
#pragma unroll
            for (int k = 0; k < 16; k += 4) *(f32x4*)(gd + k) = (f32x4){ge[k] * ginv, ge[k + 1] * ginv, ge[k + 2] * ginv, ge[k + 3] * ginv};
        }
    }
}

typedef float f32x2 __attribute__((ext_vector_type(2)));
#define XQ_WORD(pass, s) (4096 + 64 * (8 * (pass) + (s)))
#define XQ_TOK 32
#define XQ_CHUNKS (MREAL / (8 * XQ_TOK))
__device__ __forceinline__ int next_item(const Frame& F, unsigned* ctl, int qpass, int cur) {
    volatile LAS int* slot = (volatile LAS int*)(F.lds + LDS_BYTES - 32);
    __syncthreads();
    if (F.tid == 0) { int res = -1;
        for (int d = 0; d < 8; ++d) { const int s = (cur + d) & 7; unsigned* c = ctl + XQ_WORD(qpass, s);
            if (__hip_atomic_load(c, __ATOMIC_RELAXED, __HIP_MEMORY_SCOPE_AGENT) >= (unsigned)XQ_CHUNKS) continue;
            const unsigned idx = __hip_atomic_fetch_add(c, 1u, __ATOMIC_RELAXED, __HIP_MEMORY_SCOPE_AGENT);
            if (idx < (unsigned)XQ_CHUNKS) { res = (s << 16) | (int)idx; break; } }
        *slot = res; }
    __syncthreads();
    return *slot;
}
__device__ __forceinline__ float swap32_sum(float a, float b) { auto r = __builtin_amdgcn_permlane32_swap(__float_as_uint(a), __float_as_uint(b), false, false); return __uint_as_float(r[0]) + __uint_as_float(r[1]); }
__device__ __forceinline__ float swap16_sum(float a, float b) { auto r = __builtin_amdgcn_permlane16_swap(__float_as_uint(a), __float_as_uint(b), false, false); return __uint_as_float(r[0]) + __uint_as_float(r[1]); }
__device__ __forceinline__ float ror8_sum(float mine, float theirs) { return mine + __uint_as_float((unsigned)__builtin_amdgcn_update_dpp(0, (int)__float_as_uint(theirs), 0x128, 0xF, 0xF, false)); }
template <int CTRL> __device__ __forceinline__ float dpp_sum(float mine, float theirs) { return mine + __uint_as_float((unsigned)__builtin_amdgcn_update_dpp(0, (int)__float_as_uint(theirs), CTRL, 0xF, 0xF, false)); }
#define P8_LOAD8(R, EV, BASE, OFF) _Pragma("unroll") for (int ii = 0; ii < 8; ++ii) { const int e_ = __shfl((EV), 8 * ii + xg); R[ii] = *(const u32x4*)((BASE) + ((unsigned)e_ * 128u + (OFF))); }
#define P8U_DOT8(R, P0) _Pragma("unroll") for (int ii = 0; ii < 8; ++ii) { int a_ = __builtin_amdgcn_sdot4((int)R[ii][0], (int)xq[0], 0, false); a_ = __builtin_amdgcn_sdot4((int)R[ii][1], (int)xq[1], a_, false); \
        a_ = __builtin_amdgcn_sdot4((int)R[ii][2], (int)xq[2], a_, false); p[(P0) + ii] = __builtin_amdgcn_sdot4((int)R[ii][3], (int)xq[3], a_, false); }
template <int CTRL> __device__ __forceinline__ int dpp_isum(int mine, int theirs) { return mine + __builtin_amdgcn_update_dpp(0, theirs, CTRL, 0xF, 0xF, false); }
template <int CTRL> __device__ __forceinline__ float dpp_fmax(float v) { return fmaxf(v, __uint_as_float((unsigned)__builtin_amdgcn_update_dpp(0, (int)__float_as_uint(v), CTRL, 0xF, 0xF, false))); }
template <int QPASS>
__device__ __forceinline__ void p8u_sliced(const Frame& F) {
    unsigned* ctl = (unsigned*)(F.ws + WS_CTL);
    int cur = (int)(xb_xcc_id() & 7u);
    for (;;) { const int itm = next_item(F, ctl, QPASS, cur); if (itm < 0) break;
        const int s = itm >> 16, chunk = itm & 0xffff; cur = s;
        const int lane = fresh((int)threadIdx.x) & 63, xg = lane >> 3, ch = lane & 7;
        const int t0 = chunk * (8 * XQ_TOK) + F.wave * XQ_TOK;
        const unsigned char* ubase = F.U8() + (size_t)s * (NEXP * 128);
        const unsigned uoff = 16u * ch;
        const bool b2 = lane & 4, b1 = lane & 2, b0 = lane & 1;
        const int kout = 64 * (b2 ? 1 : 0) + 32 * (b0 ? 1 : 0) + 16 * (b1 ? 1 : 0) + xg;
        bf16_t* part = F.PART() + (size_t)s * ((size_t)MREAL * 128);
        LAS unsigned char* xl = F.lds + F.wave * 4096; LAS float* xsl = (LAS float*)(F.lds + 32768) + F.wave * 32;
        { u32x4 hx[4][2];
#pragma unroll
          for (int r = 0; r < 4; ++r) { const bf16_t* hp = F.H1B() + (unsigned)((t0 + 8 * r + xg) * 1024 + 128 * s + 16 * ch); hx[r][0] = *(const u32x4*)hp; hx[r][1] = *(const u32x4*)(hp + 8); }
#pragma unroll
          for (int r = 0; r < 4; ++r) { float v[16];
#pragma unroll
              for (int q = 0; q < 4; ++q) { v[2 * q] = bflo(hx[r][0][q]); v[2 * q + 1] = bfhi(hx[r][0][q]); v[8 + 2 * q] = bflo(hx[r][1][q]); v[8 + 2 * q + 1] = bfhi(hx[r][1][q]); }
              float m = fabsf(v[0]);
#pragma unroll
              for (int q = 1; q < 16; ++q) m = fmaxf(m, fabsf(v[q]));
              m = dpp_fmax<0xB1>(m); m = dpp_fmax<0x4E>(m); m = dpp_fmax<0x141>(m);
              const float sc = m > 0.f ? m * (1.f / 127.f) : 1.f, inv = m > 0.f ? 127.f / m : 0.f;
              u32x4 w;
#pragma unroll
              for (int q = 0; q < 4; ++q) w[q] = pack_i8(v[4 * q] * inv, v[4 * q + 1] * inv, v[4 * q + 2] * inv, v[4 * q + 3] * inv);
              *(LAS u32x4*)(xl + (8 * r + xg) * 128 + 16 * ch) = w;
              if (ch == 0) xsl[8 * r + xg] = sc; } }
        int e_lo = (int)F.EID()[(unsigned)(t0 * 128 + lane)], e_hi = (int)F.EID()[(unsigned)(t0 * 128 + 64 + lane)];
        int n_lo = (int)F.EID()[(unsigned)((t0 + 1) * 128 + lane)], n_hi = (int)F.EID()[(unsigned)((t0 + 1) * 128 + 64 + lane)];
        u32x4 rA[8], rB[8];
        P8_LOAD8(rA, e_lo, ubase, uoff)
#pragma unroll 1
        for (int i = 0; i < XQ_TOK; ++i) {
            const int t = t0 + i, tnn = t0 + (i < XQ_TOK - 2 ? i + 2 : XQ_TOK - 1);
            const int nn_lo = (int)F.EID()[(unsigned)(tnn * 128 + lane)], nn_hi = (int)F.EID()[(unsigned)(tnn * 128 + 64 + lane)];
            const u32x4 xq = *(const LAS u32x4*)(xl + i * 128 + 16 * ch); const float xs = xsl[i];
            int p[16];
            P8_LOAD8(rB, e_hi, ubase, uoff)
            __builtin_amdgcn_sched_barrier(0);
            P8U_DOT8(rA, 0)
            __builtin_amdgcn_sched_barrier(0);
            P8_LOAD8(rA, n_lo, ubase, uoff)
            __builtin_amdgcn_sched_barrier(0);
            P8U_DOT8(rB, 8)
            int r8[8], r4[4], r2[2];
#pragma unroll
            for (int q = 0; q < 8; ++q) r8[q] = dpp_isum<0x141>(b2 ? p[q + 8] : p[q], b2 ? p[q] : p[q + 8]);
#pragma unroll
            for (int q = 0; q < 4; ++q) r4[q] = dpp_isum<0xB1>(b0 ? r8[q + 4] : r8[q], b0 ? r8[q] : r8[q + 4]);
#pragma unroll
            for (int q = 0; q < 2; ++q) r2[q] = dpp_isum<0x4E>(b1 ? r4[q + 2] : r4[q], b1 ? r4[q] : r4[q + 2]);
            part[(unsigned)(t * 128 + kout)] = f2bf((float)r2[0] * xs); part[(unsigned)(t * 128 + kout + 8)] = f2bf((float)r2[1] * xs);
            e_lo = n_lo; e_hi = n_hi; n_lo = nn_lo; n_hi = nn_hi;
            __builtin_amdgcn_sched_barrier(0);
        }
    }
}
__device__ __forceinline__ float* CSP(const Frame& F) { return (float*)(F.ws + WS_C + (size_t)MREAL * 128 * 2); }
template <int CTRL> __device__ __forceinline__ float dpp_fmax2(float v) { return fmaxf(v, __uint_as_float((unsigned)__builtin_amdgcn_update_dpp(0, (int)__float_as_uint(v), CTRL, 0xF, 0xF, false))); }
struct CbPf { u32x4 sc[16]; u32x4 ew; f32x4 g0, g1; };
static_assert(2 * NEXP / 4 == 16 * NTHR, "scale tables: 16 loads of 16 bytes per thread");
__device__ __forceinline__ void p8c_prefetch(const Frame& F, CbPf& pf) {
    const int tid = fresh((int)threadIdx.x); const u32x4* ssrc = (const u32x4*)F.SU();
#pragma unroll
    for (int k = 0; k < 16; ++k) pf.sc[k] = ssrc[tid + NTHR * k];
    int i8 = F.bid * NTHR + tid; i8 = i8 < MREAL * 16 ? i8 : MREAL * 16 - 1;
    pf.ew = *(const u32x4*)(F.EID() + i8 * 8); pf.g0 = *(const f32x4*)(F.GATE() + i8 * 8); pf.g1 = *(const f32x4*)(F.GATE() + i8 * 8 + 4);
}
__device__ __forceinline__ void p8c_combine(const Frame& F, const CbPf& pf) {
    { const int tid = fresh((int)threadIdx.x);
#pragma unroll
      for (int k = 0; k < 16; ++k) *(LAS u32x4*)(F.lds + 16 * (tid + NTHR * k)) = pf.sc[k]; }
    __syncthreads();
    LAS const float* lsu = (LAS const float*)F.lds; LAS const float* lsv = lsu + NEXP;
    const int i8first = F.bid * NTHR + fresh((int)threadIdx.x);
    for (int i8 = i8first; i8 < MREAL * 16; i8 += F.G * NTHR) {
        const int idx = i8 * 8, t = i8 >> 4;
        u32x4 pp[8];
#pragma unroll
        for (int s = 0; s < 8; ++s) pp[s] = *(const u32x4*)(F.PART() + (size_t)s * ((size_t)MREAL * 128) + idx);
        u32x4 ew; f32x4 g0, g1;
        if (i8 == i8first) { ew = pf.ew; g0 = pf.g0; g1 = pf.g1; }
        else { ew = *(const u32x4*)(F.EID() + idx); g0 = *(const f32x4*)(F.GATE() + idx); g1 = *(const f32x4*)(F.GATE() + idx + 4); }
        const float rstd = rsqrtf(F.SUMSQ()[t] * (1.f / 1024.f) + RMS_EPS);
        float su[8], sv[8], c[8];
#pragma unroll
        for (int j = 0; j < 8; ++j) { const int e = (int)((ew[j >> 1] >> (16 * (j & 1))) & 0xffffu); su[j] = lsu[e]; sv[j] = lsv[e]; }
        float m = 0.f;
#pragma unroll
        for (int q = 0; q < 4; ++q) { float sl = 0.f, sh = 0.f;
#pragma unroll
            for (int s = 0; s < 8; ++s) { sl += bflo(pp[s][q]); sh += bfhi(pp[s][q]); }
            const float al = sl * su[2 * q] * rstd, ah = sh * su[2 * q + 1] * rstd;
            const float gl = q < 2 ? g0[2 * q] : g1[2 * q - 4], gh = q < 2 ? g0[2 * q + 1] : g1[2 * q - 3];
            c[2 * q] = 0.5f * al * (1.f + erff(al * 0.70710678118654752f)) * gl * sv[2 * q]; c[2 * q + 1] = 0.5f * ah * (1.f + erff(ah * 0.70710678118654752f)) * gh * sv[2 * q + 1];
            m = fmaxf(m, fmaxf(fabsf(c[2 * q]), fabsf(c[2 * q + 1]))); }
        m = dpp_fmax2<0xB1>(m); m = dpp_fmax2<0x4E>(m); m = dpp_fmax2<0x141>(m); m = dpp_fmax2<0x140>(m);
        const float sc = m > 0.f ? 256.f / m : 1.f;
        unsigned ow[4];
#pragma unroll
        for (int q = 0; q < 4; ++q) { const float x0 = c[2 * q] * sc, x1 = c[2 * q + 1] * sc;
            const int p1 = __builtin_amdgcn_cvt_pk_fp8_f32(x0, x1, 0, false);
            const float r0 = x0 - __builtin_amdgcn_cvt_f32_fp8(p1, 0), r1 = x1 - __builtin_amdgcn_cvt_f32_fp8(p1, 1);
            int w2 = __builtin_amdgcn_cvt_pk_fp8_f32(x0, r0, 0, false); w2 = __builtin_amdgcn_cvt_pk_fp8_f32(x1, r1, w2, true);
            ow[q] = (unsigned)w2; }
        *(u32x4*)(F.CB() + idx) = (u32x4){ow[0], ow[1], ow[2], ow[3]};
        if ((i8 & 15) == 0) CSP(F)[t] = m > 0.f ? m * (1.f / 256.f) : 1.f;
    }
    __syncthreads();
}
#define P8V_FMA8(R, C) _Pragma("unroll") for (int ii = 0; ii < 8; ++ii) { const f32x2 c2 = {C[ii], C[ii]};                            \
        _Pragma("unroll") for (int q = 0; q < 4; ++q) { acc2[2 * q] += c2 * __builtin_amdgcn_cvt_pk_f32_fp8((int)R[ii][q], false); acc2[2 * q + 1] += c2 * __builtin_amdgcn_cvt_pk_f32_fp8((int)R[ii][q], true); } }
#define P8V_COEF8(C, CV) _Pragma("unroll") for (int ii = 0; ii < 8; ++ii) C[ii] = __shfl((CV), 8 * ii + xg);
template <int QPASS>
__device__ __forceinline__ void p8v_experts(const Frame& F) {
    unsigned* ctl = (unsigned*)(F.ws + WS_CTL);
    int cur = (int)(xb_xcc_id() & 7u);
    for (;;) { const int itm = next_item(F, ctl, QPASS, cur); if (itm < 0) break;
        const int s = itm >> 16, chunk = itm & 0xffff; cur = s;
        const int lane = fresh((int)threadIdx.x) & 63, xg = lane >> 3, ch = lane & 7;
        const int t0 = chunk * (8 * XQ_TOK) + F.wave * XQ_TOK;
        const unsigned char* vbase = F.V8() + (size_t)s * (NEXP * 128);
        const unsigned voff = 16u * ch;
        const bool b5 = lane & 32, b4 = lane & 16, b3 = lane & 8;
        const int col = 128 * s + 16 * ch + (b5 ? 8 : 0) + (b4 ? 4 : 0) + (b3 ? 2 : 0);
        int e_lo = (int)F.EID()[(unsigned)(t0 * 128 + lane)], e_hi = (int)F.EID()[(unsigned)(t0 * 128 + 64 + lane)];
        int n_lo = (int)F.EID()[(unsigned)((t0 + 1) * 128 + lane)], n_hi = (int)F.EID()[(unsigned)((t0 + 1) * 128 + 64 + lane)];
#define P8V_CDEC(T, H) ((__builtin_amdgcn_cvt_f32_fp8((int)F.CB()[(unsigned)((T) * 128 + 64 * (H) + lane)], 0) + __builtin_amdgcn_cvt_f32_fp8((int)F.CB()[(unsigned)((T) * 128 + 64 * (H) + lane)], 1)) * CSP(F)[(T)])
        float c_lo = P8V_CDEC(t0, 0), c_hi = P8V_CDEC(t0, 1);
        u32x4 rA[8], rB[8];
        P8_LOAD8(rA, e_lo, vbase, voff)
#pragma unroll 1
        for (int i = 0; i < XQ_TOK; ++i) {
            const int t = t0 + i, tn = t0 + (i < XQ_TOK - 1 ? i + 1 : XQ_TOK - 1), tnn = t0 + (i < XQ_TOK - 2 ? i + 2 : XQ_TOK - 1);
            const int nn_lo = (int)F.EID()[(unsigned)(tnn * 128 + lane)], nn_hi = (int)F.EID()[(unsigned)(tnn * 128 + 64 + lane)];
            const float nc_lo = P8V_CDEC(tn, 0), nc_hi = P8V_CDEC(tn, 1);
            const unsigned h1w = *(const unsigned*)(F.H1B() + (unsigned)(t * 1024 + col)); const f32x2 h1 = {bflo(h1w), bfhi(h1w)};
            f32x2 acc2[8]; float cc[8];
#pragma unroll
            for (int q = 0; q < 8; ++q) acc2[q] = (f32x2){0.f, 0.f};
            P8_LOAD8(rB, e_hi, vbase, voff)
            P8V_COEF8(cc, c_lo)
            __builtin_amdgcn_sched_barrier(0);
            P8V_FMA8(rA, cc)
            __builtin_amdgcn_sched_barrier(0);
            P8_LOAD8(rA, n_lo, vbase, voff)
            P8V_COEF8(cc, c_hi)
            __builtin_amdgcn_sched_barrier(0);
            P8V_FMA8(rB, cc)
            __builtin_amdgcn_sched_barrier(0);
            float acc[16];
#pragma unroll
            for (int q = 0; q < 8; ++q) { acc[2 * q] = acc2[q][0]; acc[2 * q + 1] = acc2[q][1]; }
            float r8[8], r4[4], r2[2];
#pragma unroll
            for (int q = 0; q < 8; ++q) r8[q] = swap32_sum(acc[q], acc[q + 8]);
#pragma unroll
            for (int q = 0; q < 4; ++q) r4[q] = swap16_sum(r8[q], r8[q + 4]);
#pragma unroll
            for (int q = 0; q < 2; ++q) r2[q] = ror8_sum(b3 ? r4[q + 2] : r4[q], b3 ? r4[q] : r4[q + 2]);
            *(f32x2*)(F.out + (unsigned)(t * 1024 + col)) = (f32x2){h1[0] + r2[0], h1[1] + r2[1]};
            e_lo = n_lo; e_hi = n_hi; n_lo = nn_lo; n_hi = nn_hi; c_lo = nc_lo; c_hi = nc_hi;
            __builtin_amdgcn_sched_barrier(0);
        }
    }
}

typedef int i32x2 __attribute__((ext_vector_type(2)));
#define P8M_TR(DST, ADDR, OFF) asm volatile("ds_read_b64_tr_b8 %0, %1 offset:" #OFF : "=v"(DST) : "v"(ADDR) : "memory")
#define P8M_RD9(FA, F0, F1, F2, F3, F4, F5, F6, F7, VOFF, AOFF) P8M_TR(FA, aa, AOFF); P8M_TR(F0, ab[0], VOFF); P8M_TR(F1, ab[1], VOFF); P8M_TR(F2, ab[2], VOFF); P8M_TR(F3, ab[3], VOFF); \
        P8M_TR(F4, ab[4], VOFF); P8M_TR(F5, ab[5], VOFF); P8M_TR(F6, ab[6], VOFF); P8M_TR(F7, ab[7], VOFF);
#define P8M_MM8(FA, F0, F1, F2, F3, F4, F5, F6, F7) acc[0] = __builtin_amdgcn_mfma_f32_16x16x32_fp8_fp8(FA, F0, acc[0], 0, 0, 0); acc[1] = __builtin_amdgcn_mfma_f32_16x16x32_fp8_fp8(FA, F1, acc[1], 0, 0, 0); \
        acc[2] = __builtin_amdgcn_mfma_f32_16x16x32_fp8_fp8(FA, F2, acc[2], 0, 0, 0); acc[3] = __builtin_amdgcn_mfma_f32_16x16x32_fp8_fp8(FA, F3, acc[3], 0, 0, 0); \
        acc[4] = __builtin_amdgcn_mfma_f32_16x16x32_fp8_fp8(FA, F4, acc[4], 0, 0, 0); acc[5] = __builtin_amdgcn_mfma_f32_16x16x32_fp8_fp8(FA, F5, acc[5], 0, 0, 0); \
        acc[6] = __builtin_amdgcn_mfma_f32_16x16x32_fp8_fp8(FA, F6, acc[6], 0, 0, 0); acc[7] = __builtin_amdgcn_mfma_f32_16x16x32_fp8_fp8(FA, F7, acc[7], 0, 0, 0);
#define P8M_STEP2(VOFF0, AOFF0, VOFF1, AOFF1) { long fa, fb0, fb1, fb2, fb3, fb4, fb5, fb6, fb7, ga, gb0, gb1, gb2, gb3, gb4, gb5, gb6, gb7;         \
        P8M_RD9(fa, fb0, fb1, fb2, fb3, fb4, fb5, fb6, fb7, VOFF0, AOFF0) P8M_RD9(ga, gb0, gb1, gb2, gb3, gb4, gb5, gb6, gb7, VOFF1, AOFF1)               \
        asm volatile("s_waitcnt lgkmcnt(9)" : "+v"(fa), "+v"(fb0), "+v"(fb1), "+v"(fb2), "+v"(fb3), "+v"(fb4), "+v"(fb5), "+v"(fb6), "+v"(fb7) :: "memory"); \
        P8M_MM8(fa, fb0, fb1, fb2, fb3, fb4, fb5, fb6, fb7)                                                                                         \
        asm volatile("s_waitcnt lgkmcnt(0)" : "+v"(ga), "+v"(gb0), "+v"(gb1), "+v"(gb2), "+v"(gb3), "+v"(gb4), "+v"(gb5), "+v"(gb6), "+v"(gb7) :: "memory"); \
        P8M_MM8(ga, gb0, gb1, gb2, gb3, gb4, gb5, gb6, gb7) }
#define P8M_RD16(DST, ADDR, OFF) asm volatile("ds_read_u16 %0, %1 offset:" #OFF : "=v"(DST) : "v"(ADDR) : "memory")
#define P8M_IDS(G, ADDR) { P8M_RD16(G[0], ADDR, 0); P8M_RD16(G[1], ADDR, 16); P8M_RD16(G[2], ADDR, 32); P8M_RD16(G[3], ADDR, 48); P8M_RD16(G[4], ADDR, 64); P8M_RD16(G[5], ADDR, 80); P8M_RD16(G[6], ADDR, 96); P8M_RD16(G[7], ADDR, 112); }
#define P8M_HALF(P, H, B) { unsigned g_[8], cw_; const unsigned ia_ = wl32 + 17408u + 256u * (unsigned)(P) + 128u * (H) + 2u * (unsigned)xg, ca_ = wl32 + 18176u + 256u * (unsigned)(P) + 128u * (H) + 2u * (unsigned)lane; \
        P8M_IDS(g_, ia_) P8M_RD16(cw_, ca_, 0);                                                                                                 \
        asm volatile("s_waitcnt lgkmcnt(0)" : "+v"(g_[0]), "+v"(g_[1]), "+v"(g_[2]), "+v"(g_[3]), "+v"(g_[4]), "+v"(g_[5]), "+v"(g_[6]), "+v"(g_[7]), "+v"(cw_) :: "memory"); \
        const unsigned w_ = cw_ * 0x10001u; const u32x2 w2_ = {w_, w_};            \
        asm volatile("ds_write_b64 %0, %1" :: "v"(wl32 + 16384u + 512u * (B) + 8u * (unsigned)lane), "v"(w2_) : "memory");                             \
        _Pragma("unroll") for (int ii = 0; ii < 8; ++ii) __builtin_amdgcn_global_load_lds((const unsigned*)(vbase + (g_[ii] * 128u + ((ii & 1) ? off_o : off_e))), (LAS unsigned*)(wl + (B) * 8192 + ii * 1024), 16, 0, 0); }
#define P8M_SMALL(T, P) { __builtin_amdgcn_global_load_lds((const unsigned*)(F.EID() + (unsigned)((T) * 128)) + lane, (LAS unsigned*)(wl + 17408 + 256 * (P)), 4, 0, 0);       \
        __builtin_amdgcn_global_load_lds((const unsigned*)(F.CB() + (unsigned)((T) * 128)) + lane, (LAS unsigned*)(wl + 18176 + 256 * (P)), 4, 0, 0);                                 \
        __builtin_amdgcn_global_load_lds((const unsigned*)(F.H1B() + (unsigned)((T) * 1024 + 128 * s)) + lane, (LAS unsigned*)(wl + 18944 + 256 * (P)), 4, 0, 0); }
#define P8M_WAIT(N) asm volatile("s_waitcnt vmcnt(" #N ")" ::: "memory")
template <int QPASS>
__device__ __forceinline__ void p8v_mfma(const Frame& F) {
    unsigned* ctl = (unsigned*)(F.ws + WS_CTL);
    int cur = (int)(xb_xcc_id() & 7u);
    LAS unsigned char* wl = F.lds + F.wave * 19712;
    for (;;) { const int itm = next_item(F, ctl, QPASS, cur); if (itm < 0) break;
        const int s = itm >> 16, chunk = itm & 0xffff; cur = s;
        const int lane = fresh((int)threadIdx.x) & 63, xg = lane >> 3, ch = lane & 7, i16 = lane & 15, kg = lane >> 4;
        const int t0 = __builtin_amdgcn_readfirstlane(chunk * (8 * XQ_TOK) + F.wave * XQ_TOK);
        const unsigned char* vbase = F.V8() + (size_t)s * (NEXP * 128);
        const unsigned off_e = 16u * (unsigned)(ch ^ (xg >> 1)), off_o = 16u * (unsigned)(ch ^ (4 | (xg >> 1)));
        const int r0 = 8 * kg + (i16 >> 1), sl = (4 * (kg & 1)) | (i16 >> 2);
        const unsigned wl32 = (unsigned)(size_t)wl;
        unsigned ab[8];
#pragma unroll
        for (int j = 0; j < 8; ++j) ab[j] = wl32 + (unsigned)(128 * r0 + 16 * (j ^ sl) + 8 * (i16 & 1));
        const unsigned aa = wl32 + (unsigned)(8 * r0);
        const int col0 = 128 * s + lane;
        asm volatile("s_waitcnt vmcnt(0)" ::: "memory");
        P8M_SMALL(t0, 0)
        P8M_SMALL(t0 + 1, 1)
        P8M_WAIT(0);
        P8M_HALF(0, 0u, 0u)
        int r3 = 0;
        float po0 = 0.f, po1 = 0.f;
#pragma unroll 1
        for (int i = 0; i < XQ_TOK; ++i) {
            const int t = t0 + i, tn2 = t0 + (i < XQ_TOK - 2 ? i + 2 : XQ_TOK - 1), tp = t0 + (i > 0 ? i - 1 : 0);
            const int r3n = r3 == 2 ? 0 : r3 + 1, r3nn = r3n == 2 ? 0 : r3n + 1;
            float cs; { const float* csp_ = CSP(F) + t; asm volatile("s_load_dword %0, %1, 0x0" : "=s"(cs) : "s"(csp_) : "memory"); }
            f32x4 acc[8];
#pragma unroll
            for (int j = 0; j < 8; ++j) acc[j] = (f32x4){0.f, 0.f, 0.f, 0.f};
            P8M_SMALL(tn2, r3nn)
            P8M_HALF(r3, 1u, 1u)
            P8M_WAIT(11);
            F.out[(unsigned)(tp * 1024 + col0)] = po0; F.out[(unsigned)(tp * 1024 + col0 + 64)] = po1;
            __builtin_amdgcn_sched_barrier(0);
            P8M_STEP2(0, 16384, 4096, 16640)
            __builtin_amdgcn_sched_barrier(0);
            P8M_HALF(r3n, 0u, 0u)
            P8M_WAIT(10);
            __builtin_amdgcn_sched_barrier(0);
            P8M_STEP2(8192, 16896, 12288, 17152)
            __builtin_amdgcn_sched_barrier(0);
            unsigned h1ar, h1br; const unsigned ha_ = wl32 + 18944u + 256u * (unsigned)r3 + 2u * (unsigned)lane;
            P8M_RD16(h1ar, ha_, 0); P8M_RD16(h1br, ha_, 128);
            asm volatile("s_waitcnt lgkmcnt(0)" : "+v"(h1ar), "+v"(h1br) :: "memory");
            float sj[8];
#pragma unroll
            for (int j = 0; j < 8; ++j) sj[j] = acc[j][0] + acc[j][1];
            const float v0 = kg == 0 ? sj[0] : kg == 1 ? sj[1] : kg == 2 ? sj[2] : sj[3], v1 = kg == 0 ? sj[4] : kg == 1 ? sj[5] : kg == 2 ? sj[6] : sj[7];
            po0 = __uint_as_float(h1ar << 16) + v0 * cs; po1 = __uint_as_float(h1br << 16) + v1 * cs; r3 = r3n;
            __builtin_amdgcn_sched_barrier(0);
        }
        F.out[(unsigned)((t0 + XQ_TOK - 1) * 1024 + col0)] = po0; F.out[(unsigned)((t0 + XQ_TOK - 1) * 1024 + col0 + 64)] = po1;
        asm volatile("s_waitcnt vmcnt(0)" ::: "memory");
    }
}
typedef int i32x4v __attribute__((ext_vector_type(4)));
#define P8N_RD128(DST, ADDR, OFF) asm volatile("ds_read_b128 %0, %1 offset:" #OFF : "=v"(DST) : "v"(ADDR) : "memory")
#define P8N_MMA(BOFF0, BOFF1, BOFF2, BOFF3, A0, A1, A2, A3) { i32x4v r0_, r1_, r2_, r3_, r4_, r5_, r6_, r7_;                                        \
        P8N_RD128(r0_, ra0, BOFF0); P8N_RD128(r1_, ra1, BOFF0); P8N_RD128(r2_, ra0, BOFF1); P8N_RD128(r3_, ra1, BOFF1);                                 \
        P8N_RD128(r4_, ra0, BOFF2); P8N_RD128(r5_, ra1, BOFF2); P8N_RD128(r6_, ra0, BOFF3); P8N_RD128(r7_, ra1, BOFF3);                                 \
        asm volatile("s_waitcnt lgkmcnt(4)" : "+v"(r0_), "+v"(r1_), "+v"(r2_), "+v"(r3_), "+v"(xa0), "+v"(xa1) :: "memory");                            \
        const i32x4v z_ = {0, 0, 0, 0};                                                                                                           \
        A0 = __builtin_amdgcn_mfma_i32_16x16x64_i8(xa0, r0_, z_, 0, 0, 0); A1 = __builtin_amdgcn_mfma_i32_16x16x64_i8(xa0, r2_, z_, 0, 0, 0);           \
        A0 = __builtin_amdgcn_mfma_i32_16x16x64_i8(xa1, r1_, A0, 0, 0, 0); A1 = __builtin_amdgcn_mfma_i32_16x16x64_i8(xa1, r3_, A1, 0, 0, 0);           \
        asm volatile("s_waitcnt lgkmcnt(0)" : "+v"(r4_), "+v"(r5_), "+v"(r6_), "+v"(r7_) :: "memory");                                              \
        A2 = __builtin_amdgcn_mfma_i32_16x16x64_i8(xa0, r4_, z_, 0, 0, 0); A3 = __builtin_amdgcn_mfma_i32_16x16x64_i8(xa0, r6_, z_, 0, 0, 0);           \
        A2 = __builtin_amdgcn_mfma_i32_16x16x64_i8(xa1, r5_, A2, 0, 0, 0); A3 = __builtin_amdgcn_mfma_i32_16x16x64_i8(xa1, r7_, A3, 0, 0, 0); }
#define P8N_HALF(P, H, B) { unsigned g_[8]; const unsigned ia_ = wl32 + 16384u + 256u * (unsigned)(P) + 128u * (H) + 2u * (unsigned)xg;             \
        P8M_IDS(g_, ia_)                                                                                                                       \
        asm volatile("s_waitcnt lgkmcnt(0)" : "+v"(g_[0]), "+v"(g_[1]), "+v"(g_[2]), "+v"(g_[3]), "+v"(g_[4]), "+v"(g_[5]), "+v"(g_[6]), "+v"(g_[7]) :: "memory"); \
        _Pragma("unroll") for (int ii = 0; ii < 8; ++ii) __builtin_amdgcn_global_load_lds((const unsigned*)(ubase + (g_[ii] * 128u + ((ii & 1) ? off_o : off_e))), (LAS unsigned*)(wl + (B) * 8192 + ii * 1024), 16, 0, 0); }
#define P8N_SMALL(T, P) { __builtin_amdgcn_global_load_lds((const unsigned*)(F.EID() + (unsigned)((T) * 128)) + lane, (LAS unsigned*)(wl + 16384 + 256 * (P)), 4, 0, 0);       \
        __builtin_amdgcn_global_load_lds((const unsigned*)(F.H1B() + (unsigned)((T) * 1024 + 128 * s)) + lane, (LAS unsigned*)(wl + 17152 + 256 * (P)), 4, 0, 0); }
#define P8N_QUANT(P, PQ, XS) { unsigned xw_; asm volatile("ds_read_b32 %0, %1" : "=v"(xw_) : "v"(wl32 + 17152u + 256u * (unsigned)(P) + 4u * (unsigned)lane) : "memory");                      \
        asm volatile("s_waitcnt lgkmcnt(0)" : "+v"(xw_) :: "memory");                                                                           \
        const float v0_ = bflo(xw_), v1_ = bfhi(xw_); float m_ = fmaxf(fabsf(v0_), fabsf(v1_));                                                    \
        m_ = dpp_fmax<0xB1>(m_); m_ = dpp_fmax<0x4E>(m_); m_ = dpp_fmax<0x141>(m_); m_ = dpp_fmax<0x140>(m_);                                      \
        { const int mi_ = (int)__float_as_uint(m_); m_ = fmaxf(fmaxf(__uint_as_float((unsigned)__builtin_amdgcn_readlane(mi_, 0)), __uint_as_float((unsigned)__builtin_amdgcn_readlane(mi_, 16))), fmaxf(__uint_as_float((unsigned)__builtin_amdgcn_readlane(mi_, 32)), __uint_as_float((unsigned)__builtin_amdgcn_readlane(mi_, 48)))); } \
        XS = m_ > 0.f ? m_ * (1.f / 127.f) : 1.f; const float inv_ = m_ > 0.f ? 127.f / m_ : 0.f;                                                   \
        const unsigned q_ = __builtin_amdgcn_perm(__float_as_uint(v1_ * inv_ + 12582912.f), __float_as_uint(v0_ * inv_ + 12582912.f), 0x0c0c0400u);  \
        asm volatile("ds_write_b16 %0, %1" :: "v"(wl32 + 17920u + 128u * (unsigned)(PQ) + 2u * (unsigned)lane), "v"(q_) : "memory"); }
template <int QPASS>
__device__ __forceinline__ void p8u_mfma(const Frame& F) {
    unsigned* ctl = (unsigned*)(F.ws + WS_CTL);
    int cur = (int)(xb_xcc_id() & 7u);
    LAS unsigned char* wl = F.lds + F.wave * 18176;
    for (;;) { const int itm = next_item(F, ctl, QPASS, cur); if (itm < 0) break;
        const int s = itm >> 16, chunk = itm & 0xffff; cur = s;
        const int lane = fresh((int)threadIdx.x) & 63, xg = lane >> 3, ch = lane & 7, i16 = lane & 15, kg = lane >> 4;
        const int t0 = __builtin_amdgcn_readfirstlane(chunk * (8 * XQ_TOK) + F.wave * XQ_TOK);
        const unsigned char* ubase = F.U8() + (size_t)s * (NEXP * 128);
        const unsigned off_e = 16u * (unsigned)(ch ^ (xg >> 1)), off_o = 16u * (unsigned)(ch ^ (4 | (xg >> 1)));
        const unsigned wl32 = (unsigned)(size_t)wl;
        const unsigned ra0 = wl32 + (unsigned)(128 * i16 + 16 * (kg ^ (i16 >> 1))), ra1 = wl32 + (unsigned)(128 * i16 + 16 * ((kg ^ (i16 >> 1)) ^ 4));
        bf16_t* part = F.PART() + (size_t)s * ((size_t)MREAL * 128);
        const int k0 = 32 * kg + i16;
        asm volatile("s_waitcnt vmcnt(0)" ::: "memory");
        P8N_SMALL(t0, 0)
        P8N_SMALL(t0 + 1, 1)
        P8M_WAIT(0);
        float xs_cur, xs_nxt = 1.f;
        P8N_QUANT(0, 0, xs_cur)
        P8N_HALF(0, 0u, 0u)
        int r3 = 0;
        bf16_t po0 = 0, po1 = 0;
#pragma unroll 1
        for (int i = 0; i < XQ_TOK; ++i) {
            const int t = t0 + i, tn2 = t0 + (i < XQ_TOK - 2 ? i + 2 : XQ_TOK - 1), tp = t0 + (i > 0 ? i - 1 : 0), par = i & 1;
            const int r3n = r3 == 2 ? 0 : r3 + 1, r3nn = r3n == 2 ? 0 : r3n + 1;
            P8N_SMALL(tn2, r3nn)
            P8N_HALF(r3, 1u, 1u)
            P8M_WAIT(10);
            part[(unsigned)(tp * 128 + k0)] = po0; part[(unsigned)(tp * 128 + k0 + 16)] = po1;
            __builtin_amdgcn_sched_barrier(0);
            i32x4v xa0, xa1; { const unsigned xqa_ = wl32 + 17920u + 128u * (unsigned)par + 16u * (unsigned)kg; P8N_RD128(xa0, xqa_, 0); P8N_RD128(xa1, xqa_, 64); }
            i32x4v acc0, acc1, acc2, acc3, acc4, acc5, acc6, acc7;
            P8N_MMA(0, 2048, 4096, 6144, acc0, acc1, acc2, acc3)
            __builtin_amdgcn_sched_barrier(0);
            P8N_QUANT(r3n, par ^ 1, xs_nxt)
            P8N_HALF(r3n, 0u, 0u)
            P8M_WAIT(10);
            __builtin_amdgcn_sched_barrier(0);
            P8N_MMA(8192, 10240, 12288, 14336, acc4, acc5, acc6, acc7)
            __builtin_amdgcn_sched_barrier(0);
            const int v0 = kg == 0 ? acc0[0] : kg == 1 ? acc2[0] : kg == 2 ? acc4[0] : acc6[0], v1 = kg == 0 ? acc1[0] : kg == 1 ? acc3[0] : kg == 2 ? acc5[0] : acc7[0];
            po0 = f2bf_c((float)v0 * xs_cur); po1 = f2bf_c((float)v1 * xs_cur);
            xs_cur = xs_nxt; r3 = r3n;
            __builtin_amdgcn_sched_barrier(0);
        }
        part[(unsigned)((t0 + XQ_TOK - 1) * 128 + k0)] = po0; part[(unsigned)((t0 + XQ_TOK - 1) * 128 + k0 + 16)] = po1;
        asm volatile("s_waitcnt vmcnt(0)" ::: "memory");
    }
}
__device__ __forceinline__ bool p8v_calibrate(const Frame& F) {
    const int lane = fresh((int)threadIdx.x) & 63, i16 = lane & 15;
    LAS unsigned char* wl = F.lds + F.wave * 19968;
    if (lane < 32) *(LAS unsigned*)(wl + 4 * lane) = (unsigned)(4 * lane) * 0x01010101u + 0x03020100u;
    const i32x2 v = __builtin_amdgcn_ds_read_tr8_b64_v2i32((LAS i32x2*)(wl + 16 * (i16 >> 1) + 8 * (i16 & 1)));
    const unsigned n = (unsigned)i16;
    const unsigned e0 = n | ((16u + n) << 8) | ((32u + n) << 16) | ((48u + n) << 24), e1 = (64u + n) | ((80u + n) << 8) | ((96u + n) << 16) | ((112u + n) << 24);
    const bool okw = __ballot((unsigned)v[0] == e0 && (unsigned)v[1] == e1) == ~0ull;
    volatile LAS int* flag = (volatile LAS int*)(F.lds + LDS_BYTES - 48);
    __syncthreads();
    if (F.tid == 0) *flag = 1;
    __syncthreads();
    if (!okw && (fresh((int)threadIdx.x) & 63) == 0) *flag = 0;
    __syncthreads();
    return *flag != 0;
}

constexpr int NPHASE = 10;
__global__ void __launch_bounds__(NTHR, 2) mk_fwd(Args args) {
    extern __shared__ __attribute__((aligned(16))) unsigned char lds_raw[];
    Frame F;
    F.lds = (LAS unsigned char*)lds_raw;
    F.tid = threadIdx.x; F.lane = F.tid & 63; F.wave = __builtin_amdgcn_readfirstlane(F.tid >> 6); F.G = gridDim.x; F.bid = blockIdx.x;
    F.x = args.in[0]; F.meta = args.in[1]; F.g1 = args.in[2]; F.w_in = args.in[3]; F.gq = args.in[4]; F.gk = args.in[5]; F.pool_w = args.in[6]; F.pool_scale = args.in[7];
    F.w_out = args.in[8]; F.g2 = args.in[9]; F.wq = args.in[10]; F.sk1 = args.in[11]; F.sk2 = args.in[12]; F.pu = args.in[13]; F.pv = args.in[14];
    F.out = args.out; F.ws = args.ws; unsigned char* ws = args.ws;
    const int lo = args.ph_lo, hi = args.ph_hi;
#ifndef PHASE_MASK
#define PHASE_MASK 0x3ff
#endif
#define IN(k) (((PHASE_MASK >> (k)) & 1) && lo <= (k) && (k) < hi)
    volatile LAS unsigned* bst = (volatile LAS unsigned*)(F.lds + LDS_BYTES - 16);
    if (F.tid == 0) { bst[0] = 0u; bst[1] = 0u; }
    __syncthreads();
    XcdBarrier bar = xcd_barrier_post((unsigned*)(ws + WS_CTL), bst);
#define GSYNC(k) do { if (IN(k) && IN((k) + 1)) xcd_barrier(bar); } while (0)
    if (IN(0)) { p0_prologue(F); }
    GSYNC(0);
    if (IN(1)) { { pg8::Gemm g{F.XN(), F.WIN(), MPAD, NZP, 1024}; pg8::StaticOrder S; S.init(MPAD, NZP, F.G, F.bid); EpiIn E{F.Q(), F.K(), F.VV(), F.QI(), F.KI(), F.UP(), F.WI(), F.gq, F.gk}; pg8::gemm_phase<EpiIn, pg8::StaticOrder>(F.lds, g, S, E);
        if (F.bid >= p1_first_idle(F.G)) p7b_tables(F, (F.bid - p1_first_idle(F.G)) * 8 + F.wave, (F.G - p1_first_idle(F.G)) * 8, 0, tables_rows_p1(F.G)); } }
    GSYNC(1);
    AttnPf apf; const bool apf_have = IN(3) && IN(4);
    if (IN(3)) { p2_weff(F); p2_pool(F); p3_indexer(F); }
    if (apf_have) { p4_item_loads(F, F.bid, apf); xcd_barrier<8>(bar); }
    if (IN(4)) { p4_attention(F, apf, apf_have); }
    GSYNC(4);
    if (IN(5)) { { pg8::Gemm g{F.MIX(), F.WOUT(), MREAL, 1024, 1024}; pg8::StaticOrder S; S.init(MREAL, 1024, F.G, F.bid); EpiOut E{F.x, F.out, F.H1B(), F.SUMSQ()}; pg8::gemm_phase<EpiOut, pg8::StaticOrder>(F.lds, g, S, E); } }
    GSYNC(5);
    if (IN(6)) { { pg8::Gemm g{F.H1B(), F.WQ(), MREAL, 2048, 1024}; pg8::StaticOrder S; S.init(MREAL, 2048, F.G, F.bid); EpiQP E{F.QP(), F.SUMSQ()}; pg8::gemm_phase<EpiQP, pg8::StaticOrder>(F.lds, g, S, E); } }
    if (IN(7)) { p7_routing(F); }
    GSYNC(7);
    if (IN(8)) { p8u_mfma<0>(F); CbPf cpf; p8c_prefetch(F, cpf); xcd_barrier<19>(bar); p8c_combine(F, cpf); }
    GSYNC(8);
    if (IN(9)) { if (p8v_calibrate(F)) p8v_mfma<1>(F);
        else p8v_experts<1>(F); }

#undef IN
#undef GSYNC
}
}

extern "C" void kernel_launch(void* const* d_in, const int* in_sizes, int n_in, void* d_out, int out_size, void* d_ws, size_t ws_size, hipStream_t stream) {
    static int grid = 0;
    if (grid == 0) {
        if (n_in != 15 || out_size != mk::MREAL * 1024 || ws_size < mk::WS_END) { fprintf(stderr, "kernel_launch: unexpected problem (n_in %d out %d ws %zu)\n", n_in, out_size, ws_size); grid = -1; return; }
        int dev = 0, cus = 0;
        if (hipGetDevice(&dev) != hipSuccess || hipDeviceGetAttribute(&cus, hipDeviceAttributeMultiprocessorCount, dev) != hipSuccess) { grid = -1; return; }
        if (hipFuncSetAttribute((const void*)mk::mk_fwd, hipFuncAttributeMaxDynamicSharedMemorySize, mk::LDS_BYTES) != hipSuccess) { fprintf(stderr, "kernel_launch: hipFuncSetAttribute failed\n"); grid = -1; return; }
        int per_cu = 0;
        if (hipOccupancyMaxActiveBlocksPerMultiprocessor(&per_cu, (const void*)mk::mk_fwd, mk::NTHR, mk::LDS_BYTES) != hipSuccess || per_cu < 1) { fprintf(stderr, "kernel_launch: occupancy query says %d\n", per_cu); grid = -1; return; }
        grid = cus;
    }
    if (grid < 0) return;
    if (hipMemsetAsync((char*)d_ws + mk::WS_CTL, 0, 32768, stream) != hipSuccess) { fprintf(stderr, "kernel_launch: memset failed\n"); return; }
    mk::Args a{};
    for (int i = 0; i < 15; ++i) a.in[i] = (const float*)d_in[i];
    a.out = (float*)d_out; a.ws = (unsigned char*)d_ws; a.ph_lo = 0; a.ph_hi = mk::NPHASE;
    void* kargs[] = {&a};
    hipError_t e = hipLaunchCooperativeKernel((const void*)mk::mk_fwd, dim3(grid), dim3(mk::NTHR), kargs, mk::LDS_BYTES, stream);
    if (e != hipSuccess) fprintf(stderr, "kernel_launch: cooperative launch failed: %s (grid %d)\n", hipGetErrorString(e), grid);

}
```
